# Optimizing an MI355X kernel written in HIP

```python
import math
import jax, jax.numpy as jnp
from jax import lax
import numpy as np

D_MODEL = 2048
BATCH = 4
SEQ = 4096
DEPTH = 4

D_MIX = D_MODEL
D_CONV = D_MIX // 4
CONV_GROUPS = 4
CONV_WIDTH = 3
HEAD_DIM = 128
D_ATT = D_MIX // 2
N_ATT_HEADS = D_ATT // HEAD_DIM
D_LRU = D_MIX - D_CONV - D_ATT
LRU_BLOCKS = 4
LRU_BLOCK = D_LRU // LRU_BLOCKS
LRU_CONV_WIDTH = 4
LRU_C = 8.0
D_IN = 3 * D_CONV + 3 * D_ATT + N_ATT_HEADS + 2 * D_LRU
D_FF = 256 * int(math.ceil(8 * D_MODEL / 3 / 256))
Q_BLOCK = 128
EPS = 1e-6

kernel_name = "hymba_parallel_conv_fox_rglru_macaron"


def rmsnorm(x, g):
    xf = x.astype(jnp.float32)
    y = xf * lax.rsqrt(jnp.mean(xf * xf, axis=-1, keepdims=True) + EPS)
    return (y * g.astype(jnp.float32)).astype(x.dtype)


def swiglu(h, w_in, w_out):
    g, u = jnp.split(h @ w_in, 2, axis=-1)
    return (jax.nn.silu(g) * u) @ w_out


def causal_depthwise_conv(x, w):
    k_width, ch = w.shape
    return lax.conv_general_dilated(
        x, w[:, None, :].astype(x.dtype), window_strides=(1,),
        padding=[(k_width - 1, 0)], dimension_numbers=("NWC", "WIO", "NWC"),
        feature_group_count=ch)


def forgetting_attention(q, k, v, f_logit, b_f):
    bsz, seq, _ = q.shape
    def heads(t):
        return t.reshape(bsz, seq, N_ATT_HEADS, HEAD_DIM).transpose(0, 2, 1, 3)
    q, k, v = heads(q), heads(k), heads(v)
    log_f = jax.nn.log_sigmoid(f_logit.astype(jnp.float32) + b_f.astype(jnp.float32))
    cum = jnp.cumsum(log_f, axis=1).transpose(0, 2, 1)
    scale = HEAD_DIM ** -0.5
    k_pos = jnp.arange(seq)

    def block(i):
        start = i * Q_BLOCK
        qb = lax.dynamic_slice_in_dim(q, start, Q_BLOCK, axis=2)
        cb = lax.dynamic_slice_in_dim(cum, start, Q_BLOCK, axis=2)
        s = (jnp.einsum("bhqd,bhkd->bhqk", qb, k).astype(jnp.float32) * scale
             + cb[..., None] - cum[:, :, None, :])
        q_pos = start + jnp.arange(Q_BLOCK)
        s = jnp.where(k_pos[None, :] <= q_pos[:, None], s, -jnp.inf)
        p = jax.nn.softmax(s, axis=-1)
        return jnp.einsum("bhqk,bhkd->bhqd", p.astype(v.dtype), v)

    o = lax.map(block, jnp.arange(seq // Q_BLOCK))
    return o.transpose(1, 0, 3, 2, 4).reshape(bsz, seq, D_ATT)


def rg_lru(x, w_a, b_a, w_x, b_x, lam):
    bsz, seq, _ = x.shape
    xb = x.reshape(bsz, seq, LRU_BLOCKS, LRU_BLOCK)
    r = jax.nn.sigmoid(jnp.einsum("btgi,gij->btgj", xb, w_a).reshape(bsz, seq, D_LRU) + b_a)
    i = jax.nn.sigmoid(jnp.einsum("btgi,gij->btgj", xb, w_x).reshape(bsz, seq, D_LRU) + b_x)
    log_a = -LRU_C * r.astype(jnp.float32) * jax.nn.softplus(-lam.astype(jnp.float32))
    a = jnp.exp(log_a)
    u = jnp.sqrt(-jnp.expm1(2.0 * log_a)) * (i * x).astype(jnp.float32)

    def combine(left, right):
        a1, b1 = left
        a2, b2 = right
        return a1 * a2, a2 * b1 + b2

    _, h = lax.associative_scan(combine, (a, u), axis=1)
    return h.astype(x.dtype)


def parallel_mixer(h, w_in, conv_w, fgate_b, lru_conv_w, lru_conv_b, lru_w_a, lru_b_a,
                   lru_w_x, lru_b_x, lru_lambda, out_norm, w_out):
    sizes = [D_CONV] * 3 + [D_ATT] * 3 + [N_ATT_HEADS] + [D_LRU] * 2
    splits = [int(s) for s in np.cumsum(sizes)[:-1]]
    c_b, c_c, c_v, q, k, v, f_logit, lru_gate, lru_x = jnp.split(h @ w_in, splits, axis=-1)
    y_conv = c_b * causal_depthwise_conv(c_c * c_v, conv_w)
    y_att = forgetting_attention(q, k, v, f_logit, fgate_b)
    xr = causal_depthwise_conv(lru_x, lru_conv_w) + lru_conv_b
    y_lru = jax.nn.gelu(lru_gate) * rg_lru(xr, lru_w_a, lru_b_a, lru_w_x, lru_b_x, lru_lambda)
    g_c, g_a, g_l = jnp.split(out_norm, [D_CONV, D_CONV + D_ATT])
    y = jnp.concatenate([rmsnorm(y_conv, g_c), rmsnorm(y_att, g_a), rmsnorm(y_lru, g_l)], axis=-1)
    return y @ w_out


def setup_inputs(seed: int = 0) -> dict:
    key = jax.random.key(seed)
    ks = iter(jax.random.split(key, 32))
    f32 = jnp.float32
    res_scale = (2.0 * DEPTH) ** -0.5

    def normal(shape, std):
        return jax.random.normal(next(ks), shape, f32) * std

    def gain(shape):
        return 1.0 + normal(shape, 0.02)

    x = jax.random.normal(next(ks), (BATCH, SEQ, D_MODEL), f32)
    a_c = jax.random.uniform(next(ks), (DEPTH, D_LRU), f32, 0.9, 0.999)
    s = a_c ** (1.0 / LRU_C)
    lru_lambda = jnp.log(s) - jnp.log1p(-s)
    return {
        "x": x,
        "norm_ffn1": gain((DEPTH, D_MODEL)),
        "ffn1_w_in": normal((DEPTH, D_MODEL, 2 * D_FF), D_MODEL ** -0.5),
        "ffn1_w_out": normal((DEPTH, D_FF, D_MODEL), D_FF ** -0.5 * res_scale),
        "norm_mix": gain((DEPTH, D_MODEL)),
        "mix_w_in": normal((DEPTH, D_MODEL, D_IN), D_MODEL ** -0.5),
        "conv_w": normal((DEPTH, CONV_WIDTH, D_CONV), CONV_WIDTH ** -0.5),
        "fgate_b": jax.random.uniform(next(ks), (DEPTH, N_ATT_HEADS), f32, 1.0, 4.0),
        "lru_conv_w": normal((DEPTH, LRU_CONV_WIDTH, D_LRU), LRU_CONV_WIDTH ** -0.5),
        "lru_conv_b": normal((DEPTH, D_LRU), 0.02),
        "lru_w_a": normal((DEPTH, LRU_BLOCKS, LRU_BLOCK, LRU_BLOCK), LRU_BLOCK ** -0.5),
        "lru_b_a": normal((DEPTH, D_LRU), 0.02),
        "lru_w_x": normal((DEPTH, LRU_BLOCKS, LRU_BLOCK, LRU_BLOCK), LRU_BLOCK ** -0.5),
        "lru_b_x": normal((DEPTH, D_LRU), 0.02),
        "lru_lambda": lru_lambda,
        "mix_out_norm": gain((DEPTH, D_MIX)),
        "mix_w_out": normal((DEPTH, D_MIX, D_MODEL), D_MIX ** -0.5 * res_scale),
        "norm_ffn2": gain((DEPTH, D_MODEL)),
        "ffn2_w_in": normal((DEPTH, D_MODEL, 2 * D_FF), D_MODEL ** -0.5),
        "ffn2_w_out": normal((DEPTH, D_FF, D_MODEL), D_FF ** -0.5 * res_scale),
        "final_norm": gain((D_MODEL,)),
    }


def reference(x, norm_ffn1, ffn1_w_in, ffn1_w_out, norm_mix, mix_w_in, conv_w, fgate_b,
              lru_conv_w, lru_conv_b, lru_w_a, lru_b_a, lru_w_x, lru_b_x, lru_lambda,
              mix_out_norm, mix_w_out, norm_ffn2, ffn2_w_in, ffn2_w_out, final_norm):
    for l in range(DEPTH):
        x = x + 0.5 * swiglu(rmsnorm(x, norm_ffn1[l]), ffn1_w_in[l], ffn1_w_out[l])
        x = x + parallel_mixer(rmsnorm(x, norm_mix[l]), mix_w_in[l], conv_w[l], fgate_b[l],
                               lru_conv_w[l], lru_conv_b[l], lru_w_a[l], lru_b_a[l],
                               lru_w_x[l], lru_b_x[l], lru_lambda[l], mix_out_norm[l],
                               mix_w_out[l])
        x = x + 0.5 * swiglu(rmsnorm(x, norm_ffn2[l]), ffn2_w_in[l], ffn2_w_out[l])
    return rmsnorm(x, final_norm)
```

```cpp
#include <hip/hip_runtime.h>
#include <cstdio>
#include <cstdint>
namespace pg8 {
#define PG8_LAS __attribute__((address_space(3)))
typedef unsigned short bf16_t;
typedef short bf16x8 __attribute__((ext_vector_type(8)));
typedef float f32x4 __attribute__((ext_vector_type(4)));
typedef unsigned u32x4 __attribute__((ext_vector_type(4)));
constexpr int BM = 256, BK = 64, HALF = 128, HTB = HALF * BK * 2  , STAGE_BYTES = 8 * HTB, NXCD = 8, WGM = 8;

__host__ __device__ __forceinline__ int lds_byte(int r, int c) { const int st = (r >> 4) * 2 + (c >> 5), rr = r & 15, cc = c & 31, ob = rr * 64 + cc * 2; return st * 1024 + (ob ^ (((ob >> 9) & 1) << 5)); }
__host__ __device__ __forceinline__ void stage_rc(int b, int& R, int& C) { const int st = b / 1024, sb = b % 1024, swz = sb ^ (((sb >> 9) & 1) << 5); R = (st >> 1) * 16 + swz / 64; C = (st & 1) * 32 + (swz % 64) / 2; }
__host__ __device__ __forceinline__ int perm32(int rho) { const int n = rho >> 4, i = rho & 15; return 8 * (i >> 2) + 4 * n + (i & 3); }

struct Unit { int pm, pn; };
struct Gemm { const bf16_t* A; const bf16_t* Bt; int M, N, K; };

struct StaticOrder {
    int nM, nN, nwg, G, c;
    __host__ __device__ void init(int M, int N, int G_, int c_) { nM = M / BM; nN = N / BM; nwg = nM * nN; G = G_; c = c_; }
    __host__ __device__ bool next(int i, Unit& u) const {
        const long L = (long)i * G + c; if (L >= nwg) return false;
        int wgid = (int)L; { const int q = nwg / NXCD, r = nwg % NXCD, xcd = wgid % NXCD, off = wgid / NXCD; wgid = (xcd < r ? xcd * (q + 1) : r * (q + 1) + (xcd - r) * q) + off; }
        const int nig = WGM * nN, gid = wgid / nig, fm = gid * WGM, gsz = (nM - fm) < WGM ? (nM - fm) : WGM;
        u.pm = fm + ((wgid % nig) % gsz); u.pn = (wgid % nig) / gsz; return true;
    }
    __device__ __forceinline__ void a_ready(const Unit&) const {}
    __device__ __forceinline__ void done(const Unit&) const {}
};

__device__ __forceinline__ unsigned cvt_pk_bf16(float lo, float hi) { unsigned r; asm volatile("v_cvt_pk_bf16_f32 %0, %1, %2" : "=v"(r) : "v"(lo), "v"(hi)); return r; }
typedef float f32x2 __attribute__((ext_vector_type(2)));
typedef unsigned u32x2 __attribute__((ext_vector_type(2)));
__device__ __forceinline__ int otid(int wave_s) { int lane = (int)__builtin_amdgcn_mbcnt_hi(~0u, __builtin_amdgcn_mbcnt_lo(~0u, 0u)); asm volatile("" : "+v"(lane)); return wave_s * 64 + lane; }
template <int K> __device__ __forceinline__ float sx(float v) { static_assert(K > 0 && K < 32, "sx"); return __int_as_float(__builtin_amdgcn_ds_swizzle(__float_as_int(v), (K << 10) | 0x1f)); }
__device__ __forceinline__ float add32(float v) { auto rr = __builtin_amdgcn_permlane32_swap(__float_as_uint(v), __float_as_uint(v), false, false); return __uint_as_float(rr[0]) + __uint_as_float(rr[1]); }
__device__ __forceinline__ float other32(float v, int hi) { auto rr = __builtin_amdgcn_permlane32_swap(__float_as_uint(v), __float_as_uint(v), false, false); return __uint_as_float(hi ? rr[0] : rr[1]); }
__device__ __forceinline__ float log1p_small(float e) { const float u = 1.f + e, d = u - 1.f; return d == 0.f ? e : __logf(u) * (e * __builtin_amdgcn_rcpf(d)); }
struct EpiSwiGLU {
    static constexpr bool PERM = true, AFTER_DRAIN = false;
    bf16_t* O; int ldc; const PG8_LAS float* rs;
    __device__ __forceinline__ void operator()(const f32x4 (&acc)[2][2][4][2], const Unit& u, int wr, int wc, int fr, int fq) const {
        const int row0 = u.pm * BM + wr * 64 + fr, col0 = u.pn * HALF + wc * 32 + 8 * fq;
#pragma unroll
        for (int ai = 0; ai < 2; ++ai)
#pragma unroll
            for (int m = 0; m < 4; ++m) {
                const float s = rs[ai * HALF + wr * 64 + m * 16 + fr];
                float h[8];
#pragma unroll
                for (int n = 0; n < 2; ++n)
#pragma unroll
                    for (int e = 0; e < 4; ++e) { const float g = acc[ai][0][m][n][e] * s, uu = acc[ai][1][m][n][e] * s;
                        h[4 * n + e] = g * __builtin_amdgcn_rcpf(1.f + __expf(-g)) * uu; }
                u32x4 w; w.x = cvt_pk_bf16(h[0], h[1]); w.y = cvt_pk_bf16(h[2], h[3]); w.z = cvt_pk_bf16(h[4], h[5]); w.w = cvt_pk_bf16(h[6], h[7]);
                *(u32x4*)(O + (size_t)(row0 + ai * HALF + m * 16) * ldc + col0) = w; }
    }
};
struct EpiRes {
    static constexpr bool PERM = true, AFTER_DRAIN = false;
    const float* xin; float* xout; bf16_t* xb; float* ss; float alpha;
    __device__ __forceinline__ void operator()(const f32x4 (&acc)[2][2][4][2], const Unit& u, int wr, int wc, int fr, int fq) const {
        const int row0 = u.pm * BM + wr * 64 + fr, col0 = u.pn * BM + wc * 32 + 8 * fq;
#pragma unroll
        for (int ai = 0; ai < 2; ++ai)
#pragma unroll
            for (int m = 0; m < 4; ++m) {
                const int row = row0 + ai * HALF + m * 16; float sq = 0.f;
#pragma unroll
                for (int bj = 0; bj < 2; ++bj) { const size_t off = (size_t)row * 2048 + col0 + bj * HALF;
                    const f32x4 a0 = *(const f32x4*)(xin + off), a1 = *(const f32x4*)(xin + off + 4);
                    const f32x4 v0 = a0 + acc[ai][bj][m][0] * alpha, v1 = a1 + acc[ai][bj][m][1] * alpha;
                    *(f32x4*)(xout + off) = v0; *(f32x4*)(xout + off + 4) = v1;
                    u32x4 w; w.x = cvt_pk_bf16(v0[0], v0[1]); w.y = cvt_pk_bf16(v0[2], v0[3]); w.z = cvt_pk_bf16(v1[0], v1[1]); w.w = cvt_pk_bf16(v1[2], v1[3]);
                    *(u32x4*)(xb + off) = w;
                    sq += (v0[0] * v0[0] + v0[1] * v0[1]) + (v0[2] * v0[2] + v0[3] * v0[3]) + (v1[0] * v1[0] + v1[1] * v1[1]) + (v1[2] * v1[2] + v1[3] * v1[3]); }
                sq += sx<16>(sq); sq = add32(sq);
                if (fq == 0) ss[(size_t)row * 32 + u.pn * 4 + wc] = sq; }
    }
};
struct EpiMix {
    static constexpr bool PERM = true, AFTER_DRAIN = false;
    bf16_t* P; int ldc; const PG8_LAS float* rs; float* F; const float* fb;
    __device__ __forceinline__ void operator()(const f32x4 (&acc)[2][2][4][2], const Unit& u, int wr, int wc, int fr, int fq) const {
        const int row0 = u.pm * BM + wr * 64 + fr;
        if (u.pn < 22) {
            const int col0 = u.pn * BM + wc * 32 + 8 * fq;
#pragma unroll
            for (int ai = 0; ai < 2; ++ai)
#pragma unroll
                for (int m = 0; m < 4; ++m) { const float s = rs[ai * HALF + wr * 64 + m * 16 + fr]; bf16_t* rowp = P + (size_t)(row0 + ai * HALF + m * 16) * ldc + col0;
#pragma unroll
                    for (int bj = 0; bj < 2; ++bj) { const f32x4 v0 = acc[ai][bj][m][0] * s, v1 = acc[ai][bj][m][1] * s;
                        u32x4 w; w.x = cvt_pk_bf16(v0[0], v0[1]); w.y = cvt_pk_bf16(v0[2], v0[3]); w.z = cvt_pk_bf16(v1[0], v1[1]); w.w = cvt_pk_bf16(v1[2], v1[3]);
                        *(u32x4*)(rowp + bj * HALF) = w; } }
        } else if (wc == 0 && fq == 0) {
            const f32x4 b0 = *(const f32x4*)fb, b1 = *(const f32x4*)(fb + 4);
#pragma unroll
            for (int ai = 0; ai < 2; ++ai)
#pragma unroll
                for (int m = 0; m < 4; ++m) { const float s = rs[ai * HALF + wr * 64 + m * 16 + fr]; float* fp = F + (size_t)(row0 + ai * HALF + m * 16) * 8;
                    const f32x4 z0 = acc[ai][0][m][0] * s + b0, z1 = acc[ai][0][m][1] * s + b1; f32x4 l0, l1;
#pragma unroll
                    for (int e = 0; e < 4; ++e) { l0[e] = fminf(z0[e], 0.f) - log1p_small(__expf(-fabsf(z0[e]))); l1[e] = fminf(z1[e], 0.f) - log1p_small(__expf(-fabsf(z1[e]))); }
                    *(f32x4*)fp = l0; *(f32x4*)(fp + 4) = l1; }
        }
    }
};

template <class Epi, class Sched, bool ALIGN_EPI = false, bool SP2 = false>
__device__ __forceinline__ void gemm_phase(PG8_LAS unsigned char* lds, const Gemm g, const Sched& S, const Epi& E, int wave_s) {
    const int tid = otid(wave_s), wid = __builtin_amdgcn_readfirstlane(tid >> 6), lane = tid & 63, wr = wid >> 2, wc = wid & 3, fr = lane & 15, fq = lane >> 4;
    const int K = g.K, nt = K / BK;
    unsigned voffA[2], voffB[2];
#pragma unroll
    for (int i = 0; i < 2; ++i) { int R, C; stage_rc(tid * 16 + i * 8192, R, C); const int Rb = Epi::PERM ? ((R & ~31) + perm32(R & 31)) : R;
        voffA[i] = (unsigned)(R * K + C) * 2u; voffB[i] = (unsigned)(Rb * K + C) * 2u; }
    const size_t kstep = (size_t)(BK * 2);
    const size_t hstep = (size_t)HALF * K * 2;
    const size_t tstep = 2 * hstep;
    const unsigned ldsw = (unsigned)wid * 1024u;
    const int aoff = lds_byte(wr * 64 + fr, fq * 8), boff = lds_byte(wc * 32 + fr, fq * 8);
#define PG8_SA(b, h) (((b) * 2 + (h)) * HTB)
#define PG8_SB(b, h) ((4 + (b) * 2 + (h)) * HTB)
#define PG8_STAGE(bufoff, gbase, voff) do { _Pragma("unroll") for (int _i = 0; _i < 2; ++_i) \
        __builtin_amdgcn_global_load_lds((const unsigned*)((const char*)(gbase) + (voff)[_i]), (PG8_LAS unsigned*)(lds + (bufoff) + ldsw + _i * 8192), 16, 0, 0); } while (0)
#define PG8_LDA(dst, b, h) do { _Pragma("unroll") for (int m = 0; m < 4; ++m) _Pragma("unroll") for (int k = 0; k < 2; ++k) dst[m][k] = *(const PG8_LAS bf16x8*)(lds + PG8_SA(b, h) + aoff + m * 2048 + k * 1024); } while (0)
#define PG8_LDB(dst, b, h) do { _Pragma("unroll") for (int n = 0; n < 2; ++n) _Pragma("unroll") for (int k = 0; k < 2; ++k) dst[n][k] = *(const PG8_LAS bf16x8*)(lds + PG8_SB(b, h) + boff + n * 2048 + k * 1024); } while (0)
#define PG8_MMA(ai, bj, At, Bt) do { __builtin_amdgcn_s_setprio(1); _Pragma("unroll") for (int m = 0; m < 4; ++m) _Pragma("unroll") for (int n = 0; n < 2; ++n) _Pragma("unroll") for (int k = 0; k < 2; ++k) \
        acc[ai][bj][m][n] = __builtin_amdgcn_mfma_f32_16x16x32_bf16(Bt[n][k], At[m][k], acc[ai][bj][m][n], 0, 0, 0); __builtin_amdgcn_s_setprio(0); } while (0)
#define PG8_WAIT_V(n) asm volatile("s_waitcnt vmcnt(" #n ")" ::: "memory")
#define PG8_WAIT_L(n) asm volatile("s_waitcnt lgkmcnt(" #n ")" ::: "memory")
#define PG8_BAR __builtin_amdgcn_s_barrier()
#define PG8_SCHED __builtin_amdgcn_sched_barrier(0)
    Unit cur, nxt; int ui = 0;
    if (!S.next(0, cur)) return;
    f32x4 acc[2][2][4][2];
#pragma unroll
    for (int a = 0; a < 2; ++a)
#pragma unroll
        for (int b = 0; b < 2; ++b)
#pragma unroll
            for (int m = 0; m < 4; ++m)
#pragma unroll
                for (int n = 0; n < 2; ++n) acc[a][b][m][n] = (f32x4){0.f, 0.f, 0.f, 0.f};
    bf16x8 At[4][2], B0[2][2], B1[2][2];
    const char* cA = (const char*)g.A + (size_t)cur.pm * tstep; const char* cB = (const char*)g.Bt + (size_t)cur.pn * tstep;
    S.a_ready(cur);
    if constexpr (SP2) {
        PG8_STAGE(PG8_SB(0, 0), cB, voffB); PG8_STAGE(PG8_SB(0, 1), cB + hstep, voffB); PG8_STAGE(PG8_SA(0, 0), cA, voffA); PG8_STAGE(PG8_SA(0, 1), cA + hstep, voffA);
        if (wr == 1) PG8_BAR;
        PG8_WAIT_V(2); PG8_BAR;
        PG8_STAGE(PG8_SB(1, 0), cB + kstep, voffB); PG8_STAGE(PG8_SA(1, 0), cA + kstep, voffA); PG8_STAGE(PG8_SB(1, 1), cB + hstep + kstep, voffB);
        PG8_WAIT_V(6); PG8_BAR;
    } else {
        PG8_STAGE(PG8_SB(0, 0), cB, voffB); PG8_STAGE(PG8_SA(0, 0), cA, voffA); PG8_STAGE(PG8_SB(0, 1), cB + hstep, voffB); PG8_STAGE(PG8_SA(0, 1), cA + hstep, voffA);
        if (wr == 1) PG8_BAR;
        PG8_WAIT_V(4); PG8_BAR;
        PG8_STAGE(PG8_SB(1, 0), cB + kstep, voffB); PG8_STAGE(PG8_SA(1, 0), cA + kstep, voffA); PG8_STAGE(PG8_SB(1, 1), cB + hstep + kstep, voffB);
        PG8_WAIT_V(6); PG8_BAR;
    }
    for (;;) {
        const bool has_next = S.next(ui + 1, nxt);
        const char* nA = has_next ? (const char*)g.A + (size_t)nxt.pm * tstep : cA; const char* nB = has_next ? (const char*)g.Bt + (size_t)nxt.pn * tstep : cB;
        for (int t = 0; t < nt; t += 2) {
            const bool last = (t == nt - 2);
            const char* a1 = cA + (size_t)(t + 1) * kstep;
            const char* a2 = last ? nA : cA + (size_t)(t + 2) * kstep; const char* b2 = last ? nB : cB + (size_t)(t + 2) * kstep;
            const char* a3 = a2 + kstep; const char* b3 = b2 + kstep;
            if (last && has_next) S.a_ready(nxt);
            if constexpr (SP2) {
            PG8_LDB(B0, 0, 0); PG8_LDB(B1, 0, 1); PG8_SCHED; PG8_LDA(At, 0, 0); PG8_STAGE(PG8_SA(1, 1), a1 + hstep, voffA);
            PG8_WAIT_V(8); PG8_WAIT_L(0); PG8_BAR; PG8_MMA(0, 0, At, B0); PG8_MMA(0, 1, At, B1); PG8_BAR; PG8_SCHED;
            PG8_LDA(At, 0, 1); PG8_STAGE(PG8_SB(0, 0), b2, voffB); PG8_STAGE(PG8_SB(0, 1), b2 + hstep, voffB); PG8_STAGE(PG8_SA(0, 0), a2, voffA);
            PG8_WAIT_V(8); PG8_WAIT_L(0); PG8_BAR; PG8_MMA(1, 0, At, B0); PG8_MMA(1, 1, At, B1); PG8_BAR; PG8_SCHED;
            PG8_LDB(B0, 1, 0); PG8_LDB(B1, 1, 1); PG8_SCHED; PG8_LDA(At, 1, 0); PG8_STAGE(PG8_SA(0, 1), a2 + hstep, voffA);
            PG8_WAIT_V(8); PG8_WAIT_L(0); PG8_BAR; PG8_MMA(0, 0, At, B0); PG8_MMA(0, 1, At, B1); PG8_BAR; PG8_SCHED;
            PG8_LDA(At, 1, 1); PG8_STAGE(PG8_SB(1, 0), b3, voffB); PG8_STAGE(PG8_SB(1, 1), b3 + hstep, voffB); PG8_STAGE(PG8_SA(1, 0), a3, voffA);
            PG8_WAIT_V(8); PG8_WAIT_L(0); PG8_BAR; PG8_MMA(1, 0, At, B0); PG8_MMA(1, 1, At, B1); PG8_BAR; PG8_SCHED;
            } else {
            PG8_LDB(B0, 0, 0); PG8_SCHED; PG8_LDA(At, 0, 0); PG8_STAGE(PG8_SA(1, 1), a1 + hstep, voffA);
            PG8_WAIT_L(8); PG8_BAR; PG8_WAIT_L(0); PG8_MMA(0, 0, At, B0); PG8_BAR; PG8_SCHED;
            PG8_LDB(B1, 0, 1); PG8_STAGE(PG8_SB(0, 0), b2, voffB);
            PG8_BAR; PG8_WAIT_L(0); PG8_MMA(0, 1, At, B1); PG8_BAR;
            PG8_LDA(At, 0, 1); PG8_STAGE(PG8_SA(0, 0), a2, voffA);
            PG8_BAR; PG8_WAIT_L(0); PG8_MMA(1, 0, At, B0); PG8_BAR; PG8_SCHED;
            PG8_STAGE(PG8_SB(0, 1), b2 + hstep, voffB);
            PG8_WAIT_V(6); PG8_BAR; PG8_MMA(1, 1, At, B1); PG8_BAR;
            PG8_LDB(B0, 1, 0); PG8_SCHED; PG8_LDA(At, 1, 0); PG8_STAGE(PG8_SA(0, 1), a2 + hstep, voffA);
            PG8_WAIT_L(8); PG8_BAR; PG8_WAIT_L(0); PG8_MMA(0, 0, At, B0); PG8_BAR; PG8_SCHED;
            PG8_LDB(B1, 1, 1); PG8_STAGE(PG8_SB(1, 0), b3, voffB);
            PG8_BAR; PG8_WAIT_L(0); PG8_MMA(0, 1, At, B1); PG8_BAR;
            PG8_LDA(At, 1, 1); PG8_STAGE(PG8_SA(1, 0), a3, voffA);
            PG8_BAR; PG8_WAIT_L(0); PG8_MMA(1, 0, At, B0); PG8_BAR; PG8_SCHED;
            PG8_STAGE(PG8_SB(1, 1), b3 + hstep, voffB);
            PG8_WAIT_V(6); PG8_BAR; PG8_MMA(1, 1, At, B1); PG8_BAR;
            }
        }
        if constexpr (ALIGN_EPI) { if (wr == 0) PG8_BAR; }
        if constexpr (!Epi::AFTER_DRAIN) { E(acc, cur, wr, wc, fr, fq); S.done(cur); }
        if (!has_next) break;
#pragma unroll
        for (int a = 0; a < 2; ++a)
#pragma unroll
            for (int b = 0; b < 2; ++b)
#pragma unroll
                for (int m = 0; m < 4; ++m)
#pragma unroll
                    for (int n = 0; n < 2; ++n) acc[a][b][m][n] = (f32x4){0.f, 0.f, 0.f, 0.f};
        cur = nxt; cA = nA; cB = nB; ++ui;
        if constexpr (ALIGN_EPI) { if (wr == 1) PG8_BAR; }
    }
    PG8_WAIT_V(0);
    if constexpr (!ALIGN_EPI) { if (wr == 0) PG8_BAR; }
    PG8_BAR;
    if constexpr (Epi::AFTER_DRAIN) { E.fused(acc, cur, wr, wc, fr, fq, lds, wid, lane); S.done(cur); }
#undef PG8_SA
#undef PG8_SB
#undef PG8_STAGE
#undef PG8_LDA
#undef PG8_LDB
#undef PG8_MMA
#undef PG8_WAIT_V
#undef PG8_WAIT_L
#undef PG8_BAR
#undef PG8_SCHED
}
}
#ifndef ATT_SEAM
#define ATT_SEAM 0
#endif
#ifndef ATT_NOTAB
#define ATT_NOTAB 0
#endif
#ifndef ATT_NOSQ
#define ATT_NOSQ 0
#endif
namespace att {
typedef unsigned short bf16;
typedef short bf16x8 __attribute__((ext_vector_type(8)));
typedef short s16x4 __attribute__((ext_vector_type(4)));
typedef float f32x16 __attribute__((ext_vector_type(16)));
typedef float f32x4 __attribute__((ext_vector_type(4)));
typedef unsigned u32x4 __attribute__((ext_vector_type(4)));
constexpr int D = 128, NW = 8, QBLK = 32, KVBLK = 64, QB = NW * QBLK;
constexpr int PITCH = 5632, OPITCH = 1024, SEQ = 4096;
constexpr int SHM_V = KVBLK * D * 2, SHM_K = KVBLK * D * 2;
constexpr int OFF_WS = 2 * SHM_V + 2 * SHM_K, OFF_TAB = OFF_WS + NW * 64 * 4, OFF_WT = OFF_TAB + SEQ * 4, LDS_BYTES = OFF_WT + 64;
constexpr float SCALE = 0.08838834764831845f, THR = 8.f;
constexpr unsigned WBIG = 0x40000000u;

#define KSWZ(row, colB) ((row) * 256 + ((colB) ^ (((row) & 7) << 4)))
#define SBAR() __builtin_amdgcn_sched_barrier(0)
__device__ __forceinline__ int v_st(int k, int c) { const int kk = (k & ~0xC) | ((k & 4) << 1) | ((k & 8) >> 1); return ((kk >> 3) * 4 + (c >> 5)) * 512 + ((kk & 7) * 32 + (c & 31)) * 2; }
__device__ __forceinline__ int v_rd_base(int lane) { return ((lane & 3) << 3) | (((lane >> 2) & 3) << 6) | (((lane >> 4) & 1) << 5) | (((lane >> 5) & 1) << 8); }
constexpr int v_rd_off(int d0, int ks, int half) { return d0 * 512 + ks * 4096 + half * 2048; }
__device__ __forceinline__ int crow(int r, int hi) { return (r & 3) + 8 * (r >> 2) + 4 * hi; }
__device__ __forceinline__ unsigned cvtpk(float lo, float hi) { unsigned r; asm volatile("v_cvt_pk_bf16_f32 %0, %1, %2" : "=v"(r) : "v"(lo), "v"(hi)); return r; }
__device__ __forceinline__ bf16x8 load8(const bf16* p) { return *reinterpret_cast<const bf16x8*>(p); }
__device__ __forceinline__ void mask_tile(f32x16& p0, f32x16& p1, int dq) {
    const float NEG = -__builtin_inff();
#pragma unroll
    for (int r = 0; r < 16; ++r) {
        const int c = (r & 3) + 8 * (r >> 2);
        if ((unsigned)(dq - c) >= WBIG) p0[r] = NEG;
        if ((unsigned)(dq - c - 32) >= WBIG) p1[r] = NEG;
    }
}
__device__ __forceinline__ void partialSM(f32x16& p0, f32x16& p1, float& m_reg, float& mn, float& alpha) {
    float pmax = p0[0];
#pragma unroll
    for (int r = 1; r < 16; ++r) pmax = fmaxf(pmax, p0[r]);
#pragma unroll
    for (int r = 0; r < 16; ++r) pmax = fmaxf(pmax, p1[r]);
    { auto rr = __builtin_amdgcn_permlane32_swap(__float_as_uint(pmax), __float_as_uint(pmax), false, false);
      pmax = fmaxf(__uint_as_float(rr[0]), __uint_as_float(rr[1])); }
    constexpr float C2 = 1.4426950408889634f * SCALE;
    if (__builtin_expect(__all((pmax - m_reg) * SCALE <= THR), 1)) { mn = m_reg; alpha = 1.f; }
    else { mn = fmaxf(m_reg, pmax); alpha = __builtin_amdgcn_exp2f((m_reg - mn) * C2); m_reg = mn; }
    const float mnL = -mn * C2;
#pragma unroll
    for (int r = 0; r < 16; ++r) p0[r] = fmaf(p0[r], C2, mnL);
#pragma unroll
    for (int r = 0; r < 16; ++r) p1[r] = fmaf(p1[r], C2, mnL);
#pragma unroll
    for (int r = 0; r < 16; ++r) p0[r] = __builtin_amdgcn_exp2f(p0[r]);
}
__device__ __forceinline__ void finishSM(f32x16& p0, f32x16& p1, float alpha, float& l_reg, bf16x8& pa0, bf16x8& pa1, bf16x8& pa2, bf16x8& pa3) {
#pragma unroll
    for (int r = 0; r < 16; ++r) p1[r] = __builtin_amdgcn_exp2f(p1[r]);
    float ps = 0;
#pragma unroll
    for (int r = 0; r < 16; ++r) ps += p0[r];
#pragma unroll
    for (int r = 0; r < 16; ++r) ps += p1[r];
    { auto rr = __builtin_amdgcn_permlane32_swap(__float_as_uint(ps), __float_as_uint(ps), false, false);
      ps = __uint_as_float(rr[0]) + __uint_as_float(rr[1]); }
    l_reg = l_reg * alpha + ps;
#define PK4(P, B_, OUT) do { unsigned a0 = cvtpk(P[B_+0], P[B_+1]), a1 = cvtpk(P[B_+2], P[B_+3]);                          \
        unsigned b0 = cvtpk(P[B_+4], P[B_+5]), b1 = cvtpk(P[B_+6], P[B_+7]);                                             \
        auto r0 = __builtin_amdgcn_permlane32_swap(a0, b0, false, false); auto r1 = __builtin_amdgcn_permlane32_swap(a1, b1, false, false); \
        u32x4 w = {r0[0], r1[0], r0[1], r1[1]}; OUT = *reinterpret_cast<bf16x8*>(&w); } while (0)
    PK4(p0, 0, pa0); PK4(p0, 8, pa1); PK4(p1, 0, pa2); PK4(p1, 8, pa3);
#undef PK4
}
template <int KB>
__device__ __forceinline__ void qkt(f32x16& p0, f32x16& p1, const char* K_lds, int r32, int hi, const bf16x8* qr, const float* bt) {
#pragma unroll
    for (int g = 0; g < 4; ++g) {
#if ATT_NOTAB
        const f32x4 t0 = {0.f,0.f,0.f,0.f}, t1 = {0.f,0.f,0.f,0.f};
#else
        const f32x4 t0 = *reinterpret_cast<const f32x4*>(bt + 8 * g), t1 = *reinterpret_cast<const f32x4*>(bt + 32 + 8 * g);
#endif
#pragma unroll
        for (int e = 0; e < 4; ++e) { p0[4 * g + e] = t0[e]; p1[4 * g + e] = t1[e]; } }
    const char* kb[4];
#pragma unroll
    for (int dd = 0; dd < 4; ++dd) kb[dd] = K_lds + KB * SHM_K + KSWZ(r32, (dd * 16 + hi * 8) * 2);
#pragma unroll
    for (int d0 = 0; d0 < 8; ++d0) { const char* a = kb[d0 & 3] + (d0 >> 2) * 128;
        bf16x8 b0 = *reinterpret_cast<const bf16x8*>(a);
        bf16x8 b1 = *reinterpret_cast<const bf16x8*>(a + 32 * 256);
        p0 = __builtin_amdgcn_mfma_f32_32x32x16_bf16(b0, qr[d0], p0, 0, 0, 0);
        p1 = __builtin_amdgcn_mfma_f32_32x32x16_bf16(b1, qr[d0], p1, 0, 0, 0); }
}
template <int VB>
__device__ __forceinline__ void pv_tile(f32x16* o, int vb0, bf16x8 pa0, bf16x8 pa1, bf16x8 pa2, bf16x8 pa3) {
#define TRRD(dst, off) asm volatile("ds_read_b64_tr_b16 %0, %1 offset:%2" : "=&v"(dst) : "v"(vb0), "i"(off) : "memory")
#define PV_D0(d0) do { s16x4 l0, l1, l2, l3, h0, h1, h2, h3; constexpr int b_ = VB * SHM_V + v_rd_off(d0, 0, 0); \
        TRRD(l0, b_); TRRD(h0, b_ + 2048); TRRD(l1, b_ + 4096); TRRD(h1, b_ + 6144); TRRD(l2, b_ + 8192); TRRD(h2, b_ + 10240); TRRD(l3, b_ + 12288); TRRD(h3, b_ + 14336); \
        asm volatile("s_waitcnt lgkmcnt(0)" ::: "memory"); SBAR();   \
        o[d0] = __builtin_amdgcn_mfma_f32_32x32x16_bf16(pa0, (bf16x8){l0[0], l0[1], l0[2], l0[3], h0[0], h0[1], h0[2], h0[3]}, o[d0], 0, 0, 0);   \
        o[d0] = __builtin_amdgcn_mfma_f32_32x32x16_bf16(pa1, (bf16x8){l1[0], l1[1], l1[2], l1[3], h1[0], h1[1], h1[2], h1[3]}, o[d0], 0, 0, 0);   \
        o[d0] = __builtin_amdgcn_mfma_f32_32x32x16_bf16(pa2, (bf16x8){l2[0], l2[1], l2[2], l2[3], h2[0], h2[1], h2[2], h2[3]}, o[d0], 0, 0, 0);   \
        o[d0] = __builtin_amdgcn_mfma_f32_32x32x16_bf16(pa3, (bf16x8){l3[0], l3[1], l3[2], l3[3], h3[0], h3[1], h3[2], h3[3]}, o[d0], 0, 0, 0); } while (0)
    PV_D0(0); PV_D0(1); PV_D0(2); PV_D0(3);
#undef PV_D0
#undef TRRD
}
struct BlockRef { const bf16* Q; const bf16* K; const bf16* V; bf16* O; int P0; };
#define VMW() asm volatile("s_waitcnt vmcnt(0)" ::: "memory")
__device__ __forceinline__ void block(const BlockRef& cur, char* lds, int wave_s) {
    const int tid = pg8::otid(wave_s), wid = __builtin_amdgcn_readfirstlane(tid >> 6), lane = tid & 63, r32 = lane & 31, hi = lane >> 5;
    const int NT = cur.P0 / KVBLK + QB / KVBLK;
    const int qlo = cur.P0 + wid * QBLK, qm = qlo + r32 - 4 * hi;
    char* V_lds = lds; char* K_lds = lds + 2 * SHM_V;
    float* ws = (float*)(lds + OFF_WS) + wid * 64; float* li_l = ws, * al_l = ws + 32;
    const float* tab = (const float*)(lds + OFF_TAB) + 4 * hi;
    float m_reg = -1e30f, l_reg = 0; f32x16 o[4] = {};
    const int sr = tid >> 4, sc = (tid & 15) * 8, vst0 = v_st(sr, sc), vst1 = v_st(32 + sr, sc), kws = KSWZ(sr, sc * 2);
    const int vb0 = (int)(uintptr_t)V_lds + v_rd_base(lane);
    const unsigned toff = (unsigned)sr * PITCH + sc;
    const bf16* Kh = cur.K; const bf16* Vh = cur.V;
    bf16x8 qr[8], st_v0, st_v1, st_k0, st_k1;
    { const bf16* qp = cur.Q + (unsigned)(wid * QBLK + r32) * PITCH + hi * 8;
#pragma unroll
      for (int d0 = 0; d0 < 8; ++d0) qr[d0] = load8(qp + d0 * 16); }
#define SLOAD_H(t) do { const bf16* kp_ = Kh + (size_t)(t) * (KVBLK * PITCH); const bf16* vp_ = Vh + (size_t)(t) * (KVBLK * PITCH); \
        st_v0 = load8(vp_ + toff); st_v1 = load8(vp_ + 32 * PITCH + toff); st_k0 = load8(kp_ + toff); st_k1 = load8(kp_ + 32 * PITCH + toff); } while (0)
#define SWRITE_H(bf) do { *(bf16x8*)(V_lds + (bf) * SHM_V + vst0) = st_v0; *(bf16x8*)(V_lds + (bf) * SHM_V + vst1) = st_v1; \
        *(bf16x8*)(K_lds + (bf) * SHM_K + kws) = st_k0; *(bf16x8*)(K_lds + (bf) * SHM_K + kws + 32 * 256) = st_k1; } while (0)
#define RESC(a) do { if (__any((a) < 1.f)) { if (hi == 0) al_l[r32] = (a); asm volatile("s_waitcnt lgkmcnt(0)" ::: "memory");              \
                     _Pragma("unroll") for (int d_ = 0; d_ < 4; ++d_) _Pragma("unroll") for (int r = 0; r < 16; ++r) o[d_][r] *= al_l[crow(r, hi)]; } } while (0)
#define STEP(t, BF) do { f32x16 p0, p1; float mn, al; bf16x8 pa0, pa1, pa2, pa3; const int kb_ = (t) * KVBLK;                     \
        if ((t) + 1 < NT) SLOAD_H((t) + 1);                                                                                     \
        SBAR(); qkt<BF>(p0, p1, K_lds, r32, hi, qr, tab + kb_);                                                                 \
        if (kb_ + KVBLK - 1 > qlo) mask_tile(p0, p1, qm - kb_);                                                                 \
        partialSM(p0, p1, m_reg, mn, al); RESC(al); finishSM(p0, p1, al, l_reg, pa0, pa1, pa2, pa3); SBAR();                    \
        pv_tile<BF>(o, vb0, pa0, pa1, pa2, pa3); SBAR();                                                                        \
        if ((t) + 1 < NT) { VMW(); SWRITE_H(1 - (BF)); }                                                                        \
        __syncthreads(); } while (0)
    SLOAD_H(0); VMW(); SWRITE_H(0);
    __syncthreads();
    for (int t = 0; t < NT; t += 2) { STEP(t, 0); STEP(t + 1, 1); }
    if (hi == 0) li_l[r32] = l_reg; asm volatile("s_waitcnt lgkmcnt(0)" ::: "memory");
    bf16* Ow = cur.O + (size_t)(wid * QBLK) * OPITCH;
#pragma unroll
    for (int r = 0; r < 16; ++r) { const int orow = crow(r, hi); const float rl = __builtin_amdgcn_rcpf(li_l[orow]);
#pragma unroll
        for (int d0 = 0; d0 < 4; ++d0) { const float v = o[d0][r] * rl;
            const float vn = pg8::sx<1>(v);
            if ((r32 & 1) == 0) *(unsigned*)(Ow + (size_t)orow * OPITCH + d0 * 32 + r32) = cvtpk(v, vn); } }
    __syncthreads();
#undef SLOAD_H
#undef SWRITE_H
#undef RESC
#undef STEP
}
#undef VMW
__device__ __forceinline__ void fill_table(const float* Fh, char* lds, int wave_s) {
    const int tid = pg8::otid(wave_s), wid = __builtin_amdgcn_readfirstlane(tid >> 6), lane = tid & 63;
    float* tab = (float*)(lds + OFF_TAB); float* wt = (float*)(lds + OFF_WT);
    float v[8];
#pragma unroll
    for (int j = 0; j < 8; ++j) v[j] = Fh[(size_t)(tid * 8 + j) * 8];
#pragma unroll
    for (int j = 1; j < 8; ++j) v[j] += v[j - 1];
    const float tot = v[7]; float scn = tot;
#pragma unroll
    for (int o = 1; o < 64; o <<= 1) { const int src = lane >= o ? lane - o : lane; const float n = __int_as_float(__builtin_amdgcn_ds_bpermute(src << 2, __float_as_int(scn))); if (lane >= o) scn += n; }
    if (lane == 63) wt[wid] = scn;
    __syncthreads();
    float woff = 0.f;
    for (int w = 0; w < wid; ++w) woff += wt[w];
    const float base = woff + scn - tot;
#pragma unroll
    for (int j = 0; j < 8; ++j) tab[tid * 8 + j] = -(base + v[j]) * (1.f / SCALE);
    __syncthreads();
}
#undef KSWZ
#undef SBAR
}

constexpr int NWAVES = 8;
constexpr int BATCH = 4, T = 4096, D = 2048, DEPTH = 4, M = BATCH * T;
constexpr int FF = 5632, NFF = 2 * FF;
constexpr int DCONV = 512, DATT = 1024, DLRU = 512, NH = 8, HD = 128;
constexpr int DIN = 5640;
constexpr int PW = 5632;
constexpr int NMIX = 5888;
constexpr int PC_B = 0, PC_C = 512, PC_V = 1024, PC_Q = 1536, PC_K = 2560, PC_VV = 3584, PC_G = 4608, PC_X = 5120;
constexpr int LCH = 32, NCH = T / LCH;
constexpr float EPS = 1e-6f;
constexpr int N_PHASES = 2 + 8 * DEPTH;

constexpr size_t MiB = 1u << 20;
constexpr size_t WS_CTL = 0, CTL_ZERO_BYTES = 1 * MiB;
constexpr size_t SZ_W1 = (size_t)NFF * D * 2, SZ_W2 = (size_t)D * FF * 2, SZ_WM = (size_t)NMIX * D * 2, SZ_WO = (size_t)D * D * 2, SZ_WG = (size_t)2 * 4 * 128 * 128 * 2;
constexpr size_t WS_W1 = 1 * MiB;
constexpr size_t WS_W2 = WS_W1 + 2 * DEPTH * SZ_W1;
constexpr size_t WS_WM = WS_W2 + 2 * DEPTH * SZ_W2;
constexpr size_t WS_WO = WS_WM + DEPTH * SZ_WM;
constexpr size_t WS_WG = WS_WO + DEPTH * SZ_WO;
constexpr size_t WS_XB = WS_WG + DEPTH * SZ_WG;
constexpr size_t WS_HB = WS_XB + (size_t)M * D * 2;
constexpr size_t WS_P  = WS_HB + (size_t)M * FF * 2;
constexpr size_t WS_YA = WS_P + (size_t)M * PW * 2;
constexpr size_t WS_Y  = WS_YA + (size_t)M * DATT * 2;
constexpr size_t WS_F  = WS_Y + (size_t)M * D * 2;
constexpr size_t WS_SA = WS_F + (size_t)M * 8 * 4;
constexpr size_t WS_SS = WS_SA + (size_t)M * 8 * 4;
constexpr size_t WS_CS = WS_SS + (size_t)M * 32 * 4;
constexpr size_t WS_END = WS_CS + (size_t)BATCH * NCH * DLRU * 2 * 4;
static_assert(WS_W1 % 256 == 0 && WS_XB % 256 == 0 && WS_F % 256 == 0 && WS_CS % 256 == 0, "d_ws map alignment");
constexpr int CW_TMO = 0;
constexpr int CW_BAR = 4096;

constexpr int RING_OFF = 0, RING_BYTES = 131072;
constexpr int RS_OFF = RING_BYTES;
constexpr int LDSCTL_OFF = RS_OFF + 1024, MISC_OFF = LDSCTL_OFF + 320;
constexpr int LDS_BYTES = 147456;
static_assert(MISC_OFF + 128 <= LDS_BYTES, "LDS map");
constexpr int LRU_XF = 0;
constexpr int LRU_XH_PITCH = 1040;
constexpr int LRU_XH = 65536;
constexpr int LRU_SQ = LRU_XH + 32 * LRU_XH_PITCH;
static_assert(LRU_SQ + 8 * 32 * 4 <= RING_BYTES && att::LDS_BYTES <= RING_BYTES, "phase scratch inside the ring region");

#define GAS __attribute__((address_space(1)))
#define LAS __attribute__((address_space(3)))
typedef unsigned short bf16;
typedef unsigned v4u __attribute__((ext_vector_type(4)));
typedef unsigned v2u __attribute__((ext_vector_type(2)));
typedef float f32x4 __attribute__((ext_vector_type(4)));
typedef float f32x2 __attribute__((ext_vector_type(2)));
typedef float f32x16 __attribute__((ext_vector_type(16)));
typedef short bf16x8 __attribute__((ext_vector_type(8)));
typedef GAS unsigned gu32;
#define RLX_AGENT __ATOMIC_RELAXED, __HIP_MEMORY_SCOPE_AGENT
#define LDS_WAIT() asm volatile("s_waitcnt lgkmcnt(0)" ::: "memory")
#define VM_WAIT() asm volatile("s_waitcnt vmcnt(0)" ::: "memory")
__device__ __forceinline__ unsigned pk2(float lo, float hi) { return pg8::cvt_pk_bf16(lo, hi); }
__device__ __forceinline__ float bflo(unsigned w) { return __uint_as_float(w << 16); }
__device__ __forceinline__ float bfhi(unsigned w) { return __uint_as_float(w & 0xffff0000u); }
__device__ __forceinline__ float bf1(bf16 h) { return __uint_as_float((unsigned)h << 16); }
__device__ __forceinline__ float wave_sum(float v) {
    v += pg8::sx<1>(v); v += pg8::sx<2>(v); v += pg8::sx<4>(v); v += pg8::sx<8>(v); v += pg8::sx<16>(v); return pg8::add32(v);
}

#define XB_TMO      128
#define XB_XCNT(j)  (256  + 64 * (j))
#define XB_XSUB(j)  (1280 + 64 * (j))
#define XB_XGEN(j)  (2304 + 64 * (j))
#define XB_TOP      3328
#define XB_TOPGEN   3392
#define XCD_BAR_WORDS 3456
#define XB_SPIN_CAP (1u << 18)

__device__ __forceinline__ unsigned xb_ld(unsigned* p)              { return __hip_atomic_load(p, __ATOMIC_RELAXED, __HIP_MEMORY_SCOPE_AGENT); }
__device__ __forceinline__ unsigned xb_add(unsigned* p, unsigned v) { return __hip_atomic_fetch_add(p, v, __ATOMIC_RELAXED, __HIP_MEMORY_SCOPE_AGENT); }
__device__ __forceinline__ unsigned xb_xcc_id() { return (unsigned)__builtin_amdgcn_s_getreg((3 << 11) | 20) & 0xFu; }
#define XB_SPIN(cond, bar) do { unsigned _sp = 0; while (cond) { __builtin_amdgcn_s_sleep(1); \
    if ((++_sp & 255u) == 0u) { if (xb_ld(&(bar)[XB_TMO])) break; if (_sp > XB_SPIN_CAP) { atomicAdd(&(bar)[XB_TMO], 1u); break; } } } } while (0)

struct XcdBarrier {
    unsigned* bar; unsigned x; int w;
    volatile LAS unsigned* st;
};

__device__ __forceinline__ bool xb_thread0(int w) { return w == 0 && __builtin_amdgcn_mbcnt_hi(~0u, __builtin_amdgcn_mbcnt_lo(~0u, 0u)) == 0u; }
__device__ __forceinline__ XcdBarrier xcd_barrier_post(unsigned* bar, volatile LAS unsigned* st, int w) {
    XcdBarrier b; b.bar = bar; b.x = xb_xcc_id(); b.st = st; b.w = w;
    if (xb_thread0(w)) (void)xb_add(&bar[XB_XCNT(b.x)], 1u);
    return b;
}
__device__ __forceinline__ void xcd_barrier_complete(unsigned* bar, unsigned x, unsigned& nloc, unsigned& nx) {
    const unsigned G = gridDim.x * gridDim.y * gridDim.z;
    asm volatile("" : "+s"(x));
    unsigned sum, cnt, mine, sp = 0u;
    for (;;) {
        sum = 0u; cnt = 0u; mine = 0u;
#pragma unroll
        for (unsigned j = 0; j < 16; ++j) { const unsigned c = xb_ld(&bar[XB_XCNT(j)]); sum += c; cnt += (c > 0u) ? 1u : 0u; mine = (j == x) ? c : mine; }
        if (sum == G) break;
        __builtin_amdgcn_s_sleep(1);
        if ((++sp & 255u) == 0u) { if (xb_ld(&bar[XB_TMO])) break; if (sp > XB_SPIN_CAP) { atomicAdd(&bar[XB_TMO], 1u); break; } }
    }
    nloc = mine > 0u ? mine : 1u; nx = cnt > 0u ? cnt : 1u;
}

__device__ __forceinline__ void xcd_barrier(const XcdBarrier& b_in) {
    XcdBarrier b = b_in; asm volatile("" : "+s"(b.bar), "+s"(b.x));
    asm volatile("s_waitcnt vmcnt(0)" ::: "memory");
    __syncthreads();
    if (xb_thread0(b.w)) {
        unsigned* bar = b.bar;
        __builtin_amdgcn_s_waitcnt(0);
        unsigned nloc = b.st[0], nx = b.st[1];
        if (nloc == 0u) { xcd_barrier_complete(bar, b.x, nloc, nx); b.st[0] = nloc; b.st[1] = nx; }
        const unsigned old = xb_add(&bar[XB_XSUB(b.x)], 1u);
        const unsigned gen = old / nloc;
        if (old + 1u == (gen + 1u) * nloc) {
            __builtin_amdgcn_fence(__ATOMIC_RELEASE, "agent");
            asm volatile("s_waitcnt vmcnt(0)" ::: "memory");
            const unsigned og = xb_add(&bar[XB_TOP], 1u);
            const unsigned tg = og / nx;
            if (og + 1u == (tg + 1u) * nx) xb_add(&bar[XB_TOPGEN], 1u);
            else XB_SPIN(xb_ld(&bar[XB_TOPGEN]) == tg, bar);
            __builtin_amdgcn_fence(__ATOMIC_ACQUIRE, "agent");
            xb_add(&bar[XB_XGEN(b.x)], 1u);
            asm volatile("s_waitcnt vmcnt(0)" ::: "memory");
        } else {
            XB_SPIN(xb_ld(&bar[XB_XGEN(b.x)]) == gen, bar);
            __builtin_amdgcn_fence(__ATOMIC_ACQUIRE, "agent");
            asm volatile("s_waitcnt vmcnt(0)" ::: "memory");
        }
    }
    __syncthreads();
}
template <int MODE> __device__ __forceinline__ int src_col(int n) {
    if (MODE == 1) { const int pn = n >> 8, bj = (n >> 7) & 1, jj = n & 127; return bj * FF + 128 * pn + jj; }
    if (MODE == 2) { if (n < 4608) return n; if (n < 5632) return n + 8; if (n < 5640) return n - 1024; return -1; }
    return n;
}
template <int MODE>
__device__ __forceinline__ void tr_item(const float* W, int K, int Nsrc, const float* gain, bf16* WT, int nblk, LAS float* scr, int item, int lane) {
    const int kb = item / nblk, nb = item % nblk, k0 = 64 * kb, n0 = 32 * nb;
    const int sc = src_col<MODE>(n0 + (lane & 31));
#pragma unroll 8
    for (int i = 0; i < 32; ++i) { const int kk = 2 * i + (lane >> 5);
        float v = 0.f; if (sc >= 0) v = W[(size_t)(k0 + kk) * Nsrc + sc];
        if (gain) v *= gain[k0 + kk];
        scr[kk * 33 + (lane & 31)] = v; }
    LDS_WAIT(); asm volatile("" ::: "memory");
    const int c = lane & 7;
#pragma unroll
    for (int j = 0; j < 4; ++j) { const int n = (lane >> 3) + 8 * j; const LAS float* s = scr + (8 * c) * 33 + n;
        v4u o; o.x = pk2(s[0 * 33], s[1 * 33]); o.y = pk2(s[2 * 33], s[3 * 33]); o.z = pk2(s[4 * 33], s[5 * 33]); o.w = pk2(s[6 * 33], s[7 * 33]);
        *(GAS v4u*)(WT + (size_t)(n0 + n) * K + k0 + 8 * c) = o; }
    LDS_WAIT(); asm volatile("" ::: "memory");
}
template <int MODE>
__device__ __forceinline__ void tr_matrix(const float* W, int K, int Nsrc, const float* gain, bf16* WT, int Ndst, LAS float* scr, int gw, int NGW, int lane) {
    const int nblk = Ndst / 32, nitems = (K / 64) * nblk;
    for (int it = gw; it < nitems; it += NGW) tr_item<MODE>(W, K, Nsrc, gain, WT, nblk, scr, it, lane);
}

__device__ __forceinline__ void compute_rs(LAS unsigned char* lds, int pm, const float* SS, int wave_s) {
    const int tid = pg8::otid(wave_s);
    const f32x4* p = (const f32x4*)(SS + (size_t)(pm * 256 + (tid >> 1)) * 32 + (tid & 1) * 16);
    const f32x4 a = p[0], b = p[1], c = p[2], d = p[3];
    float s = ((a[0] + a[1]) + (a[2] + a[3])) + ((b[0] + b[1]) + (b[2] + b[3])) + ((c[0] + c[1]) + (c[2] + c[3])) + ((d[0] + d[1]) + (d[2] + d[3]));
    s += pg8::sx<1>(s);
    if ((tid & 1) == 0) ((LAS float*)(lds + RS_OFF))[tid >> 1] = __builtin_amdgcn_rsqf(s * (1.f / D) + EPS);
    __syncthreads();
}

__device__ __forceinline__ float sigmoidf_(float z) { return __builtin_amdgcn_rcpf(1.f + __expf(-z)); }
__device__ __forceinline__ float gelu_tanh(float x) { const float z = 0.7978845608028654f * (x + 0.044715f * x * x * x); const float t = __expf(2.f * z); return 0.5f * x * (2.f - 2.f * __builtin_amdgcn_rcpf(t + 1.f)); }
__device__ __forceinline__ bf16 f2bf(float f) { unsigned u = __float_as_uint(f); return (bf16)((u + 0x7fffu + ((u >> 16) & 1u)) >> 16); }
template <bool FINAL>
__device__ __forceinline__ void lru_unit(LAS unsigned char* lds, int b, int ck, const bf16* P, const float* cw, const float* cbias, const bf16* WG,
                                         const float* b_a, const float* b_x, const float* lam, float* CS, bf16* Y, int wave_s) {
    const int tid = pg8::otid(wave_s), wid = __builtin_amdgcn_readfirstlane(tid >> 6), lane = tid & 63, j = lane & 31, hi = lane >> 5;
    const int t0 = ck * LCH; const size_t m0 = (size_t)b * T + t0;
    LAS float* XF = (LAS float*)(lds + LRU_XF); LAS unsigned char* XH = lds + LRU_XH; LAS float* SQ = (LAS float*)(lds + LRU_SQ);
#pragma unroll
    for (int it = 0; it < 4; ++it) {
        const int idx = it * 512 + tid, tt = idx >> 6, c0 = (idx & 63) * 8;
        f32x4 a0 = *(const f32x4*)(cbias + c0), a1 = *(const f32x4*)(cbias + c0 + 4);
#pragma unroll
        for (int k = 0; k < 4; ++k) {
            if (t0 + tt - 3 + k >= 0) {
                const v4u w = *(const v4u*)(P + (m0 + tt - 3 + k) * PW + PC_X + c0);
                const f32x4 w0 = *(const f32x4*)(cw + k * DLRU + c0), w1 = *(const f32x4*)(cw + k * DLRU + c0 + 4);
                a0[0] += w0[0] * bflo(w.x); a0[1] += w0[1] * bfhi(w.x); a0[2] += w0[2] * bflo(w.y); a0[3] += w0[3] * bfhi(w.y);
                a1[0] += w1[0] * bflo(w.z); a1[1] += w1[1] * bfhi(w.z); a1[2] += w1[2] * bflo(w.w); a1[3] += w1[3] * bfhi(w.w);
            }
        }
        *(LAS f32x4*)(XF + tt * DLRU + c0) = a0; *(LAS f32x4*)(XF + tt * DLRU + c0 + 4) = a1;
        v4u hw; hw.x = pk2(a0[0], a0[1]); hw.y = pk2(a0[2], a0[3]); hw.z = pk2(a1[0], a1[1]); hw.w = pk2(a1[2], a1[3]);
        *(LAS v4u*)(XH + tt * LRU_XH_PITCH + c0 * 2) = hw;
    }
    __syncthreads();
    const int g = wid >> 1, cwv = 64 * wid;
    f32x16 acc[2][2];
#pragma unroll
    for (int ga = 0; ga < 2; ++ga)
#pragma unroll
        for (int nt = 0; nt < 2; ++nt)
#pragma unroll
            for (int r = 0; r < 16; ++r) acc[ga][nt][r] = 0.f;
#pragma unroll
    for (int ks = 0; ks < 8; ++ks) {
        const bf16x8 A = *(const LAS bf16x8*)(XH + j * LRU_XH_PITCH + (128 * g + 16 * ks + 8 * hi) * 2);
#pragma unroll
        for (int ga = 0; ga < 2; ++ga)
#pragma unroll
            for (int nt = 0; nt < 2; ++nt) {
                const bf16x8 Bf = *(const bf16x8*)(WG + ((size_t)(ga * 4 + g) * 128 + (64 * (wid & 1) + 32 * nt + j)) * 128 + 16 * ks + 8 * hi);
                acc[ga][nt] = __builtin_amdgcn_mfma_f32_32x32x16_bf16(A, Bf, acc[ga][nt], 0, 0, 0);
            }
    }
    float h0[2] = {0.f, 0.f};
    if (FINAL) {
        for (int k = 0; k < ck; ++k) {
#pragma unroll
            for (int nt = 0; nt < 2; ++nt) { const f32x2 s = *(const f32x2*)(CS + ((size_t)(b * NCH + k) * DLRU + cwv + 32 * nt + j) * 2); h0[nt] = s.x * h0[nt] + s.y; }
        }
    }
    float sq[16];
#pragma unroll
    for (int r = 0; r < 16; ++r) sq[r] = 0.f;
#pragma unroll
    for (int nt = 0; nt < 2; ++nt) {
        const int c = cwv + 32 * nt + j;
        const float ba = b_a[c], bx = b_x[c], sp = pg8::log1p_small(__expf(-lam[c]));
#pragma unroll
        for (int r = 0; r < 16; ++r) { const int tt = (r & 3) + 8 * (r >> 2) + 4 * hi;
            const float xr = XF[tt * DLRU + c];
            const float rg = sigmoidf_(acc[0][nt][r] + ba), ig = sigmoidf_(acc[1][nt][r] + bx);
            const float la = -8.f * rg * sp, a = __expf(la), x2 = 2.f * la;
            const float em = -x2 * (1.f + x2 * 0.5f * (1.f + x2 * (1.f / 3.f) * (1.f + x2 * 0.25f * (1.f + x2 * 0.2f * (1.f + x2 * (1.f / 6.f) * (1.f + x2 * (1.f / 7.f))))))), mult = __builtin_amdgcn_sqrtf(em);
            acc[0][nt][r] = a; acc[1][nt][r] = mult * (ig * xr); }
        float Ae[4], He[4], pA[4], pH[4], cin[4];
#pragma unroll
        for (int q = 0; q < 4; ++q) { float hl = 0.f, cA = 1.f;
#pragma unroll
            for (int e = 0; e < 4; ++e) { const int r = 4 * q + e; const float a = acc[0][nt][r], u = acc[1][nt][r]; hl = a * hl + u; cA *= a; acc[1][nt][r] = hl; acc[0][nt][r] = cA; }
            Ae[q] = cA; He[q] = hl; cin[q] = 0.f; }
#pragma unroll
        for (int q = 0; q < 4; ++q) { pA[q] = pg8::other32(Ae[q], hi); pH[q] = pg8::other32(He[q], hi); }
        float carry = h0[nt], Atot = 1.f;
#pragma unroll
        for (int G = 0; G < 8; ++G) { const int q = G >> 1; const bool mine = ((G & 1) == hi);
            const float Ag = mine ? Ae[q] : pA[q], Hg = mine ? He[q] : pH[q];
            cin[q] = mine ? carry : cin[q]; carry = Ag * carry + Hg; Atot *= Ag; }
        if (!FINAL) { if (hi == 0) { f32x2 s; s.x = Atot; s.y = carry; *(f32x2*)(CS + ((size_t)(b * NCH + ck) * DLRU + c) * 2) = s; } }
        else {
#pragma unroll
            for (int r = 0; r < 16; ++r) { const int tt = (r & 3) + 8 * (r >> 2) + 4 * hi;
                const float h = acc[1][nt][r] + acc[0][nt][r] * cin[r >> 2];
                const float gt = bf1(P[(m0 + tt) * PW + PC_G + c]);
                const float y = gelu_tanh(gt) * h; acc[1][nt][r] = y; sq[r] += y * y; }
        }
    }
    if (FINAL) {
#pragma unroll
        for (int r = 0; r < 16; ++r) { float s = sq[r]; s += pg8::sx<1>(s); s += pg8::sx<2>(s); s += pg8::sx<4>(s); s += pg8::sx<8>(s); s += pg8::sx<16>(s); sq[r] = s; }
        if (j == 0) {
#pragma unroll
            for (int r = 0; r < 16; ++r) SQ[wid * 32 + (r & 3) + 8 * (r >> 2) + 4 * hi] = sq[r]; }
        __syncthreads();
#pragma unroll
        for (int r = 0; r < 16; ++r) { const int tt = (r & 3) + 8 * (r >> 2) + 4 * hi; float tot = 0.f;
#pragma unroll
            for (int w = 0; w < 8; ++w) tot += SQ[w * 32 + tt];
            const float rsn = __builtin_amdgcn_rsqf(tot * (1.f / DLRU) + EPS);
#pragma unroll
            for (int nt = 0; nt < 2; ++nt) Y[(m0 + tt) * D + (DCONV + DATT) + cwv + 32 * nt + j] = f2bf(acc[1][nt][r] * rsn); }
    }
    __syncthreads();
}

__device__ __forceinline__ void token_unit(int m, int lane, const bf16* P, const bf16* YA, const float* cw, bf16* Y) {
    const int t = m & (T - 1);
    const bf16* pr = P + (size_t)m * PW + 8 * lane;
    const v4u cb = *(const v4u*)(pr + PC_B), c0 = *(const v4u*)(pr + PC_C), v0 = *(const v4u*)(pr + PC_V);
    v4u c1 = {0u, 0u, 0u, 0u}, v1 = {0u, 0u, 0u, 0u}, c2 = {0u, 0u, 0u, 0u}, v2 = {0u, 0u, 0u, 0u};
    if (t >= 1) { c1 = *(const v4u*)(pr - PW + PC_C); v1 = *(const v4u*)(pr - PW + PC_V); }
    if (t >= 2) { c2 = *(const v4u*)(pr - 2 * PW + PC_C); v2 = *(const v4u*)(pr - 2 * PW + PC_V); }
    float y[8]; float s = 0.f;
#pragma unroll
    for (int e = 0; e < 4; ++e) {
        const int ch = 8 * lane + 2 * e;
        const float z0l = bflo(c0[e]) * bflo(v0[e]), z0h = bfhi(c0[e]) * bfhi(v0[e]);
        const float z1l = bflo(c1[e]) * bflo(v1[e]), z1h = bfhi(c1[e]) * bfhi(v1[e]);
        const float z2l = bflo(c2[e]) * bflo(v2[e]), z2h = bfhi(c2[e]) * bfhi(v2[e]);
        const f32x2 w0 = *(const f32x2*)(cw + ch), w1 = *(const f32x2*)(cw + DCONV + ch), w2 = *(const f32x2*)(cw + 2 * DCONV + ch);
        y[2 * e] = bflo(cb[e]) * (w0.x * z2l + w1.x * z1l + w2.x * z0l);
        y[2 * e + 1] = bfhi(cb[e]) * (w0.y * z2h + w1.y * z1h + w2.y * z0h);
        s += y[2 * e] * y[2 * e] + y[2 * e + 1] * y[2 * e + 1];
    }
    s = wave_sum(s);
    const float rsc = __builtin_amdgcn_rsqf(s * (1.f / DCONV) + EPS);
    v4u o; o.x = pk2(y[0] * rsc, y[1] * rsc); o.y = pk2(y[2] * rsc, y[3] * rsc); o.z = pk2(y[4] * rsc, y[5] * rsc); o.w = pk2(y[6] * rsc, y[7] * rsc);
    *(v4u*)(Y + (size_t)m * D + 8 * lane) = o;
    const v4u a0 = *(const v4u*)(YA + (size_t)m * DATT + 16 * lane), a1 = *(const v4u*)(YA + (size_t)m * DATT + 16 * lane + 8);
    float tot = 0.f;
#pragma unroll
    for (int e = 0; e < 4; ++e) { const float x0 = bflo(a0[e]), x1 = bfhi(a0[e]), x2 = bflo(a1[e]), x3 = bfhi(a1[e]); tot += (x0 * x0 + x1 * x1) + (x2 * x2 + x3 * x3); }
    tot = wave_sum(tot);
    const float rsa = __builtin_amdgcn_rsqf(tot * (1.f / DATT) + EPS);
    v4u q0, q1;
#pragma unroll
    for (int e = 0; e < 4; ++e) { q0[e] = pk2(bflo(a0[e]) * rsa, bfhi(a0[e]) * rsa); q1[e] = pk2(bflo(a1[e]) * rsa, bfhi(a1[e]) * rsa); }
    *(v4u*)(Y + (size_t)m * D + DCONV + 16 * lane) = q0; *(v4u*)(Y + (size_t)m * D + DCONV + 16 * lane + 8) = q1;
}

#ifndef EN_ALL
#define EN_ALL 1
#endif
#ifndef EN_P0
#define EN_P0 EN_ALL
#endif
#ifndef EN_G1
#define EN_G1 EN_ALL
#endif
#ifndef EN_G2
#define EN_G2 EN_ALL
#endif
#ifndef EN_G3
#define EN_G3 EN_ALL
#endif
#ifndef EN_X1
#define EN_X1 EN_ALL
#endif
#ifndef EN_X2
#define EN_X2 EN_ALL
#endif
#ifndef EN_G4
#define EN_G4 EN_ALL
#endif
#ifndef EN_G5
#define EN_G5 EN_ALL
#endif
#ifndef EN_G6
#define EN_G6 EN_ALL
#endif
#ifndef EN_ATT
#define EN_ATT 1
#endif
#ifndef EN_LRU
#define EN_LRU 1
#endif
#ifndef ATT_ONESITE
#define ATT_ONESITE 1
#endif
#ifndef EN_FN
#define EN_FN EN_ALL
#endif
#ifndef MK_SINGLE
#define MK_SINGLE 1
#endif
struct Args { const float* in[21]; float* out; unsigned char* ws; int ph_lo, ph_hi; };
typedef const __attribute__((address_space(4))) Args* CArgs;
__device__ __forceinline__ CArgs oargs(CArgs p) { asm volatile("" : "+s"(p)); return p; }
template <class T> __device__ __forceinline__ T* asglobal(T* p) { return (T*)(__attribute__((address_space(1))) T*)p; }
#define WSP(T, off) ((T*)(ws + (off)))
__global__ void __launch_bounds__(NWAVES * 64, 2) hymba_fwd(Args args_unused) {
    extern __shared__ __attribute__((aligned(16))) unsigned char lds_raw[];
    LAS unsigned char* lds = (LAS unsigned char*)lds_raw;
    volatile LAS unsigned* MISC = (volatile LAS unsigned*)(lds + MISC_OFF);
    const CArgs ap = (CArgs)__builtin_amdgcn_kernarg_segment_ptr();
    const int G = gridDim.x, bid = blockIdx.x;
    const int wave_s = __builtin_amdgcn_readfirstlane(threadIdx.x >> 6);
    { const int tid = pg8::otid(wave_s); for (int u = tid; u < (LDS_BYTES - LDSCTL_OFF) / 4; u += NWAVES * 64) ((LAS unsigned*)(lds + LDSCTL_OFF))[u] = 0u; }
    __syncthreads();
#if MK_SINGLE
    constexpr int lo = 0, hi = N_PHASES;
#else
    const int lo = ap->ph_lo, hi = ap->ph_hi;
#endif
    XcdBarrier bar; bar.bar = (unsigned*)(asglobal(ap->ws) + WS_CTL) + CW_BAR; bar.x = 0; bar.st = nullptr; bar.w = wave_s;
    if (hi - lo > 1) bar = xcd_barrier_post((unsigned*)(asglobal(ap->ws) + WS_CTL) + CW_BAR, MISC + 8, wave_s);
#define IN(k) (lo <= (k) && (k) < hi)
#define SEAM(k) do { if (IN((k) + 1)) xcd_barrier(bar); } while (0)
#define PHASE_ENTRY() const CArgs a = oargs(ap); unsigned char* const ws = asglobal(a->ws); const int tid = pg8::otid(wave_s), lane = tid & 63, wave = wave_s; \
        const int gw = bid * NWAVES + wave, NGW = G * NWAVES; (void)lane; (void)gw; (void)NGW; (void)ws
    const LAS float* rs_lds = (const LAS float*)(lds + RS_OFF);

    if (EN_P0 && IN(0)) {
        PHASE_ENTRY();
        LAS float* scr = (LAS float*)(lds + RING_OFF + wave * 16384);
        for (int l = 0; l < DEPTH; ++l) {
            tr_matrix<1>(asglobal(a->in[2]) + (size_t)l * D * NFF, D, NFF, asglobal(a->in[1]) + l * D, WSP(bf16, WS_W1 + (size_t)(0 * DEPTH + l) * SZ_W1), NFF, scr, gw, NGW, lane);
            tr_matrix<1>(asglobal(a->in[18]) + (size_t)l * D * NFF, D, NFF, asglobal(a->in[17]) + l * D, WSP(bf16, WS_W1 + (size_t)(1 * DEPTH + l) * SZ_W1), NFF, scr, gw, NGW, lane);
            tr_matrix<0>(asglobal(a->in[3]) + (size_t)l * FF * D, FF, D, nullptr, WSP(bf16, WS_W2 + (size_t)(0 * DEPTH + l) * SZ_W2), D, scr, gw, NGW, lane);
            tr_matrix<0>(asglobal(a->in[19]) + (size_t)l * FF * D, FF, D, nullptr, WSP(bf16, WS_W2 + (size_t)(1 * DEPTH + l) * SZ_W2), D, scr, gw, NGW, lane);
            tr_matrix<2>(asglobal(a->in[5]) + (size_t)l * D * DIN, D, DIN, asglobal(a->in[4]) + l * D, WSP(bf16, WS_WM + (size_t)l * SZ_WM), NMIX, scr, gw, NGW, lane);
            tr_matrix<0>(asglobal(a->in[16]) + (size_t)l * D * D, D, D, asglobal(a->in[15]) + l * D, WSP(bf16, WS_WO + (size_t)l * SZ_WO), D, scr, gw, NGW, lane);
            for (int it = gw; it < 64; it += NGW) { const int mat = it >> 3, ga = mat >> 2, g = mat & 3;
                tr_item<0>((ga ? asglobal(a->in[12]) : asglobal(a->in[10])) + (size_t)(l * 4 + g) * 128 * 128, 128, 128, nullptr, WSP(bf16, WS_WG + (size_t)l * SZ_WG) + (size_t)mat * 128 * 128, 4, scr, it & 7, lane); }
        }
        const float* xin = asglobal(a->in[0]); bf16* XB = WSP(bf16, WS_XB); float* SS = WSP(float, WS_SS);
        for (int m = gw; m < M; m += NGW) {
            const GAS f32x4* xr = (const GAS f32x4*)(xin + (size_t)m * D) + lane; float s = 0.f;
            GAS v2u* o8 = (GAS v2u*)(XB + (size_t)m * D) + lane;
#pragma unroll
            for (int jj = 0; jj < 8; ++jj) { const f32x4 v = xr[64 * jj]; s += (v[0] * v[0] + v[1] * v[1]) + (v[2] * v[2] + v[3] * v[3]);
                v2u w; w.x = pk2(v[0], v[1]); w.y = pk2(v[2], v[3]); o8[64 * jj] = w; }
            s = wave_sum(s);
            if (lane < 32) SS[(size_t)m * 32 + lane] = (lane == 0) ? s : 0.f;
        }
        SEAM(0);
    }

#pragma nounroll
    for (int l = 0; l < DEPTH; ++l) {
        const int pb = 1 + 8 * l;
        if (EN_G1 && IN(pb + 0)) {
            PHASE_ENTRY();
            pg8::StaticOrder S; S.init(M, NFF, G, bid); pg8::Unit u0; u0.pm = 0; u0.pn = 0; S.next(0, u0); compute_rs(lds, u0.pm, WSP(float, WS_SS), wave_s);
            pg8::Gemm g{WSP(bf16, WS_XB), WSP(bf16, WS_W1 + (size_t)(0 * DEPTH + l) * SZ_W1), M, NFF, D}; pg8::EpiSwiGLU E{WSP(bf16, WS_HB), FF, rs_lds};
            pg8::gemm_phase<pg8::EpiSwiGLU, pg8::StaticOrder, true, true>(lds + RING_OFF, g, S, E, wave_s);
            SEAM(pb + 0);
        }
        if (EN_G2 && IN(pb + 1)) {
            PHASE_ENTRY();
            pg8::StaticOrder S; S.init(M, D, G, bid);
            pg8::Gemm g{WSP(bf16, WS_HB), WSP(bf16, WS_W2 + (size_t)(0 * DEPTH + l) * SZ_W2), M, D, FF}; pg8::EpiRes E{l == 0 ? asglobal(a->in[0]) : asglobal(a->out), asglobal(a->out), WSP(bf16, WS_XB), WSP(float, WS_SS), 0.5f};
            pg8::gemm_phase<pg8::EpiRes, pg8::StaticOrder, true, true>(lds + RING_OFF, g, S, E, wave_s);
            SEAM(pb + 1);
        }
        if (EN_G3 && IN(pb + 2)) {
            PHASE_ENTRY();
            pg8::StaticOrder S; S.init(M, NMIX, G, bid); pg8::Unit u0; u0.pm = 0; u0.pn = 0; S.next(0, u0); compute_rs(lds, u0.pm, WSP(float, WS_SS), wave_s);
            pg8::Gemm g{WSP(bf16, WS_XB), WSP(bf16, WS_WM + (size_t)l * SZ_WM), M, NMIX, D}; pg8::EpiMix E{WSP(bf16, WS_P), PW, rs_lds, WSP(float, WS_F), asglobal(a->in[7]) + l * NH};
            pg8::gemm_phase<pg8::EpiMix, pg8::StaticOrder, true, true>(lds + RING_OFF, g, S, E, wave_s);
            SEAM(pb + 2);
        }
        if (EN_X1 && IN(pb + 3)) {
            PHASE_ENTRY();
            const bf16* P = WSP(bf16, WS_P);
            if (EN_ATT) for (int L = bid; L < 256; L += G) {
                const int bh = (L & 7) + 8 * (L >> 6), xq = (L >> 3) & 7, b = bh >> 3, h = bh & 7;
                att::fill_table(WSP(float, WS_F) + (size_t)b * T * 8 + h, (char*)lds_raw + RING_OFF, wave_s);
                const bf16* Pb = P + (size_t)b * T * PW + h * HD;
#pragma nounroll
                for (int pass = 0; pass < 2; ++pass) {
                    att::BlockRef r; r.P0 = (pass ? 15 - xq : xq) * 256;
                    r.K = Pb + PC_K; r.V = Pb + PC_VV; r.Q = Pb + PC_Q + (size_t)r.P0 * PW;
                    r.O = WSP(bf16, WS_YA) + ((size_t)b * T + r.P0) * DATT + h * HD;
                    att::block(r, (char*)lds_raw + RING_OFF, wave_s);
                }
                VM_WAIT(); __syncthreads();
            }
            if (EN_LRU) for (int u = bid; u < BATCH * NCH; u += G)
                lru_unit<false>(lds + RING_OFF, u / NCH, u % NCH, P, asglobal(a->in[8]) + l * 4 * DLRU, asglobal(a->in[9]) + l * DLRU, WSP(bf16, WS_WG + (size_t)l * SZ_WG), asglobal(a->in[11]) + l * DLRU, asglobal(a->in[13]) + l * DLRU, asglobal(a->in[14]) + l * DLRU, WSP(float, WS_CS), WSP(bf16, WS_Y), wave_s);
            SEAM(pb + 3);
        }
        if (EN_X2 && IN(pb + 4)) {
            PHASE_ENTRY();
            const bf16* P = WSP(bf16, WS_P);
            for (int u = bid; u < BATCH * NCH; u += G)
                lru_unit<true>(lds + RING_OFF, u / NCH, u % NCH, P, asglobal(a->in[8]) + l * 4 * DLRU, asglobal(a->in[9]) + l * DLRU, WSP(bf16, WS_WG + (size_t)l * SZ_WG), asglobal(a->in[11]) + l * DLRU, asglobal(a->in[13]) + l * DLRU, asglobal(a->in[14]) + l * DLRU, WSP(float, WS_CS), WSP(bf16, WS_Y), wave_s);
            for (int m = gw; m < M; m += NGW) token_unit(m, lane, P, WSP(bf16, WS_YA), asglobal(a->in[6]) + l * 3 * DCONV, WSP(bf16, WS_Y));
            SEAM(pb + 4);
        }
        if (EN_G4 && IN(pb + 5)) {
            PHASE_ENTRY();
            pg8::StaticOrder S; S.init(M, D, G, bid);
            pg8::Gemm g{WSP(bf16, WS_Y), WSP(bf16, WS_WO + (size_t)l * SZ_WO), M, D, D}; pg8::EpiRes E{asglobal(a->out), asglobal(a->out), WSP(bf16, WS_XB), WSP(float, WS_SS), 1.0f};
            pg8::gemm_phase<pg8::EpiRes, pg8::StaticOrder, true, true>(lds + RING_OFF, g, S, E, wave_s);
            SEAM(pb + 5);
        }
        if (EN_G5 && IN(pb + 6)) {
            PHASE_ENTRY();
            pg8::StaticOrder S; S.init(M, NFF, G, bid); pg8::Unit u0; u0.pm = 0; u0.pn = 0; S.next(0, u0); compute_rs(lds, u0.pm, WSP(float, WS_SS), wave_s);
            pg8::Gemm g{WSP(bf16, WS_XB), WSP(bf16, WS_W1 + (size_t)(1 * DEPTH + l) * SZ_W1), M, NFF, D}; pg8::EpiSwiGLU E{WSP(bf16, WS_HB), FF, rs_lds};
            pg8::gemm_phase<pg8::EpiSwiGLU, pg8::StaticOrder, true, true>(lds + RING_OFF, g, S, E, wave_s);
            SEAM(pb + 6);
        }
        if (EN_G6 && IN(pb + 7)) {
            PHASE_ENTRY();
            pg8::StaticOrder S; S.init(M, D, G, bid);
            pg8::Gemm g{WSP(bf16, WS_HB), WSP(bf16, WS_W2 + (size_t)(1 * DEPTH + l) * SZ_W2), M, D, FF}; pg8::EpiRes E{asglobal(a->out), asglobal(a->out), WSP(bf16, WS_XB), WSP(float, WS_SS), 0.5f};
            pg8::gemm_phase<pg8::EpiRes, pg8::StaticOrder, true, true>(lds + RING_OFF, g, S, E, wave_s);
            SEAM(pb + 7);
        }
    }
    if (EN_FN && IN(N_PHASES - 1)) {
        PHASE_ENTRY();
        const float* gfin = asglobal(a->in[20]); float* X = asglobal(a->out); const float* SS = WSP(float, WS_SS);
        for (int m = gw; m < M; m += NGW) {
            float s = lane < 32 ? SS[(size_t)m * 32 + lane] : 0.f; s = wave_sum(s);
            const float rsn = __builtin_amdgcn_rsqf(s * (1.f / D) + EPS);
            GAS f32x4* xr = (GAS f32x4*)(X + (size_t)m * D) + lane; const GAS f32x4* gr = (const GAS f32x4*)gfin + lane;
#pragma unroll
            for (int jj = 0; jj < 8; ++jj) { const f32x4 v = xr[64 * jj], gg = gr[64 * jj]; xr[64 * jj] = v * rsn * gg; }
        }
    }
#undef IN
#undef SEAM
#undef PHASE_ENTRY
}

extern "C" void kernel_launch(void* const* d_in, const int* in_sizes, int n_in, void* d_out, int out_size, void* d_ws, size_t ws_size, hipStream_t stream) {
    static int grid = 0;
    if (grid == 0) {
        if (n_in != 21 || in_sizes[0] != M * D || out_size != M * D || ws_size < WS_END) {
            fprintf(stderr, "kernel_launch: built for 21 inputs, x/out of %d floats, >= %zu bytes of workspace; got n_in %d, in0 %d, out %d, ws %zu; nothing launched\n", M * D, (size_t)WS_END, n_in, n_in > 0 ? in_sizes[0] : -1, out_size, ws_size);
            grid = -1; return; }
        int dev = 0, cus = 0, per_cu = 0;
        if (hipGetDevice(&dev) != hipSuccess || hipDeviceGetAttribute(&cus, hipDeviceAttributeMultiprocessorCount, dev) != hipSuccess) { fprintf(stderr, "kernel_launch: device query failed\n"); grid = -1; return; }
        if (hipFuncSetAttribute((const void*)hymba_fwd, hipFuncAttributeMaxDynamicSharedMemorySize, LDS_BYTES) != hipSuccess) { fprintf(stderr, "kernel_launch: hipFuncSetAttribute failed\n"); grid = -1; return; }
        if (hipOccupancyMaxActiveBlocksPerMultiprocessor(&per_cu, (const void*)hymba_fwd, NWAVES * 64, LDS_BYTES) != hipSuccess || per_cu < 1)
            fprintf(stderr, "kernel_launch: note: occupancy query reports %d workgroups per CU\n", per_cu);
        (void)hipGetLastError();
        grid = cus;
        if (grid != 256) fprintf(stderr, "kernel_launch: %d CUs; the row-scale tables assume a 256-workgroup grid\n", grid);
        const int Ns[3] = {NFF, D, NMIX};
        for (int k = 0; k < 3; ++k) for (int c = 0; c < grid; ++c) { pg8::StaticOrder S; S.init(M, Ns[k], grid, c); pg8::Unit u0, u; if (!S.next(0, u0)) continue;
            for (int i = 1; S.next(i, u); ++i) if (u.pm != u0.pm) { fprintf(stderr, "kernel_launch: unit order gives workgroup %d two row panels (N %d)\n", c, Ns[k]); grid = -1; return; } }
    }
    if (grid < 0) return;
    if (hipMemsetAsync((char*)d_ws + WS_CTL, 0, CTL_ZERO_BYTES, stream) != hipSuccess) { fprintf(stderr, "kernel_launch: hipMemsetAsync failed\n"); return; }
    Args a{};
    for (int i = 0; i < 21; ++i) a.in[i] = (const float*)d_in[i];
    a.out = (float*)d_out; a.ws = (unsigned char*)d_ws;
#if MK_SINGLE
    a.ph_lo = 0; a.ph_hi = N_PHASES;
    hipLaunchKernelGGL(hymba_fwd, dim3(grid), dim3(NWAVES * 64), LDS_BYTES, stream, a);
#else
    for (int p = 0; p < N_PHASES; ++p) { a.ph_lo = p; a.ph_hi = p + 1; hipLaunchKernelGGL(hymba_fwd, dim3(grid), dim3(NWAVES * 64), LDS_BYTES, stream, a); }
#endif
    const hipError_t le = hipPeekAtLastError();
    if (le != hipSuccess) fprintf(stderr, "kernel_launch: launch failed: %s\n", hipGetErrorName(le));
}
```

```cpp
#include <hip/hip_runtime.h>
#include <cstdio>
#include <cstdint>
namespace pg8 {
#define PG8_LAS __attribute__((address_space(3)))
typedef unsigned short bf16_t;
typedef short bf16x8 __attribute__((ext_vector_type(8)));
typedef float f32x4 __attribute__((ext_vector_type(4)));
typedef unsigned u32x4 __attribute__((ext_vector_type(4)));
constexpr int BM = 256, BK = 64, HALF = 128, HTB = HALF * BK * 2  , STAGE_BYTES = 8 * HTB, NXCD = 8, WGM = 8;

__host__ __device__ __forceinline__ int lds_byte(int r, int c) { const int st = (r >> 4) * 2 + (c >> 5), rr = r & 15, cc = c & 31, ob = rr * 64 + cc * 2; return st * 1024 + (ob ^ (((ob >> 9) & 1) << 5)); }
__host__ __device__ __forceinline__ void stage_rc(int b, int& R, int& C) { const int st = b / 1024, sb = b % 1024, swz = sb ^ (((sb >> 9) & 1) << 5); R = (st >> 1) * 16 + swz / 64; C = (st & 1) * 32 + (swz % 64) / 2; }
__host__ __device__ __forceinline__ int perm32(int rho) { const int n = rho >> 4, i = rho & 15; return 8 * (i >> 2) + 4 * n + (i & 3); }

struct Unit { int pm, pn; };
struct Gemm { const bf16_t* A; const bf16_t* Bt; int M, N, K; };

struct StaticOrder {
    int nM, nN, nwg, G, c;
    __host__ __device__ void init(int M, int N, int G_, int c_) { nM = M / BM; nN = N / BM; nwg = nM * nN; G = G_; c = c_; }
    __host__ __device__ bool next(int i, Unit& u) const {
        const long L = (long)i * G + c; if (L >= nwg) return false;
        int wgid = (int)L; { const int q = nwg / NXCD, r = nwg % NXCD, xcd = wgid % NXCD, off = wgid / NXCD; wgid = (xcd < r ? xcd * (q + 1) : r * (q + 1) + (xcd - r) * q) + off; }
        const int nig = WGM * nN, gid = wgid / nig, fm = gid * WGM, gsz = (nM - fm) < WGM ? (nM - fm) : WGM;
        u.pm = fm + ((wgid % nig) % gsz); u.pn = (wgid % nig) / gsz; return true;
    }
    __device__ __forceinline__ void a_ready(const Unit&) const {}
    __device__ __forceinline__ void done(const Unit&) const {}
};

__device__ __forceinline__ unsigned cvt_pk_bf16(float lo, float hi) { unsigned r; asm volatile("v_cvt_pk_bf16_f32 %0, %1, %2" : "=v"(r) : "v"(lo), "v"(hi)); return r; }
typedef float f32x2 __attribute__((ext_vector_type(2)));
typedef unsigned u32x2 __attribute__((ext_vector_type(2)));
__device__ __forceinline__ int otid(int wave_s) { int lane = (int)__builtin_amdgcn_mbcnt_hi(~0u, __builtin_amdgcn_mbcnt_lo(~0u, 0u)); asm volatile("" : "+v"(lane)); return wave_s * 64 + lane; }
template <int K> __device__ __forceinline__ float sx(float v) { static_assert(K > 0 && K < 32, "sx"); return __int_as_float(__builtin_amdgcn_ds_swizzle(__float_as_int(v), (K << 10) | 0x1f)); }
__device__ __forceinline__ float add32(float v) { auto rr = __builtin_amdgcn_permlane32_swap(__float_as_uint(v), __float_as_uint(v), false, false); return __uint_as_float(rr[0]) + __uint_as_float(rr[1]); }
__device__ __forceinline__ float other32(float v, int hi) { auto rr = __builtin_amdgcn_permlane32_swap(__float_as_uint(v), __float_as_uint(v), false, false); return __uint_as_float(hi ? rr[0] : rr[1]); }
__device__ __forceinline__ float log1p_small(float e) { const float u = 1.f + e, d = u - 1.f; return d == 0.f ? e : __logf(u) * (e * __builtin_amdgcn_rcpf(d)); }
struct EpiSwiGLU {
    static constexpr bool PERM = true, AFTER_DRAIN = false;
    bf16_t* O; int ldc; const PG8_LAS float* rs;
    __device__ __forceinline__ void operator()(const f32x4 (&acc)[2][2][4][2], const Unit& u, int wr, int wc, int fr, int fq) const {
        const int row0 = u.pm * BM + wr * 64 + fr, col0 = u.pn * HALF + wc * 32 + 8 * fq;
#pragma unroll
        for (int ai = 0; ai < 2; ++ai)
#pragma unroll
            for (int m = 0; m < 4; ++m) {
                const float s = rs[ai * HALF + wr * 64 + m * 16 + fr];
                float h[8];
#pragma unroll
                for (int n = 0; n < 2; ++n)
#pragma unroll
                    for (int e = 0; e < 4; ++e) { const float g = acc[ai][0][m][n][e] * s, uu = acc[ai][1][m][n][e] * s;
                        h[4 * n + e] = g * __builtin_amdgcn_rcpf(1.f + __expf(-g)) * uu; }
                u32x4 w; w.x = cvt_pk_bf16(h[0], h[1]); w.y = cvt_pk_bf16(h[2], h[3]); w.z = cvt_pk_bf16(h[4], h[5]); w.w = cvt_pk_bf16(h[6], h[7]);
                *(u32x4*)(O + (size_t)(row0 + ai * HALF + m * 16) * ldc + col0) = w; }
    }
};
struct EpiRes {
    static constexpr bool PERM = true, AFTER_DRAIN = false;
    const float* xin; float* xout; bf16_t* xb; float* ss; float alpha;
    __device__ __forceinline__ void operator()(const f32x4 (&acc)[2][2][4][2], const Unit& u, int wr, int wc, int fr, int fq) const {
        const int row0 = u.pm * BM + wr * 64 + fr, col0 = u.pn * BM + wc * 32 + 8 * fq;
#pragma unroll
        for (int ai = 0; ai < 2; ++ai)
#pragma unroll
            for (int m = 0; m < 4; ++m) {
                const int row = row0 + ai * HALF + m * 16; float sq = 0.f;
#pragma unroll
                for (int bj = 0; bj < 2; ++bj) { const size_t off = (size_t)row * 2048 + col0 + bj * HALF;
                    const f32x4 a0 = *(const f32x4*)(xin + off), a1 = *(const f32x4*)(xin + off + 4);
                    const f32x4 v0 = a0 + acc[ai][bj][m][0] * alpha, v1 = a1 + acc[ai][bj][m][1] * alpha;
                    *(f32x4*)(xout + off) = v0; *(f32x4*)(xout + off + 4) = v1;
                    u32x4 w; w.x = cvt_pk_bf16(v0[0], v0[1]); w.y = cvt_pk_bf16(v0[2], v0[3]); w.z = cvt_pk_bf16(v1[0], v1[1]); w.w = cvt_pk_bf16(v1[2], v1[3]);
                    *(u32x4*)(xb + off) = w;
                    sq += (v0[0] * v0[0] + v0[1] * v0[1]) + (v0[2] * v0[2] + v0[3] * v0[3]) + (v1[0] * v1[0] + v1[1] * v1[1]) + (v1[2] * v1[2] + v1[3] * v1[3]); }
                sq += sx<16>(sq); sq = add32(sq);
                if (fq == 0) ss[(size_t)row * 32 + u.pn * 4 + wc] = sq; }
    }
};
struct EpiMix {
    static constexpr bool PERM = true, AFTER_DRAIN = false;
    bf16_t* P; int ldc; const PG8_LAS float* rs; float* F; const float* fb;
    __device__ __forceinline__ void operator()(const f32x4 (&acc)[2][2][4][2], const Unit& u, int wr, int wc, int fr, int fq) const {
        const int row0 = u.pm * BM + wr * 64 + fr;
        if (u.pn < 22) {
            const int col0 = u.pn * BM + wc * 32 + 8 * fq;
#pragma unroll
            for (int ai = 0; ai < 2; ++ai)
#pragma unroll
                for (int m = 0; m < 4; ++m) { const float s = rs[ai * HALF + wr * 64 + m * 16 + fr]; bf16_t* rowp = P + (size_t)(row0 + ai * HALF + m * 16) * ldc + col0;
#pragma unroll
                    for (int bj = 0; bj < 2; ++bj) { const f32x4 v0 = acc[ai][bj][m][0] * s, v1 = acc[ai][bj][m][1] * s;
                        u32x4 w; w.x = cvt_pk_bf16(v0[0], v0[1]); w.y = cvt_pk_bf16(v0[2], v0[3]); w.z = cvt_pk_bf16(v1[0], v1[1]); w.w = cvt_pk_bf16(v1[2], v1[3]);
                        *(u32x4*)(rowp + bj * HALF) = w; } }
        } else if (wc == 0 && fq == 0) {
            const f32x4 b0 = *(const f32x4*)fb, b1 = *(const f32x4*)(fb + 4);
#pragma unroll
            for (int ai = 0; ai < 2; ++ai)
#pragma unroll
                for (int m = 0; m < 4; ++m) { const float s = rs[ai * HALF + wr * 64 + m * 16 + fr]; float* fp = F + (size_t)(row0 + ai * HALF + m * 16) * 8;
                    const f32x4 z0 = acc[ai][0][m][0] * s + b0, z1 = acc[ai][0][m][1] * s + b1; f32x4 l0, l1;
#pragma unroll
                    for (int e = 0; e < 4; ++e) { l0[e] = fminf(z0[e], 0.f) - log1p_small(__expf(-fabsf(z0[e]))); l1[e] = fminf(z1[e], 0.f) - log1p_small(__expf(-fabsf(z1[e]))); }
                    *(f32x4*)fp = l0; *(f32x4*)(fp + 4) = l1; }
        }
    }
};

template <class Epi, class Sched, bool ALIGN_EPI = false, bool SP2 = false>
__device__ __forceinline__ void gemm_phase(PG8_LAS unsigned char* lds, const Gemm g, const Sched& S, const Epi& E, int wave_s) {
    const int tid = otid(wave_s), wid = __builtin_amdgcn_readfirstlane(tid >> 6), lane = tid & 63, wr = wid >> 2, wc = wid & 3, fr = lane & 15, fq = lane >> 4;
    const int K = g.K, nt = K / BK;
    unsigned voffA[2], voffB[2];
#pragma unroll
    for (int i = 0; i < 2; ++i) { int R, C; stage_rc(tid * 16 + i * 8192, R, C); const int Rb = Epi::PERM ? ((R & ~31) + perm32(R & 31)) : R;
        voffA[i] = (unsigned)(R * K + C) * 2u; voffB[i] = (unsigned)(Rb * K + C) * 2u; }
    const size_t kstep = (size_t)(BK * 2);
    const size_t hstep = (size_t)HALF * K * 2;
    const size_t tstep = 2 * hstep;
    const unsigned ldsw = (unsigned)wid * 1024u;
    const int aoff = lds_byte(wr * 64 + fr, fq * 8), boff = lds_byte(wc * 32 + fr, fq * 8);
#define PG8_SA(b, h) (((b) * 2 + (h)) * HTB)
#define PG8_SB(b, h) ((4 + (b) * 2 + (h)) * HTB)
#define PG8_STAGE(bufoff, gbase, voff) do { _Pragma("unroll") for (int _i = 0; _i < 2; ++_i) \
        __builtin_amdgcn_global_load_lds((const unsigned*)((const char*)(gbase) + (voff)[_i]), (PG8_LAS unsigned*)(lds + (bufoff) + ldsw + _i * 8192), 16, 0, 0); } while (0)
#define PG8_LDA(dst, b, h) do { _Pragma("unroll") for (int m = 0; m < 4; ++m) _Pragma("unroll") for (int k = 0; k < 2; ++k) dst[m][k] = *(const PG8_LAS bf16x8*)(lds + PG8_SA(b, h) + aoff + m * 2048 + k * 1024); } while (0)
#define PG8_LDB(dst, b, h) do { _Pragma("unroll") for (int n = 0; n < 2; ++n) _Pragma("unroll") for (int k = 0; k < 2; ++k) dst[n][k] = *(const PG8_LAS bf16x8*)(lds + PG8_SB(b, h) + boff + n * 2048 + k * 1024); } while (0)
#define PG8_MMA(ai, bj, At, Bt) do { __builtin_amdgcn_s_setprio(1); _Pragma("unroll") for (int m = 0; m < 4; ++m) _Pragma("unroll") for (int n = 0; n < 2; ++n) _Pragma("unroll") for (int k = 0; k < 2; ++k) \
        acc[ai][bj][m][n] = __builtin_amdgcn_mfma_f32_16x16x32_bf16(Bt[n][k], At[m][k], acc[ai][bj][m][n], 0, 0, 0); __builtin_amdgcn_s_setprio(0); } while (0)
#define PG8_WAIT_V(n) asm volatile("s_waitcnt vmcnt(" #n ")" ::: "memory")
#define PG8_WAIT_L(n) asm volatile("s_waitcnt lgkmcnt(" #n ")" ::: "memory")
#define PG8_BAR __builtin_amdgcn_s_barrier()
#define PG8_SCHED __builtin_amdgcn_sched_barrier(0)
    Unit cur, nxt; int ui = 0;
    if (!S.next(0, cur)) return;
    f32x4 acc[2][2][4][2];
#pragma unroll
    for (int a = 0; a < 2; ++a)
#pragma unroll
        for (int b = 0; b < 2; ++b)
#pragma unroll
            for (int m = 0; m < 4; ++m)
#pragma unroll
                for (int n = 0; n < 2; ++n) acc[a][b][m][n] = (f32x4){0.f, 0.f, 0.f, 0.f};
    bf16x8 At[4][2], B0[2][2], B1[2][2];
    const char* cA = (const char*)g.A + (size_t)cur.pm * tstep; const char* cB = (const char*)g.Bt + (size_t)cur.pn * tstep;
    S.a_ready(cur);
    if constexpr (SP2) {
        PG8_STAGE(PG8_SB(0, 0), cB, voffB); PG8_STAGE(PG8_SB(0, 1), cB + hstep, voffB); PG8_STAGE(PG8_SA(0, 0), cA, voffA); PG8_STAGE(PG8_SA(0, 1), cA + hstep, voffA);
        if (wr == 1) PG8_BAR;
        PG8_WAIT_V(2); PG8_BAR;
        PG8_STAGE(PG8_SB(1, 0), cB + kstep, voffB); PG8_STAGE(PG8_SA(1, 0), cA + kstep, voffA); PG8_STAGE(PG8_SB(1, 1), cB + hstep + kstep, voffB);
        PG8_WAIT_V(6); PG8_BAR;
    } else {
        PG8_STAGE(PG8_SB(0, 0), cB, voffB); PG8_STAGE(PG8_SA(0, 0), cA, voffA); PG8_STAGE(PG8_SB(0, 1), cB + hstep, voffB); PG8_STAGE(PG8_SA(0, 1), cA + hstep, voffA);
        if (wr == 1) PG8_BAR;
        PG8_WAIT_V(4); PG8_BAR;
        PG8_STAGE(PG8_SB(1, 0), cB + kstep, voffB); PG8_STAGE(PG8_SA(1, 0), cA + kstep, voffA); PG8_STAGE(PG8_SB(1, 1), cB + hstep + kstep, voffB);
        PG8_WAIT_V(6); PG8_BAR;
    }
    for (;;) {
        const bool has_next = S.next(ui + 1, nxt);
        const char* nA = has_next ? (const char*)g.A + (size_t)nxt.pm * tstep : cA; const char* nB = has_next ? (const char*)g.Bt + (size_t)nxt.pn * tstep : cB;
        for (int t = 0; t < nt; t += 2) {
            const bool last = (t == nt - 2);
            const char* a1 = cA + (size_t)(t + 1) * kstep;
            const char* a2 = last ? nA : cA + (size_t)(t + 2) * kstep; const char* b2 = last ? nB : cB + (size_t)(t + 2) * kstep;
            const char* a3 = a2 + kstep; const char* b3 = b2 + kstep;
            if (last && has_next) S.a_ready(nxt);
            if constexpr (SP2) {
            PG8_LDB(B0, 0, 0); PG8_LDB(B1, 0, 1); PG8_SCHED; PG8_LDA(At, 0, 0); PG8_STAGE(PG8_SA(1, 1), a1 + hstep, voffA);
            PG8_WAIT_V(8); PG8_WAIT_L(0); PG8_BAR; PG8_MMA(0, 0, At, B0); PG8_MMA(0, 1, At, B1); PG8_BAR; PG8_SCHED;
            PG8_LDA(At, 0, 1); PG8_STAGE(PG8_SB(0, 0), b2, voffB); PG8_STAGE(PG8_SB(0, 1), b2 + hstep, voffB); PG8_STAGE(PG8_SA(0, 0), a2, voffA);
            PG8_WAIT_V(8); PG8_WAIT_L(0); PG8_BAR; PG8_MMA(1, 0, At, B0); PG8_MMA(1, 1, At, B1); PG8_BAR; PG8_SCHED;
            PG8_LDB(B0, 1, 0); PG8_LDB(B1, 1, 1); PG8_SCHED; PG8_LDA(At, 1, 0); PG8_STAGE(PG8_SA(0, 1), a2 + hstep, voffA);
            PG8_WAIT_V(8); PG8_WAIT_L(0); PG8_BAR; PG8_MMA(0, 0, At, B0); PG8_MMA(0, 1, At, B1); PG8_BAR; PG8_SCHED;
            PG8_LDA(At, 1, 1); PG8_STAGE(PG8_SB(1, 0), b3, voffB); PG8_STAGE(PG8_SB(1, 1), b3 + hstep, voffB); PG8_STAGE(PG8_SA(1, 0), a3, voffA);
            PG8_WAIT_V(8); PG8_WAIT_L(0); PG8_BAR; PG8_MMA(1, 0, At, B0); PG8_MMA(1, 1, At, B1); PG8_BAR; PG8_SCHED;
            } else {
            PG8_LDB(B0, 0, 0); PG8_SCHED; PG8_LDA(At, 0, 0); PG8_STAGE(PG8_SA(1, 1), a1 + hstep, voffA);
            PG8_WAIT_L(8); PG8_BAR; PG8_WAIT_L(0); PG8_MMA(0, 0, At, B0); PG8_BAR; PG8_SCHED;
            PG8_LDB(B1, 0, 1); PG8_STAGE(PG8_SB(0, 0), b2, voffB);
            PG8_BAR; PG8_WAIT_L(0); PG8_MMA(0, 1, At, B1); PG8_BAR;
            PG8_LDA(At, 0, 1); PG8_STAGE(PG8_SA(0, 0), a2, voffA);
            PG8_BAR; PG8_WAIT_L(0); PG8_MMA(1, 0, At, B0); PG8_BAR; PG8_SCHED;
            PG8_STAGE(PG8_SB(0, 1), b2 + hstep, voffB);
            PG8_WAIT_V(6); PG8_BAR; PG8_MMA(1, 1, At, B1); PG8_BAR;
            PG8_LDB(B0, 1, 0); PG8_SCHED; PG8_LDA(At, 1, 0); PG8_STAGE(PG8_SA(0, 1), a2 + hstep, voffA);
            PG8_WAIT_L(8); PG8_BAR; PG8_WAIT_L(0); PG8_MMA(0, 0, At, B0); PG8_BAR; PG8_SCHED;
            PG8_LDB(B1, 1, 1); PG8_STAGE(PG8_SB(1, 0), b3, voffB);
            PG8_BAR; PG8_WAIT_L(0); PG8_MMA(0, 1, At, B1); PG8_BAR;
            PG8_LDA(At, 1, 1); PG8_STAGE(PG8_SA(1, 0), a3, voffA);
            PG8_BAR; PG8_WAIT_L(0); PG8_MMA(1, 0, At, B0); PG8_BAR; PG8_SCHED;
            PG8_STAGE(PG8_SB(1, 1), b3 + hstep, voffB);
            PG8_WAIT_V(6); PG8_BAR; PG8_MMA(1, 1, At, B1); PG8_BAR;
            }
        }
        if constexpr (ALIGN_EPI) { if (wr == 0) PG8_BAR; }
        if constexpr (!Epi::AFTER_DRAIN) { E(acc, cur, wr, wc, fr, fq); S.done(cur); }
        if (!has_next) break;
#pragma unroll
        for (int a = 0; a < 2; ++a)
#pragma unroll
            for (int b = 0; b < 2; ++b)
#pragma unroll
                for (int m = 0; m < 4; ++m)
#pragma unroll
                    for (int n = 0; n < 2; ++n) acc[a][b][m][n] = (f32x4){0.f, 0.f, 0.f, 0.f};
        cur = nxt; cA = nA; cB = nB; ++ui;
        if constexpr (ALIGN_EPI) { if (wr == 1) PG8_BAR; }
    }
    PG8_WAIT_V(0);
    if constexpr (!ALIGN_EPI) { if (wr == 0) PG8_BAR; }
    PG8_BAR;
    if constexpr (Epi::AFTER_DRAIN) { E.fused(acc, cur, wr, wc, fr, fq, lds, wid, lane); S.done(cur); }
#undef PG8_SA
#undef PG8_SB
#undef PG8_STAGE
#undef PG8_LDA
#undef PG8_LDB
#undef PG8_MMA
#undef PG8_WAIT_V
#undef PG8_WAIT_L
#undef PG8_BAR
#undef PG8_SCHED
}
}
#ifndef ATT_SEAM
#define ATT_SEAM 0
#endif
#ifndef ATT_NOTAB
#define ATT_NOTAB 0
#endif
#ifndef ATT_NOSQ
#define ATT_NOSQ 0
#endif
namespace att {
typedef unsigned short bf16;
typedef short bf16x8 __attribute__((ext_vector_type(8)));
typedef short s16x4 __attribute__((ext_vector_type(4)));
typedef float f32x16 __attribute__((ext_vector_type(16)));
typedef float f32x4 __attribute__((ext_vector_type(4)));
typedef unsigned u32x4 __attribute__((ext_vector_type(4)));
constexpr int D = 128, NW = 8, QBLK = 32, KVBLK = 64, QB = NW * QBLK;
constexpr int PITCH = 5632, OPITCH = 1024, SEQ = 4096;
constexpr int SHM_V = KVBLK * D * 2, SHM_K = KVBLK * D * 2;
constexpr int OFF_WS = 2 * SHM_V + 2 * SHM_K, OFF_TAB = OFF_WS + NW * 64 * 4, OFF_WT = OFF_TAB + SEQ * 4, LDS_BYTES = OFF_WT + 64;
constexpr float SCALE = 0.08838834764831845f, THR = 8.f;
constexpr unsigned WBIG = 0x40000000u;

#define KSWZ(row, colB) ((row) * 256 + ((colB) ^ (((row) & 7) << 4)))
#define SBAR() __builtin_amdgcn_sched_barrier(0)
__device__ __forceinline__ int v_st(int k, int c) { const int kk = (k & ~0xC) | ((k & 4) << 1) | ((k & 8) >> 1); return ((kk >> 3) * 4 + (c >> 5)) * 512 + ((kk & 7) * 32 + (c & 31)) * 2; }
__device__ __forceinline__ int v_rd_base(int lane) { return ((lane & 3) << 3) | (((lane >> 2) & 3) << 6) | (((lane >> 4) & 1) << 5) | (((lane >> 5) & 1) << 8); }
constexpr int v_rd_off(int d0, int ks, int half) { return d0 * 512 + ks * 4096 + half * 2048; }
__device__ __forceinline__ int crow(int r, int hi) { return (r & 3) + 8 * (r >> 2) + 4 * hi; }
__device__ __forceinline__ unsigned cvtpk(float lo, float hi) { unsigned r; asm volatile("v_cvt_pk_bf16_f32 %0, %1, %2" : "=v"(r) : "v"(lo), "v"(hi)); return r; }
__device__ __forceinline__ bf16x8 load8(const bf16* p) { return *reinterpret_cast<const bf16x8*>(p); }
__device__ __forceinline__ void mask_tile(f32x16& p0, f32x16& p1, int dq) {
    const float NEG = -__builtin_inff();
#pragma unroll
    for (int r = 0; r < 16; ++r) {
        const int c = (r & 3) + 8 * (r >> 2);
        if ((unsigned)(dq - c) >= WBIG) p0[r] = NEG;
        if ((unsigned)(dq - c - 32) >= WBIG) p1[r] = NEG;
    }
}
__device__ __forceinline__ void partialSM(f32x16& p0, f32x16& p1, float& m_reg, float& mn, float& alpha) {
    float pmax = p0[0];
#pragma unroll
    for (int r = 1; r < 16; ++r) pmax = fmaxf(pmax, p0[r]);
#pragma unroll
    for (int r = 0; r < 16; ++r) pmax = fmaxf(pmax, p1[r]);
    { auto rr = __builtin_amdgcn_permlane32_swap(__float_as_uint(pmax), __float_as_uint(pmax), false, false);
      pmax = fmaxf(__uint_as_float(rr[0]), __uint_as_float(rr[1])); }
    constexpr float C2 = 1.4426950408889634f * SCALE;
    if (__builtin_expect(__all((pmax - m_reg) * SCALE <= THR), 1)) { mn = m_reg; alpha = 1.f; }
    else { mn = fmaxf(m_reg, pmax); alpha = __builtin_amdgcn_exp2f((m_reg - mn) * C2); m_reg = mn; }
    const float mnL = -mn * C2;
#pragma unroll
    for (int r = 0; r < 16; ++r) p0[r] = fmaf(p0[r], C2, mnL);
#pragma unroll
    for (int r = 0; r < 16; ++r) p1[r] = fmaf(p1[r], C2, mnL);
#pragma unroll
    for (int r = 0; r < 16; ++r) p0[r] = __builtin_amdgcn_exp2f(p0[r]);
}
__device__ __forceinline__ void finishSM(f32x16& p0, f32x16& p1, float alpha, float& l_reg, bf16x8& pa0, bf16x8& pa1, bf16x8& pa2, bf16x8& pa3) {
#pragma unroll
    for (int r = 0; r < 16; ++r) p1[r] = __builtin_amdgcn_exp2f(p1[r]);
    float ps = 0;
#pragma unroll
    for (int r = 0; r < 16; ++r) ps += p0[r];
#pragma unroll
    for (int r = 0; r < 16; ++r) ps += p1[r];
    { auto rr = __builtin_amdgcn_permlane32_swap(__float_as_uint(ps), __float_as_uint(ps), false, false);
      ps = __uint_as_float(rr[0]) + __uint_as_float(rr[1]); }
    l_reg = l_reg * alpha + ps;
#define PK4(P, B_, OUT) do { unsigned a0 = cvtpk(P[B_+0], P[B_+1]), a1 = cvtpk(P[B_+2], P[B_+3]);                          \
        unsigned b0 = cvtpk(P[B_+4], P[B_+5]), b1 = cvtpk(P[B_+6], P[B_+7]);                                             \
        auto r0 = __builtin_amdgcn_permlane32_swap(a0, b0, false, false); auto r1 = __builtin_amdgcn_permlane32_swap(a1, b1, false, false); \
        u32x4 w = {r0[0], r1[0], r0[1], r1[1]}; OUT = *reinterpret_cast<bf16x8*>(&w); } while (0)
    PK4(p0, 0, pa0); PK4(p0, 8, pa1); PK4(p1, 0, pa2); PK4(p1, 8, pa3);
#undef PK4
}
template <int KB>
__device__ __forceinline__ void qkt(f32x16& p0, f32x16& p1, const char* K_lds, int r32, int hi, const bf16x8* qr, const float* bt) {
#pragma unroll
    for (int g = 0; g < 4; ++g) {
#if ATT_NOTAB
        const f32x4 t0 = {0.f,0.f,0.f,0.f}, t1 = {0.f,0.f,0.f,0.f};
#else
        const f32x4 t0 = *reinterpret_cast<const f32x4*>(bt + 8 * g), t1 = *reinterpret_cast<const f32x4*>(bt + 32 + 8 * g);
#endif
#pragma unroll
        for (int e = 0; e < 4; ++e) { p0[4 * g + e] = t0[e]; p1[4 * g + e] = t1[e]; } }
    const char* kb[4];
#pragma unroll
    for (int dd = 0; dd < 4; ++dd) kb[dd] = K_lds + KB * SHM_K + KSWZ(r32, (dd * 16 + hi * 8) * 2);
#pragma unroll
    for (int d0 = 0; d0 < 8; ++d0) { const char* a = kb[d0 & 3] + (d0 >> 2) * 128;
        bf16x8 b0 = *reinterpret_cast<const bf16x8*>(a);
        bf16x8 b1 = *reinterpret_cast<const bf16x8*>(a + 32 * 256);
        p0 = __builtin_amdgcn_mfma_f32_32x32x16_bf16(b0, qr[d0], p0, 0, 0, 0);
        p1 = __builtin_amdgcn_mfma_f32_32x32x16_bf16(b1, qr[d0], p1, 0, 0, 0); }
}
template <int VB>
__device__ __forceinline__ void pv_tile(f32x16* o, int vb0, bf16x8 pa0, bf16x8 pa1, bf16x8 pa2, bf16x8 pa3) {
#define TRRD(dst, off) asm volatile("ds_read_b64_tr_b16 %0, %1 offset:%2" : "=&v"(dst) : "v"(vb0), "i"(off) : "memory")
#define PV_D0(d0) do { s16x4 l0, l1, l2, l3, h0, h1, h2, h3; constexpr int b_ = VB * SHM_V + v_rd_off(d0, 0, 0); \
        TRRD(l0, b_); TRRD(h0, b_ + 2048); TRRD(l1, b_ + 4096); TRRD(h1, b_ + 6144); TRRD(l2, b_ + 8192); TRRD(h2, b_ + 10240); TRRD(l3, b_ + 12288); TRRD(h3, b_ + 14336); \
        asm volatile("s_waitcnt lgkmcnt(0)" ::: "memory"); SBAR();   \
        o[d0] = __builtin_amdgcn_mfma_f32_32x32x16_bf16(pa0, (bf16x8){l0[0], l0[1], l0[2], l0[3], h0[0], h0[1], h0[2], h0[3]}, o[d0], 0, 0, 0);   \
        o[d0] = __builtin_amdgcn_mfma_f32_32x32x16_bf16(pa1, (bf16x8){l1[0], l1[1], l1[2], l1[3], h1[0], h1[1], h1[2], h1[3]}, o[d0], 0, 0, 0);   \
        o[d0] = __builtin_amdgcn_mfma_f32_32x32x16_bf16(pa2, (bf16x8){l2[0], l2[1], l2[2], l2[3], h2[0], h2[1], h2[2], h2[3]}, o[d0], 0, 0, 0);   \
        o[d0] = __builtin_amdgcn_mfma_f32_32x32x16_bf16(pa3, (bf16x8){l3[0], l3[1], l3[2], l3[3], h3[0], h3[1], h3[2], h3[3]}, o[d0], 0, 0, 0); } while (0)
    PV_D0(0); PV_D0(1); PV_D0(2); PV_D0(3);
#undef PV_D0
#undef TRRD
}
struct BlockRef { const bf16* Q; const bf16* K; const bf16* V; bf16* O; int P0; };
#define VMW() asm volatile("s_waitcnt vmcnt(0)" ::: "memory")
__device__ __forceinline__ void block(const BlockRef& cur, char* lds, int wave_s) {
    const int tid = pg8::otid(wave_s), wid = __builtin_amdgcn_readfirstlane(tid >> 6), lane = tid & 63, r32 = lane & 31, hi = lane >> 5;
    const int NT = cur.P0 / KVBLK + QB / KVBLK;
    const int qlo = cur.P0 + wid * QBLK, qm = qlo + r32 - 4 * hi;
    char* V_lds = lds; char* K_lds = lds + 2 * SHM_V;
    float* ws = (float*)(lds + OFF_WS) + wid * 64; float* li_l = ws, * al_l = ws + 32;
    const float* tab = (const float*)(lds + OFF_TAB) + 4 * hi;
    float m_reg = -1e30f, l_reg = 0; f32x16 o[4] = {};
    const int sr = tid >> 4, sc = (tid & 15) * 8, vst0 = v_st(sr, sc), vst1 = v_st(32 + sr, sc), kws = KSWZ(sr, sc * 2);
    const int vb0 = (int)(uintptr_t)V_lds + v_rd_base(lane);
    const unsigned toff = (unsigned)sr * PITCH + sc;
    const bf16* Kh = cur.K; const bf16* Vh = cur.V;
    bf16x8 qr[8], st_v0, st_v1, st_k0, st_k1;
    { const bf16* qp = cur.Q + (unsigned)(wid * QBLK + r32) * PITCH + hi * 8;
#pragma unroll
      for (int d0 = 0; d0 < 8; ++d0) qr[d0] = load8(qp + d0 * 16); }
#define SLOAD_H(t) do { const bf16* kp_ = Kh + (size_t)(t) * (KVBLK * PITCH); const bf16* vp_ = Vh + (size_t)(t) * (KVBLK * PITCH); \
        st_v0 = load8(vp_ + toff); st_v1 = load8(vp_ + 32 * PITCH + toff); st_k0 = load8(kp_ + toff); st_k1 = load8(kp_ + 32 * PITCH + toff); } while (0)
#define SWRITE_H(bf) do { *(bf16x8*)(V_lds + (bf) * SHM_V + vst0) = st_v0; *(bf16x8*)(V_lds + (bf) * SHM_V + vst1) = st_v1; \
        *(bf16x8*)(K_lds + (bf) * SHM_K + kws) = st_k0; *(bf16x8*)(K_lds + (bf) * SHM_K + kws + 32 * 256) = st_k1; } while (0)
#define RESC(a) do { if (__any((a) < 1.f)) { if (hi == 0) al_l[r32] = (a); asm volatile("s_waitcnt lgkmcnt(0)" ::: "memory");              \
                     _Pragma("unroll") for (int d_ = 0; d_ < 4; ++d_) _Pragma("unroll") for (int r = 0; r < 16; ++r) o[d_][r] *= al_l[crow(r, hi)]; } } while (0)
#define STEP(t, BF) do { f32x16 p0, p1; float mn, al; bf16x8 pa0, pa1, pa2, pa3; const int kb_ = (t) * KVBLK;                     \
        if ((t) + 1 < NT) SLOAD_H((t) + 1);                                                                                     \
        SBAR(); qkt<BF>(p0, p1, K_lds, r32, hi, qr, tab + kb_);                                                                 \
        if (kb_ + KVBLK - 1 > qlo) mask_tile(p0, p1, qm - kb_);                                                                 \
        partialSM(p0, p1, m_reg, mn, al); RESC(al); finishSM(p0, p1, al, l_reg, pa0, pa1, pa2, pa3); SBAR();                    \
        pv_tile<BF>(o, vb0, pa0, pa1, pa2, pa3); SBAR();                                                                        \
        if ((t) + 1 < NT) { VMW(); SWRITE_H(1 - (BF)); }                                                                        \
        __syncthreads(); } while (0)
    SLOAD_H(0); VMW(); SWRITE_H(0);
    __syncthreads();
    for (int t = 0; t < NT; t += 2) { STEP(t, 0); STEP(t + 1, 1); }
    if (hi == 0) li_l[r32] = l_reg; asm volatile("s_waitcnt lgkmcnt(0)" ::: "memory");
    bf16* Ow = cur.O + (size_t)(wid * QBLK) * OPITCH;
#pragma unroll
    for (int r = 0; r < 16; ++r) { const int orow = crow(r, hi); const float rl = __builtin_amdgcn_rcpf(li_l[orow]);
#pragma unroll
        for (int d0 = 0; d0 < 4; ++d0) { const float v = o[d0][r] * rl;
            const float vn = pg8::sx<1>(v);
            if ((r32 & 1) == 0) *(unsigned*)(Ow + (size_t)orow * OPITCH + d0 * 32 + r32) = cvtpk(v, vn); } }
    __syncthreads();
#undef SLOAD_H
#undef SWRITE_H
#undef RESC
#undef STEP
}
#undef VMW
__device__ __forceinline__ void fill_table(const float* Fh, char* lds, int wave_s) {
    const int tid = pg8::otid(wave_s), wid = __builtin_amdgcn_readfirstlane(tid >> 6), lane = tid & 63;
    float* tab = (float*)(lds + OFF_TAB); float* wt = (float*)(lds + OFF_WT);
    float v[8];
#pragma unroll
    for (int j = 0; j < 8; ++j) v[j] = Fh[(size_t)(tid * 8 + j) * 8];
#pragma unroll
    for (int j = 1; j < 8; ++j) v[j] += v[j - 1];
    const float tot = v[7]; float scn = tot;
#pragma unroll
    for (int o = 1; o < 64; o <<= 1) { const int src = lane >= o ? lane - o : lane; const float n = __int_as_float(__builtin_amdgcn_ds_bpermute(src << 2, __float_as_int(scn))); if (lane >= o) scn += n; }
    if (lane == 63) wt[wid] = scn;
    __syncthreads();
    float woff = 0.f;
    for (int w = 0; w < wid; ++w) woff += wt[w];
    const float base = woff + scn - tot;
#pragma unroll
    for (int j = 0; j < 8; ++j) tab[tid * 8 + j] = -(base + v[j]) * (1.f / SCALE);
    __syncthreads();
}
#undef KSWZ
#undef SBAR
}

constexpr int NWAVES = 8;
constexpr int BATCH = 4, T = 4096, D = 2048, DEPTH = 4, M = BATCH * T;
constexpr int FF = 5632, NFF = 2 * FF;
constexpr int DCONV = 512, DATT = 1024, DLRU = 512, NH = 8, HD = 128;
constexpr int DIN = 5640;
constexpr int PW = 5632;
constexpr int NMIX = 5888;
constexpr int PC_B = 0, PC_C = 512, PC_V = 1024, PC_Q = 1536, PC_K = 2560, PC_VV = 3584, PC_G = 4608, PC_X = 5120;
constexpr int LCH = 32, NCH = T / LCH;
constexpr float EPS = 1e-6f;
constexpr int N_PHASES = 2 + 8 * DEPTH;

constexpr size_t MiB = 1u << 20;
constexpr size_t WS_CTL = 0, CTL_ZERO_BYTES = 1 * MiB;
constexpr size_t SZ_W1 = (size_t)NFF * D * 2, SZ_W2 = (size_t)D * FF * 2, SZ_WM = (size_t)NMIX * D * 2, SZ_WO = (size_t)D * D * 2, SZ_WG = (size_t)2 * 4 * 128 * 128 * 2;
constexpr size_t WS_W1 = 1 * MiB;
constexpr size_t WS_W2 = WS_W1 + 2 * DEPTH * SZ_W1;
constexpr size_t WS_WM = WS_W2 + 2 * DEPTH * SZ_W2;
constexpr size_t WS_WO = WS_WM + DEPTH * SZ_WM;
constexpr size_t WS_WG = WS_WO + DEPTH * SZ_WO;
constexpr size_t WS_XB = WS_WG + DEPTH * SZ_WG;
constexpr size_t WS_HB = WS_XB + (size_t)M * D * 2;
constexpr size_t WS_P  = WS_HB + (size_t)M * FF * 2;
constexpr size_t WS_YA = WS_P + (size_t)M * PW * 2;
constexpr size_t WS_Y  = WS_YA + (size_t)M * DATT * 2;
constexpr size_t WS_F  = WS_Y + (size_t)M * D * 2;
constexpr size_t WS_SA = WS_F + (size_t)M * 8 * 4;
constexpr size_t WS_SS = WS_SA + (size_t)M * 8 * 4;
constexpr size_t WS_CS = WS_SS + (size_t)M * 32 * 4;
constexpr size_t WS_END = WS_CS + (size_t)BATCH * NCH * DLRU * 2 * 4;
static_assert(WS_W1 % 256 == 0 && WS_XB % 256 == 0 && WS_F % 256 == 0 && WS_CS % 256 == 0, "d_ws map alignment");
constexpr int CW_TMO = 0;
constexpr int CW_BAR = 4096;

constexpr int RING_OFF = 0, RING_BYTES = 131072;
constexpr int RS_OFF = RING_BYTES;
constexpr int LDSCTL_OFF = RS_OFF + 1024, MISC_OFF = LDSCTL_OFF + 320;
constexpr int LDS_BYTES = 147456;
static_assert(MISC_OFF + 128 <= LDS_BYTES, "LDS map");
constexpr int LRU_XF = 0;
constexpr int LRU_XH_PITCH = 1040;
constexpr int LRU_XH = 65536;
constexpr int LRU_SQ = LRU_XH + 32 * LRU_XH_PITCH;
static_assert(LRU_SQ + 8 * 32 * 4 <= RING_BYTES && att::LDS_BYTES <= RING_BYTES, "phase scratch inside the ring region");

#define GAS __attribute__((address_space(1)))
#define LAS __attribute__((address_space(3)))
typedef unsigned short bf16;
typedef unsigned v4u __attribute__((ext_vector_type(4)));
typedef unsigned v2u __attribute__((ext_vector_type(2)));
typedef float f32x4 __attribute__((ext_vector_type(4)));
typedef float f32x2 __attribute__((ext_vector_type(2)));
typedef float f32x16 __attribute__((ext_vector_type(16)));
typedef short bf16x8 __attribute__((ext_vector_type(8)));
typedef GAS unsigned gu32;
#define RLX_AGENT __ATOMIC_RELAXED, __HIP_MEMORY_SCOPE_AGENT
#define LDS_WAIT() asm volatile("s_waitcnt lgkmcnt(0)" ::: "memory")
#define VM_WAIT() asm volatile("s_waitcnt vmcnt(0)" ::: "memory")
__device__ __forceinline__ unsigned pk2(float lo, float hi) { return pg8::cvt_pk_bf16(lo, hi); }
__device__ __forceinline__ float bflo(unsigned w) { return __uint_as_float(w << 16); }
__device__ __forceinline__ float bfhi(unsigned w) { return __uint_as_float(w & 0xffff0000u); }
__device__ __forceinline__ float bf1(bf16 h) { return __uint_as_float((unsigned)h << 16); }
__device__ __forceinline__ float wave_sum(float v) {
    v += pg8::sx<1>(v); v += pg8::sx<2>(v); v += pg8::sx<4>(v); v += pg8::sx<8>(v); v += pg8::sx<16>(v); return pg8::add32(v);
}

#define XB_TMO      128
#define XB_XCNT(j)  (256  + 64 * (j))
#define XB_XSUB(j)  (1280 + 64 * (j))
#define XB_XGEN(j)  (2304 + 64 * (j))
#define XB_TOP      3328
#define XB_TOPGEN   3392
#define XCD_BAR_WORDS 3456
#define XB_SPIN_CAP (1u << 18)

__device__ __forceinline__ unsigned xb_ld(unsigned* p)              { return __hip_atomic_load(p, __ATOMIC_RELAXED, __HIP_MEMORY_SCOPE_AGENT); }
__device__ __forceinline__ unsigned xb_add(unsigned* p, unsigned v) { return __hip_atomic_fetch_add(p, v, __ATOMIC_RELAXED, __HIP_MEMORY_SCOPE_AGENT); }
__device__ __forceinline__ unsigned xb_xcc_id() { return (unsigned)__builtin_amdgcn_s_getreg((3 << 11) | 20) & 0xFu; }
#define XB_SPIN(cond, bar) do { unsigned _sp = 0; while (cond) { __builtin_amdgcn_s_sleep(1); \
    if ((++_sp & 255u) == 0u) { if (xb_ld(&(bar)[XB_TMO])) break; if (_sp > XB_SPIN_CAP) { atomicAdd(&(bar)[XB_TMO], 1u); break; } } } } while (0)

struct XcdBarrier {
    unsigned* bar; unsigned x; int w;
    volatile LAS unsigned* st;
};

__device__ __forceinline__ bool xb_thread0(int w) { return w == 0 && __builtin_amdgcn_mbcnt_hi(~0u, __builtin_amdgcn_mbcnt_lo(~0u, 0u)) == 0u; }
__device__ __forceinline__ XcdBarrier xcd_barrier_post(unsigned* bar, volatile LAS unsigned* st, int w) {
    XcdBarrier b; b.bar = bar; b.x = xb_xcc_id(); b.st = st; b.w = w;
    if (xb_thread0(w)) (void)xb_add(&bar[XB_XCNT(b.x)], 1u);
    return b;
}
__device__ __forceinline__ void xcd_barrier_complete(unsigned* bar, unsigned x, unsigned& nloc, unsigned& nx) {
    const unsigned G = gridDim.x * gridDim.y * gridDim.z;
    asm volatile("" : "+s"(x));
    unsigned sum, cnt, mine, sp = 0u;
    for (;;) {
        sum = 0u; cnt = 0u; mine = 0u;
#pragma unroll
        for (unsigned j = 0; j < 16; ++j) { const unsigned c = xb_ld(&bar[XB_XCNT(j)]); sum += c; cnt += (c > 0u) ? 1u : 0u; mine = (j == x) ? c : mine; }
        if (sum == G) break;
        __builtin_amdgcn_s_sleep(1);
        if ((++sp & 255u) == 0u) { if (xb_ld(&bar[XB_TMO])) break; if (sp > XB_SPIN_CAP) { atomicAdd(&bar[XB_TMO], 1u); break; } }
    }
    nloc = mine > 0u ? mine : 1u; nx = cnt > 0u ? cnt : 1u;
}

__device__ __forceinline__ void xcd_barrier(const XcdBarrier& b_in) {
    XcdBarrier b = b_in; asm volatile("" : "+s"(b.bar), "+s"(b.x));
    asm volatile("s_waitcnt vmcnt(0)" ::: "memory");
    __syncthreads();
    if (xb_thread0(b.w)) {
        unsigned* bar = b.bar;
        __builtin_amdgcn_s_waitcnt(0);
        unsigned nloc = b.st[0], nx = b.st[1];
        if (nloc == 0u) { xcd_barrier_complete(bar, b.x, nloc, nx); b.st[0] = nloc; b.st[1] = nx; }
        const unsigned old = xb_add(&bar[XB_XSUB(b.x)], 1u);
        const unsigned gen = old / nloc;
        if (old + 1u == (gen + 1u) * nloc) {
            __builtin_amdgcn_fence(__ATOMIC_RELEASE, "agent");
            asm volatile("s_waitcnt vmcnt(0)" ::: "memory");
            const unsigned og = xb_add(&bar[XB_TOP], 1u);
            const unsigned tg = og / nx;
            if (og + 1u == (tg + 1u) * nx) xb_add(&bar[XB_TOPGEN], 1u);
            else XB_SPIN(xb_ld(&bar[XB_TOPGEN]) == tg, bar);
            __builtin_amdgcn_fence(__ATOMIC_ACQUIRE, "agent");
            xb_add(&bar[XB_XGEN(b.x)], 1u);
            asm volatile("s_waitcnt vmcnt(0)" ::: "memory");
        } else {
            XB_SPIN(xb_ld(&bar[XB_XGEN(b.x)]) == gen, bar);
            __builtin_amdgcn_fence(__ATOMIC_ACQUIRE, "agent");
            asm volatile("s_waitcnt vmcnt(0)" ::: "memory");
        }
    }
    __syncthreads();
}
template <int MODE> __device__ __forceinline__ int src_col(int n) {
    if (MODE == 1) { const int pn = n >> 8, bj = (n >> 7) & 1, jj = n & 127; return bj * FF + 128 * pn + jj; }
    if (MODE == 2) { if (n < 4608) return n; if (n < 5632) return n + 8; if (n < 5640) return n - 1024; return -1; }
    return n;
}
template <int MODE>
__device__ __forceinline__ void tr_item(const float* W, int K, int Nsrc, const float* gain, bf16* WT, int nblk, LAS unsigned* scr, int item, int lane) {
    const int kb = item / nblk, nb = item % nblk, k0 = 64 * kb, n0 = 64 * nb;
    const int n4 = lane & 15, pr = lane >> 4;
    const int sc = src_col<MODE>(n0 + 4 * n4);
    f32x4 va[8], vb[8];
#pragma unroll
    for (int i = 0; i < 8; ++i) { const int p = 4 * i + pr;
        if (sc >= 0) { const float* s = W + (size_t)(k0 + 2 * p) * Nsrc + sc; va[i] = *(const f32x4*)s; vb[i] = *(const f32x4*)(s + Nsrc); }
        else { va[i] = (f32x4){0.f, 0.f, 0.f, 0.f}; vb[i] = va[i]; } }
#pragma unroll
    for (int i = 0; i < 8; ++i) { const int p = 4 * i + pr;
        float ga = 1.f, gb = 1.f; if (gain) { ga = gain[k0 + 2 * p]; gb = gain[k0 + 2 * p + 1]; }
        v4u w; w.x = pk2(va[i][0] * ga, vb[i][0] * gb); w.y = pk2(va[i][1] * ga, vb[i][1] * gb); w.z = pk2(va[i][2] * ga, vb[i][2] * gb); w.w = pk2(va[i][3] * ga, vb[i][3] * gb);
        *(LAS v4u*)(scr + p * 64 + 4 * (n4 ^ ((p >> 2) & 7))) = w; }
    LDS_WAIT(); asm volatile("" ::: "memory");
    const int c = lane & 7;
#pragma unroll
    for (int j = 0; j < 8; ++j) { const int n = (lane >> 3) + 8 * j;
        v4u o;
#pragma unroll
        for (int i = 0; i < 4; ++i) { const int p = 4 * c + i; o[i] = scr[p * 64 + (n ^ (((p >> 2) & 7) << 2))]; }
        *(GAS v4u*)(WT + (size_t)(n0 + n) * K + k0 + 8 * c) = o; }
    LDS_WAIT(); asm volatile("" ::: "memory");
}
template <int MODE>
__device__ __forceinline__ void tr_matrix(const float* W, int K, int Nsrc, const float* gain, bf16* WT, int Ndst, LAS unsigned* scr, int gw, int NGW, int lane) {
    const int nblk = Ndst / 64, nitems = (K / 64) * nblk;
    for (int it = gw; it < nitems; it += NGW) tr_item<MODE>(W, K, Nsrc, gain, WT, nblk, scr, it, lane);
}

__device__ __forceinline__ void compute_rs(LAS unsigned char* lds, int pm, const float* SS, int wave_s) {
    const int tid = pg8::otid(wave_s);
    const f32x4* p = (const f32x4*)(SS + (size_t)(pm * 256 + (tid >> 1)) * 32 + (tid & 1) * 16);
    const f32x4 a = p[0], b = p[1], c = p[2], d = p[3];
    float s = ((a[0] + a[1]) + (a[2] + a[3])) + ((b[0] + b[1]) + (b[2] + b[3])) + ((c[0] + c[1]) + (c[2] + c[3])) + ((d[0] + d[1]) + (d[2] + d[3]));
    s += pg8::sx<1>(s);
    if ((tid & 1) == 0) ((LAS float*)(lds + RS_OFF))[tid >> 1] = __builtin_amdgcn_rsqf(s * (1.f / D) + EPS);
    __syncthreads();
}

__device__ __forceinline__ float sigmoidf_(float z) { return __builtin_amdgcn_rcpf(1.f + __expf(-z)); }
__device__ __forceinline__ float gelu_tanh(float x) { const float z = 0.7978845608028654f * (x + 0.044715f * x * x * x); const float t = __expf(2.f * z); return 0.5f * x * (2.f - 2.f * __builtin_amdgcn_rcpf(t + 1.f)); }
__device__ __forceinline__ bf16 f2bf(float f) { unsigned u = __float_as_uint(f); return (bf16)((u + 0x7fffu + ((u >> 16) & 1u)) >> 16); }
template <bool FINAL>
__device__ __forceinline__ void lru_unit(LAS unsigned char* lds, int b, int ck, const bf16* P, const float* cw, const float* cbias, const bf16* WG,
                                         const float* b_a, const float* b_x, const float* lam, float* CS, bf16* Y, int wave_s) {
    const int tid = pg8::otid(wave_s), wid = __builtin_amdgcn_readfirstlane(tid >> 6), lane = tid & 63, j = lane & 31, hi = lane >> 5;
    const int t0 = ck * LCH; const size_t m0 = (size_t)b * T + t0;
    LAS float* XF = (LAS float*)(lds + LRU_XF); LAS unsigned char* XH = lds + LRU_XH; LAS float* SQ = (LAS float*)(lds + LRU_SQ);
#pragma unroll
    for (int it = 0; it < 4; ++it) {
        const int idx = it * 512 + tid, tt = idx >> 6, c0 = (idx & 63) * 8;
        f32x4 a0 = *(const f32x4*)(cbias + c0), a1 = *(const f32x4*)(cbias + c0 + 4);
#pragma unroll
        for (int k = 0; k < 4; ++k) {
            if (t0 + tt - 3 + k >= 0) {
                const v4u w = *(const v4u*)(P + (m0 + tt - 3 + k) * PW + PC_X + c0);
                const f32x4 w0 = *(const f32x4*)(cw + k * DLRU + c0), w1 = *(const f32x4*)(cw + k * DLRU + c0 + 4);
                a0[0] += w0[0] * bflo(w.x); a0[1] += w0[1] * bfhi(w.x); a0[2] += w0[2] * bflo(w.y); a0[3] += w0[3] * bfhi(w.y);
                a1[0] += w1[0] * bflo(w.z); a1[1] += w1[1] * bfhi(w.z); a1[2] += w1[2] * bflo(w.w); a1[3] += w1[3] * bfhi(w.w);
            }
        }
        *(LAS f32x4*)(XF + tt * DLRU + c0) = a0; *(LAS f32x4*)(XF + tt * DLRU + c0 + 4) = a1;
        v4u hw; hw.x = pk2(a0[0], a0[1]); hw.y = pk2(a0[2], a0[3]); hw.z = pk2(a1[0], a1[1]); hw.w = pk2(a1[2], a1[3]);
        *(LAS v4u*)(XH + tt * LRU_XH_PITCH + c0 * 2) = hw;
    }
    __syncthreads();
    const int g = wid >> 1, cwv = 64 * wid;
    f32x16 acc[2][2];
#pragma unroll
    for (int ga = 0; ga < 2; ++ga)
#pragma unroll
        for (int nt = 0; nt < 2; ++nt)
#pragma unroll
            for (int r = 0; r < 16; ++r) acc[ga][nt][r] = 0.f;
#pragma unroll
    for (int ks = 0; ks < 8; ++ks) {
        const bf16x8 A = *(const LAS bf16x8*)(XH + j * LRU_XH_PITCH + (128 * g + 16 * ks + 8 * hi) * 2);
#pragma unroll
        for (int ga = 0; ga < 2; ++ga)
#pragma unroll
            for (int nt = 0; nt < 2; ++nt) {
                const bf16x8 Bf = *(const bf16x8*)(WG + ((size_t)(ga * 4 + g) * 128 + (64 * (wid & 1) + 32 * nt + j)) * 128 + 16 * ks + 8 * hi);
                acc[ga][nt] = __builtin_amdgcn_mfma_f32_32x32x16_bf16(A, Bf, acc[ga][nt], 0, 0, 0);
            }
    }
    float h0[2] = {0.f, 0.f};
    if (FINAL) {
        for (int k = 0; k < ck; ++k) {
#pragma unroll
            for (int nt = 0; nt < 2; ++nt) { const f32x2 s = *(const f32x2*)(CS + ((size_t)(b * NCH + k) * DLRU + cwv + 32 * nt + j) * 2); h0[nt] = s.x * h0[nt] + s.y; }
        }
    }
    float sq[16];
#pragma unroll
    for (int r = 0; r < 16; ++r) sq[r] = 0.f;
#pragma unroll
    for (int nt = 0; nt < 2; ++nt) {
        const int c = cwv + 32 * nt + j;
        const float ba = b_a[c], bx = b_x[c], sp = pg8::log1p_small(__expf(-lam[c]));
#pragma unroll
        for (int r = 0; r < 16; ++r) { const int tt = (r & 3) + 8 * (r >> 2) + 4 * hi;
            const float xr = XF[tt * DLRU + c];
            const float rg = sigmoidf_(acc[0][nt][r] + ba), ig = sigmoidf_(acc[1][nt][r] + bx);
            const float la = -8.f * rg * sp, a = __expf(la), x2 = 2.f * la;
            const float em = -x2 * (1.f + x2 * 0.5f * (1.f + x2 * (1.f / 3.f) * (1.f + x2 * 0.25f * (1.f + x2 * 0.2f * (1.f + x2 * (1.f / 6.f) * (1.f + x2 * (1.f / 7.f))))))), mult = __builtin_amdgcn_sqrtf(em);
            acc[0][nt][r] = a; acc[1][nt][r] = mult * (ig * xr); }
        float Ae[4], He[4], pA[4], pH[4], cin[4];
#pragma unroll
        for (int q = 0; q < 4; ++q) { float hl = 0.f, cA = 1.f;
#pragma unroll
            for (int e = 0; e < 4; ++e) { const int r = 4 * q + e; const float a = acc[0][nt][r], u = acc[1][nt][r]; hl = a * hl + u; cA *= a; acc[1][nt][r] = hl; acc[0][nt][r] = cA; }
            Ae[q] = cA; He[q] = hl; cin[q] = 0.f; }
#pragma unroll
        for (int q = 0; q < 4; ++q) { pA[q] = pg8::other32(Ae[q], hi); pH[q] = pg8::other32(He[q], hi); }
        float carry = h0[nt], Atot = 1.f;
#pragma unroll
        for (int G = 0; G < 8; ++G) { const int q = G >> 1; const bool mine = ((G & 1) == hi);
            const float Ag = mine ? Ae[q] : pA[q], Hg = mine ? He[q] : pH[q];
            cin[q] = mine ? carry : cin[q]; carry = Ag * carry + Hg; Atot *= Ag; }
        if (!FINAL) { if (hi == 0) { f32x2 s; s.x = Atot; s.y = carry; *(f32x2*)(CS + ((size_t)(b * NCH + ck) * DLRU + c) * 2) = s; } }
        else {
#pragma unroll
            for (int r = 0; r < 16; ++r) { const int tt = (r & 3) + 8 * (r >> 2) + 4 * hi;
                const float h = acc[1][nt][r] + acc[0][nt][r] * cin[r >> 2];
                const float gt = bf1(P[(m0 + tt) * PW + PC_G + c]);
                const float y = gelu_tanh(gt) * h; acc[1][nt][r] = y; sq[r] += y * y; }
        }
    }
    if (FINAL) {
#pragma unroll
        for (int r = 0; r < 16; ++r) { float s = sq[r]; s += pg8::sx<1>(s); s += pg8::sx<2>(s); s += pg8::sx<4>(s); s += pg8::sx<8>(s); s += pg8::sx<16>(s); sq[r] = s; }
        if (j == 0) {
#pragma unroll
            for (int r = 0; r < 16; ++r) SQ[wid * 32 + (r & 3) + 8 * (r >> 2) + 4 * hi] = sq[r]; }
        __syncthreads();
#pragma unroll
        for (int r = 0; r < 16; ++r) { const int tt = (r & 3) + 8 * (r >> 2) + 4 * hi; float tot = 0.f;
#pragma unroll
            for (int w = 0; w < 8; ++w) tot += SQ[w * 32 + tt];
            const float rsn = __builtin_amdgcn_rsqf(tot * (1.f / DLRU) + EPS);
#pragma unroll
            for (int nt = 0; nt < 2; ++nt) Y[(m0 + tt) * D + (DCONV + DATT) + cwv + 32 * nt + j] = f2bf(acc[1][nt][r] * rsn); }
    }
    __syncthreads();
}

__device__ __forceinline__ void token_unit(int m, int lane, const bf16* P, const bf16* YA, const float* cw, bf16* Y) {
    const int t = m & (T - 1);
    const bf16* pr = P + (size_t)m * PW + 8 * lane;
    const v4u cb = *(const v4u*)(pr + PC_B), c0 = *(const v4u*)(pr + PC_C), v0 = *(const v4u*)(pr + PC_V);
    v4u c1 = {0u, 0u, 0u, 0u}, v1 = {0u, 0u, 0u, 0u}, c2 = {0u, 0u, 0u, 0u}, v2 = {0u, 0u, 0u, 0u};
    if (t >= 1) { c1 = *(const v4u*)(pr - PW + PC_C); v1 = *(const v4u*)(pr - PW + PC_V); }
    if (t >= 2) { c2 = *(const v4u*)(pr - 2 * PW + PC_C); v2 = *(const v4u*)(pr - 2 * PW + PC_V); }
    float y[8]; float s = 0.f;
#pragma unroll
    for (int e = 0; e < 4; ++e) {
        const int ch = 8 * lane + 2 * e;
        const float z0l = bflo(c0[e]) * bflo(v0[e]), z0h = bfhi(c0[e]) * bfhi(v0[e]);
        const float z1l = bflo(c1[e]) * bflo(v1[e]), z1h = bfhi(c1[e]) * bfhi(v1[e]);
        const float z2l = bflo(c2[e]) * bflo(v2[e]), z2h = bfhi(c2[e]) * bfhi(v2[e]);
        const f32x2 w0 = *(const f32x2*)(cw + ch), w1 = *(const f32x2*)(cw + DCONV + ch), w2 = *(const f32x2*)(cw + 2 * DCONV + ch);
        y[2 * e] = bflo(cb[e]) * (w0.x * z2l + w1.x * z1l + w2.x * z0l);
        y[2 * e + 1] = bfhi(cb[e]) * (w0.y * z2h + w1.y * z1h + w2.y * z0h);
        s += y[2 * e] * y[2 * e] + y[2 * e + 1] * y[2 * e + 1];
    }
    s = wave_sum(s);
    const float rsc = __builtin_amdgcn_rsqf(s * (1.f / DCONV) + EPS);
    v4u o; o.x = pk2(y[0] * rsc, y[1] * rsc); o.y = pk2(y[2] * rsc, y[3] * rsc); o.z = pk2(y[4] * rsc, y[5] * rsc); o.w = pk2(y[6] * rsc, y[7] * rsc);
    *(v4u*)(Y + (size_t)m * D + 8 * lane) = o;
    const v4u a0 = *(const v4u*)(YA + (size_t)m * DATT + 16 * lane), a1 = *(const v4u*)(YA + (size_t)m * DATT + 16 * lane + 8);
    float tot = 0.f;
#pragma unroll
    for (int e = 0; e < 4; ++e) { const float x0 = bflo(a0[e]), x1 = bfhi(a0[e]), x2 = bflo(a1[e]), x3 = bfhi(a1[e]); tot += (x0 * x0 + x1 * x1) + (x2 * x2 + x3 * x3); }
    tot = wave_sum(tot);
    const float rsa = __builtin_amdgcn_rsqf(tot * (1.f / DATT) + EPS);
    v4u q0, q1;
#pragma unroll
    for (int e = 0; e < 4; ++e) { q0[e] = pk2(bflo(a0[e]) * rsa, bfhi(a0[e]) * rsa); q1[e] = pk2(bflo(a1[e]) * rsa, bfhi(a1[e]) * rsa); }
    *(v4u*)(Y + (size_t)m * D + DCONV + 16 * lane) = q0; *(v4u*)(Y + (size_t)m * D + DCONV + 16 * lane + 8) = q1;
}

#ifndef REP_P0
#define REP_P0 1
#endif
#ifndef REP_G1
#define REP_G1 1
#endif
#ifndef REP_G3
#define REP_G3 1
#endif
#ifndef REP_X1
#define REP_X1 1
#endif
#ifndef REP_X2
#define REP_X2 1
#endif
#ifndef EN_ALL
#define EN_ALL 1
#endif
#ifndef EN_P0
#define EN_P0 EN_ALL
#endif
#ifndef EN_G1
#define EN_G1 EN_ALL
#endif
#ifndef EN_G2
#define EN_G2 EN_ALL
#endif
#ifndef EN_G3
#define EN_G3 EN_ALL
#endif
#ifndef EN_X1
#define EN_X1 EN_ALL
#endif
#ifndef EN_X2
#define EN_X2 EN_ALL
#endif
#ifndef EN_G4
#define EN_G4 EN_ALL
#endif
#ifndef EN_G5
#define EN_G5 EN_ALL
#endif
#ifndef EN_G6
#define EN_G6 EN_ALL
#endif
#ifndef EN_ATT
#define EN_ATT 1
#endif
#ifndef EN_LRU
#define EN_LRU 1
#endif
#ifndef ATT_ONESITE
#define ATT_ONESITE 1
#endif
#ifndef EN_FN
#define EN_FN EN_ALL
#endif
#ifndef MK_SINGLE
#define MK_SINGLE 1
#endif
struct Args { const float* in[21]; float* out; unsigned char* ws; int ph_lo, ph_hi; };
typedef const __attribute__((address_space(4))) Args* CArgs;
__device__ __forceinline__ CArgs oargs(CArgs p) { asm volatile("" : "+s"(p)); return p; }
template <class T> __device__ __forceinline__ T* asglobal(T* p) { return (T*)(__attribute__((address_space(1))) T*)p; }
#define WSP(T, off) ((T*)(ws + (off)))
__global__ void __launch_bounds__(NWAVES * 64, 2) hymba_fwd(Args args_unused) {
    extern __shared__ __attribute__((aligned(16))) unsigned char lds_raw[];
    LAS unsigned char* lds = (LAS unsigned char*)lds_raw;
    volatile LAS unsigned* MISC = (volatile LAS unsigned*)(lds + MISC_OFF);
    const CArgs ap = (CArgs)__builtin_amdgcn_kernarg_segment_ptr();
    const int G = gridDim.x, bid = blockIdx.x;
    const int wave_s = __builtin_amdgcn_readfirstlane(threadIdx.x >> 6);
    { const int tid = pg8::otid(wave_s); for (int u = tid; u < (LDS_BYTES - LDSCTL_OFF) / 4; u += NWAVES * 64) ((LAS unsigned*)(lds + LDSCTL_OFF))[u] = 0u; }
    __syncthreads();
#if MK_SINGLE
    constexpr int lo = 0, hi = N_PHASES;
#else
    const int lo = ap->ph_lo, hi = ap->ph_hi;
#endif
    XcdBarrier bar; bar.bar = (unsigned*)(asglobal(ap->ws) + WS_CTL) + CW_BAR; bar.x = 0; bar.st = nullptr; bar.w = wave_s;
    if (hi - lo > 1) bar = xcd_barrier_post((unsigned*)(asglobal(ap->ws) + WS_CTL) + CW_BAR, MISC + 8, wave_s);
#define IN(k) (lo <= (k) && (k) < hi)
#define SEAM(k) do { if (IN((k) + 1)) xcd_barrier(bar); } while (0)
#define PHASE_ENTRY() const CArgs a = oargs(ap); unsigned char* const ws = asglobal(a->ws); const int tid = pg8::otid(wave_s), lane = tid & 63, wave = wave_s; \
        const int gw = bid * NWAVES + wave, NGW = G * NWAVES; (void)lane; (void)gw; (void)NGW; (void)ws
    const LAS float* rs_lds = (const LAS float*)(lds + RS_OFF);

    if (EN_P0 && IN(0))
_Pragma("nounroll") for (int rep_ = 0; rep_ < REP_P0; ++rep_) {
        PHASE_ENTRY();
        LAS unsigned* scr = (LAS unsigned*)(lds + RING_OFF + wave * 8192);
        for (int l = 0; l < DEPTH; ++l) {
            tr_matrix<1>(asglobal(a->in[2]) + (size_t)l * D * NFF, D, NFF, asglobal(a->in[1]) + l * D, WSP(bf16, WS_W1 + (size_t)(0 * DEPTH + l) * SZ_W1), NFF, scr, gw, NGW, lane);
            tr_matrix<1>(asglobal(a->in[18]) + (size_t)l * D * NFF, D, NFF, asglobal(a->in[17]) + l * D, WSP(bf16, WS_W1 + (size_t)(1 * DEPTH + l) * SZ_W1), NFF, scr, gw, NGW, lane);
            tr_matrix<0>(asglobal(a->in[3]) + (size_t)l * FF * D, FF, D, nullptr, WSP(bf16, WS_W2 + (size_t)(0 * DEPTH + l) * SZ_W2), D, scr, gw, NGW, lane);
            tr_matrix<0>(asglobal(a->in[19]) + (size_t)l * FF * D, FF, D, nullptr, WSP(bf16, WS_W2 + (size_t)(1 * DEPTH + l) * SZ_W2), D, scr, gw, NGW, lane);
            tr_matrix<2>(asglobal(a->in[5]) + (size_t)l * D * DIN, D, DIN, asglobal(a->in[4]) + l * D, WSP(bf16, WS_WM + (size_t)l * SZ_WM), NMIX, scr, gw, NGW, lane);
            tr_matrix<0>(asglobal(a->in[16]) + (size_t)l * D * D, D, D, asglobal(a->in[15]) + l * D, WSP(bf16, WS_WO + (size_t)l * SZ_WO), D, scr, gw, NGW, lane);
            for (int it = gw; it < 32; it += NGW) { const int mat = it >> 2, ga = mat >> 2, g = mat & 3;
                tr_item<0>((ga ? asglobal(a->in[12]) : asglobal(a->in[10])) + (size_t)(l * 4 + g) * 128 * 128, 128, 128, nullptr, WSP(bf16, WS_WG + (size_t)l * SZ_WG) + (size_t)mat * 128 * 128, 2, scr, it & 3, lane); }
        }
        const float* xin = asglobal(a->in[0]); bf16* XB = WSP(bf16, WS_XB); float* SS = WSP(float, WS_SS);
        for (int m = gw; m < M; m += NGW) {
            const GAS f32x4* xr = (const GAS f32x4*)(xin + (size_t)m * D) + lane; float s = 0.f;
            GAS v2u* o8 = (GAS v2u*)(XB + (size_t)m * D) + lane;
#pragma unroll
            for (int jj = 0; jj < 8; ++jj) { const f32x4 v = xr[64 * jj]; s += (v[0] * v[0] + v[1] * v[1]) + (v[2] * v[2] + v[3] * v[3]);
                v2u w; w.x = pk2(v[0], v[1]); w.y = pk2(v[2], v[3]); o8[64 * jj] = w; }
            s = wave_sum(s);
            if (lane < 32) SS[(size_t)m * 32 + lane] = (lane == 0) ? s : 0.f;
        }
        SEAM(0);
    }

#pragma nounroll
    for (int l = 0; l < DEPTH; ++l) {
        const int pb = 1 + 8 * l;
        if (EN_G1 && IN(pb + 0))
_Pragma("nounroll") for (int rep_ = 0; rep_ < REP_G1; ++rep_) {
            PHASE_ENTRY();
            pg8::StaticOrder S; S.init(M, NFF, G, bid); pg8::Unit u0; u0.pm = 0; u0.pn = 0; S.next(0, u0); compute_rs(lds, u0.pm, WSP(float, WS_SS), wave_s);
            pg8::Gemm g{WSP(bf16, WS_XB), WSP(bf16, WS_W1 + (size_t)(0 * DEPTH + l) * SZ_W1), M, NFF, D}; pg8::EpiSwiGLU E{WSP(bf16, WS_HB), FF, rs_lds};
            pg8::gemm_phase<pg8::EpiSwiGLU, pg8::StaticOrder, true, true>(lds + RING_OFF, g, S, E, wave_s);
            SEAM(pb + 0);
        }
        if (EN_G2 && IN(pb + 1)) {
            PHASE_ENTRY();
            pg8::StaticOrder S; S.init(M, D, G, bid);
            pg8::Gemm g{WSP(bf16, WS_HB), WSP(bf16, WS_W2 + (size_t)(0 * DEPTH + l) * SZ_W2), M, D, FF}; pg8::EpiRes E{l == 0 ? asglobal(a->in[0]) : asglobal(a->out), asglobal(a->out), WSP(bf16, WS_XB), WSP(float, WS_SS), 0.5f};
            pg8::gemm_phase<pg8::EpiRes, pg8::StaticOrder, true, true>(lds + RING_OFF, g, S, E, wave_s);
            SEAM(pb + 1);
        }
        if (EN_G3 && IN(pb + 2))
_Pragma("nounroll") for (int rep_ = 0; rep_ < REP_G3; ++rep_) {
            PHASE_ENTRY();
            pg8::StaticOrder S; S.init(M, NMIX, G, bid); pg8::Unit u0; u0.pm = 0; u0.pn = 0; S.next(0, u0); compute_rs(lds, u0.pm, WSP(float, WS_SS), wave_s);
            pg8::Gemm g{WSP(bf16, WS_XB), WSP(bf16, WS_WM + (size_t)l * SZ_WM), M, NMIX, D}; pg8::EpiMix E{WSP(bf16, WS_P), PW, rs_lds, WSP(float, WS_F), asglobal(a->in[7]) + l * NH};
            pg8::gemm_phase<pg8::EpiMix, pg8::StaticOrder, true, true>(lds + RING_OFF, g, S, E, wave_s);
            SEAM(pb + 2);
        }
        if (EN_X1 && IN(pb + 3))
_Pragma("nounroll") for (int rep_ = 0; rep_ < REP_X1; ++rep_) {
            PHASE_ENTRY();
            const bf16* P = WSP(bf16, WS_P);
            if (EN_ATT) for (int L = bid; L < 256; L += G) {
                const int bh = (L & 7) + 8 * (L >> 6), xq = (L >> 3) & 7, b = bh >> 3, h = bh & 7;
                att::fill_table(WSP(float, WS_F) + (size_t)b * T * 8 + h, (char*)lds_raw + RING_OFF, wave_s);
                const bf16* Pb = P + (size_t)b * T * PW + h * HD;
#pragma nounroll
                for (int pass = 0; pass < 2; ++pass) {
                    att::BlockRef r; r.P0 = (pass ? 15 - xq : xq) * 256;
                    r.K = Pb + PC_K; r.V = Pb + PC_VV; r.Q = Pb + PC_Q + (size_t)r.P0 * PW;
                    r.O = WSP(bf16, WS_YA) + ((size_t)b * T + r.P0) * DATT + h * HD;
                    att::block(r, (char*)lds_raw + RING_OFF, wave_s);
                }
                VM_WAIT(); __syncthreads();
            }
            if (EN_LRU) for (int u = bid; u < BATCH * NCH; u += G)
                lru_unit<false>(lds + RING_OFF, u / NCH, u % NCH, P, asglobal(a->in[8]) + l * 4 * DLRU, asglobal(a->in[9]) + l * DLRU, WSP(bf16, WS_WG + (size_t)l * SZ_WG), asglobal(a->in[11]) + l * DLRU, asglobal(a->in[13]) + l * DLRU, asglobal(a->in[14]) + l * DLRU, WSP(float, WS_CS), WSP(bf16, WS_Y), wave_s);
            SEAM(pb + 3);
        }
        if (EN_X2 && IN(pb + 4))
_Pragma("nounroll") for (int rep_ = 0; rep_ < REP_X2; ++rep_) {
            PHASE_ENTRY();
            const bf16* P = WSP(bf16, WS_P);
            for (int u = bid; u < BATCH * NCH; u += G)
                lru_unit<true>(lds + RING_OFF, u / NCH, u % NCH, P, asglobal(a->in[8]) + l * 4 * DLRU, asglobal(a->in[9]) + l * DLRU, WSP(bf16, WS_WG + (size_t)l * SZ_WG), asglobal(a->in[11]) + l * DLRU, asglobal(a->in[13]) + l * DLRU, asglobal(a->in[14]) + l * DLRU, WSP(float, WS_CS), WSP(bf16, WS_Y), wave_s);
            for (int m = gw; m < M; m += NGW) token_unit(m, lane, P, WSP(bf16, WS_YA), asglobal(a->in[6]) + l * 3 * DCONV, WSP(bf16, WS_Y));
            SEAM(pb + 4);
        }
        if (EN_G4 && IN(pb + 5)) {
            PHASE_ENTRY();
            pg8::StaticOrder S; S.init(M, D, G, bid);
            pg8::Gemm g{WSP(bf16, WS_Y), WSP(bf16, WS_WO + (size_t)l * SZ_WO), M, D, D}; pg8::EpiRes E{asglobal(a->out), asglobal(a->out), WSP(bf16, WS_XB), WSP(float, WS_SS), 1.0f};
            pg8::gemm_phase<pg8::EpiRes, pg8::StaticOrder, true, true>(lds + RING_OFF, g, S, E, wave_s);
            SEAM(pb + 5);
        }
        if (EN_G5 && IN(pb + 6)) {
            PHASE_ENTRY();
            pg8::StaticOrder S; S.init(M, NFF, G, bid); pg8::Unit u0; u0.pm = 0; u0.pn = 0; S.next(0, u0); compute_rs(lds, u0.pm, WSP(float, WS_SS), wave_s);
            pg8::Gemm g{WSP(bf16, WS_XB), WSP(bf16, WS_W1 + (size_t)(1 * DEPTH + l) * SZ_W1), M, NFF, D}; pg8::EpiSwiGLU E{WSP(bf16, WS_HB), FF, rs_lds};
            pg8::gemm_phase<pg8::EpiSwiGLU, pg8::StaticOrder, true, true>(lds + RING_OFF, g, S, E, wave_s);
            SEAM(pb + 6);
        }
        if (EN_G6 && IN(pb + 7)) {
            PHASE_ENTRY();
            pg8::StaticOrder S; S.init(M, D, G, bid);
            pg8::Gemm g{WSP(bf16, WS_HB), WSP(bf16, WS_W2 + (size_t)(1 * DEPTH + l) * SZ_W2), M, D, FF}; pg8::EpiRes E{asglobal(a->out), asglobal(a->out), WSP(bf16, WS_XB), WSP(float, WS_SS), 0.5f};
            pg8::gemm_phase<pg8::EpiRes, pg8::StaticOrder, true, true>(lds + RING_OFF, g, S, E, wave_s);
            SEAM(pb + 7);
        }
    }
    if (EN_FN && IN(N_PHASES - 1)) {
        PHASE_ENTRY();
        const float* gfin = asglobal(a->in[20]); float* X = asglobal(a->out); const float* SS = WSP(float, WS_SS);
        for (int m = gw; m < M; m += NGW) {
            float s = lane < 32 ? SS[(size_t)m * 32 + lane] : 0.f; s = wave_sum(s);
            const float rsn = __builtin_amdgcn_rsqf(s * (1.f / D) + EPS);
            GAS f32x4* xr = (GAS f32x4*)(X + (size_t)m * D) + lane; const GAS f32x4* gr = (const GAS f32x4*)gfin + lane;
#pragma unroll
            for (int jj = 0; jj < 8; ++jj) { const f32x4 v = xr[64 * jj], gg = gr[64 * jj]; xr[64 * jj] = v * rsn * gg; }
        }
    }
#undef IN
#undef SEAM
#undef PHASE_ENTRY
}

extern "C" void kernel_launch(void* const* d_in, const int* in_sizes, int n_in, void* d_out, int out_size, void* d_ws, size_t ws_size, hipStream_t stream) {
    static int grid = 0;
    if (grid == 0) {
        if (n_in != 21 || in_sizes[0] != M * D || out_size != M * D || ws_size < WS_END) {
            fprintf(stderr, "kernel_launch: built for 21 inputs, x/out of %d floats, >= %zu bytes of workspace; got n_in %d, in0 %d, out %d, ws %zu; nothing launched\n", M * D, (size_t)WS_END, n_in, n_in > 0 ? in_sizes[0] : -1, out_size, ws_size);
            grid = -1; return; }
        int dev = 0, cus = 0, per_cu = 0;
        if (hipGetDevice(&dev) != hipSuccess || hipDeviceGetAttribute(&cus, hipDeviceAttributeMultiprocessorCount, dev) != hipSuccess) { fprintf(stderr, "kernel_launch: device query failed\n"); grid = -1; return; }
        if (hipFuncSetAttribute((const void*)hymba_fwd, hipFuncAttributeMaxDynamicSharedMemorySize, LDS_BYTES) != hipSuccess) { fprintf(stderr, "kernel_launch: hipFuncSetAttribute failed\n"); grid = -1; return; }
        if (hipOccupancyMaxActiveBlocksPerMultiprocessor(&per_cu, (const void*)hymba_fwd, NWAVES * 64, LDS_BYTES) != hipSuccess || per_cu < 1)
            fprintf(stderr, "kernel_launch: note: occupancy query reports %d workgroups per CU\n", per_cu);
        (void)hipGetLastError();
        grid = cus;
        if (grid != 256) fprintf(stderr, "kernel_launch: %d CUs; the row-scale tables assume a 256-workgroup grid\n", grid);
        const int Ns[3] = {NFF, D, NMIX};
        for (int k = 0; k < 3; ++k) for (int c = 0; c < grid; ++c) { pg8::StaticOrder S; S.init(M, Ns[k], grid, c); pg8::Unit u0, u; if (!S.next(0, u0)) continue;
            for (int i = 1; S.next(i, u); ++i) if (u.pm != u0.pm) { fprintf(stderr, "kernel_launch: unit order gives workgroup %d two row panels (N %d)\n", c, Ns[k]); grid = -1; return; } }
    }
    if (grid < 0) return;
    if (hipMemsetAsync((char*)d_ws + WS_CTL, 0, CTL_ZERO_BYTES, stream) != hipSuccess) { fprintf(stderr, "kernel_launch: hipMemsetAsync failed\n"); return; }
    Args a{};
    for (int i = 0; i < 21; ++i) a.in[i] = (const float*)d_in[i];
    a.out = (float*)d_out; a.ws = (unsigned char*)d_ws;
#if MK_SINGLE
    a.ph_lo = 0; a.ph_hi = N_PHASES;
    hipLaunchKernelGGL(hymba_fwd, dim3(grid), dim3(NWAVES * 64), LDS_BYTES, stream, a);
#else
    for (int p = 0; p < N_PHASES; ++p) { a.ph_lo = p; a.ph_hi = p + 1; hipLaunchKernelGGL(hymba_fwd, dim3(grid), dim3(NWAVES * 64), LDS_BYTES, stream, a); }
#endif
    const hipError_t le = hipPeekAtLastError();
    if (le != hipSuccess) fprintf(stderr, "kernel_launch: launch failed: %s\n", hipGetErrorName(le));
}
```

```cpp
#include <hip/hip_runtime.h>
#include <cstdio>
#include <cstdint>
namespace pg8 {
#define PG8_LAS __attribute__((address_space(3)))
typedef unsigned short bf16_t;
typedef short bf16x8 __attribute__((ext_vector_type(8)));
typedef float f32x4 __attribute__((ext_vector_type(4)));
typedef unsigned u32x4 __attribute__((ext_vector_type(4)));
typedef unsigned u32x2 __attribute__((ext_vector_type(2)));
constexpr int BM = 256, BK = 64, HALF = 128, HTB = HALF * BK * 2  , STAGE_BYTES = 8 * HTB, NXCD = 8, WGM = 8;

__host__ __device__ __forceinline__ int lds_byte(int r, int c) { const int st = (r >> 4) * 2 + (c >> 5), rr = r & 15, cc = c & 31, ob = rr * 64 + cc * 2; return st * 1024 + (ob ^ (((ob >> 9) & 1) << 5)); }
__host__ __device__ __forceinline__ void stage_rc(int b, int& R, int& C) { const int st = b / 1024, sb = b % 1024, swz = sb ^ (((sb >> 9) & 1) << 5); R = (st >> 1) * 16 + swz / 64; C = (st & 1) * 32 + (swz % 64) / 2; }
__host__ __device__ __forceinline__ int perm32(int rho) { const int n = rho >> 4, i = rho & 15; return 8 * (i >> 2) + 4 * n + (i & 3); }

struct Unit { int pm, pn; };
struct Gemm { const bf16_t* A; const bf16_t* Bt; int M, N, K; };

struct StaticOrder {
    int nM, nN, nwg, G, c;
    __host__ __device__ __forceinline__ void init(int M, int N, int G_, int c_) { nM = M / BM; nN = N / BM; nwg = nM * nN; G = G_; c = c_; }
    __host__ __device__ __forceinline__ bool next(int i, Unit& u) const {
        const long L = (long)i * G + c; if (L >= nwg) return false;
        int wgid = (int)L; { const int q = nwg / NXCD, r = nwg % NXCD, xcd = wgid % NXCD, off = wgid / NXCD; wgid = (xcd < r ? xcd * (q + 1) : r * (q + 1) + (xcd - r) * q) + off; }
        const int nig = WGM * nN, gid = wgid / nig, fm = gid * WGM, gsz = (nM - fm) < WGM ? (nM - fm) : WGM;
        u.pm = fm + ((wgid % nig) % gsz); u.pn = (wgid % nig) / gsz; return true;
    }
    __device__ __forceinline__ void a_ready(const Unit&) const {}
    __device__ __forceinline__ void done(const Unit&) const {}
};

__device__ __forceinline__ unsigned cvt_pk_bf16(float lo, float hi) { unsigned r; asm volatile("v_cvt_pk_bf16_f32 %0, %1, %2" : "=v"(r) : "v"(lo), "v"(hi)); return r; }
typedef float f32x2 __attribute__((ext_vector_type(2)));
#ifndef HB_NT
#define HB_NT 0
#endif
typedef unsigned u32x2 __attribute__((ext_vector_type(2)));
__device__ __forceinline__ int olane() { int lane; asm volatile("v_mbcnt_lo_u32_b32 %0, -1, 0\n\tv_mbcnt_hi_u32_b32 %0, -1, %0" : "=v"(lane)); return lane; }
__device__ __forceinline__ int otid(int wave_s) { return wave_s * 64 + olane(); }
template <int K> __device__ __forceinline__ float sx(float v) { static_assert(K > 0 && K < 32, "sx"); return __int_as_float(__builtin_amdgcn_ds_swizzle(__float_as_int(v), (K << 10) | 0x1f)); }
__device__ __forceinline__ float add32(float v) { auto rr = __builtin_amdgcn_permlane32_swap(__float_as_uint(v), __float_as_uint(v), false, false); return __uint_as_float(rr[0]) + __uint_as_float(rr[1]); }
__device__ __forceinline__ float max16(float v) { auto rr = __builtin_amdgcn_permlane16_swap(__float_as_uint(v), __float_as_uint(v), false, false); return __builtin_fmaxf(__uint_as_float(rr[0]), __uint_as_float(rr[1])); }
__device__ __forceinline__ float add16(float v) { auto rr = __builtin_amdgcn_permlane16_swap(__float_as_uint(v), __float_as_uint(v), false, false); return __uint_as_float(rr[0]) + __uint_as_float(rr[1]); }
__device__ __forceinline__ float max32(float v) { auto rr = __builtin_amdgcn_permlane32_swap(__float_as_uint(v), __float_as_uint(v), false, false); return __builtin_fmaxf(__uint_as_float(rr[0]), __uint_as_float(rr[1])); }
__device__ __forceinline__ float other32(float v, int hi) { auto rr = __builtin_amdgcn_permlane32_swap(__float_as_uint(v), __float_as_uint(v), false, false); return __uint_as_float(hi ? rr[0] : rr[1]); }
__device__ __forceinline__ float log1p_small(float e) { const float u = 1.f + e, d = u - 1.f; return d == 0.f ? e : __logf(u) * (e * __builtin_amdgcn_rcpf(d)); }
typedef int i32x4 __attribute__((ext_vector_type(4)));
template <bool INT8> __device__ __forceinline__ f32x4 mma16(bf16x8 b, bf16x8 a, f32x4 c) {
    if constexpr (INT8) return __builtin_bit_cast(f32x4, __builtin_amdgcn_mfma_i32_16x16x64_i8(__builtin_bit_cast(i32x4, b), __builtin_bit_cast(i32x4, a), __builtin_bit_cast(i32x4, c), 0, 0, 0));
    else return __builtin_amdgcn_mfma_f32_16x16x32_bf16(b, a, c, 0, 0, 0);
}
struct EpiSwiGLU {
    static constexpr bool PERM = true, AFTER_DRAIN = false, INT8 = false;
    bf16_t* O; int ldc; const PG8_LAS float* rs;
    __device__ __forceinline__ void operator()(const f32x4 (&acc)[2][2][4][2], const Unit& u_in, int wr, int wc, int fr, int fq) const {
        Unit u = u_in; asm volatile("" : "+s"(u.pm), "+s"(u.pn));
        const int row0 = u.pm * BM + wr * 64 + fr, col0 = u.pn * HALF + wc * 32 + 8 * fq;
#pragma unroll
        for (int ai = 0; ai < 2; ++ai)
#pragma unroll
            for (int m = 0; m < 4; ++m) {
                const float s = rs[ai * HALF + wr * 64 + m * 16 + fr];
                float h[8];
#pragma unroll
                for (int n = 0; n < 2; ++n)
#pragma unroll
                    for (int e = 0; e < 4; ++e) { const float g = acc[ai][0][m][n][e] * s, uu = acc[ai][1][m][n][e] * s;
                        h[4 * n + e] = g * __builtin_amdgcn_rcpf(1.f + __expf(-g)) * uu; }
                u32x4 w; w.x = cvt_pk_bf16(h[0], h[1]); w.y = cvt_pk_bf16(h[2], h[3]); w.z = cvt_pk_bf16(h[4], h[5]); w.w = cvt_pk_bf16(h[6], h[7]);
#if HB_NT
                __builtin_nontemporal_store(w, (u32x4*)(O + (size_t)(row0 + ai * HALF + m * 16) * ldc + col0)); }
#else
                *(u32x4*)(O + (size_t)(row0 + ai * HALF + m * 16) * ldc + col0) = w; }
#endif
    }
};
struct EpiSwiGLUq {
    static constexpr bool PERM = true, AFTER_DRAIN = false, INT8 = true;
    unsigned char* Q; int ldc; const PG8_LAS float* rsa; const float* sw; float* BS;
    __device__ __forceinline__ void operator()(const f32x4 (&acc)[2][2][4][2], const Unit& u_in, int wr, int wc, int fr, int fq) const {
        Unit u = u_in; asm volatile("" : "+s"(u.pm), "+s"(u.pn));
        const int row0 = u.pm * BM + wr * 64 + fr, col0 = u.pn * HALF + wc * 32 + 8 * fq, n0 = u.pn * BM + wc * 32 + 8 * fq;
        f32x2 SG[2][2], SU[2][2];
        { const f32x4 sg0 = *(const f32x4*)(sw + n0), sg1 = *(const f32x4*)(sw + n0 + 4), su0 = *(const f32x4*)(sw + n0 + HALF), su1 = *(const f32x4*)(sw + n0 + HALF + 4);
          SG[0][0] = f32x2{sg0[0], sg0[1]}; SG[0][1] = f32x2{sg0[2], sg0[3]}; SG[1][0] = f32x2{sg1[0], sg1[1]}; SG[1][1] = f32x2{sg1[2], sg1[3]};
          SU[0][0] = f32x2{su0[0], su0[1]}; SU[0][1] = f32x2{su0[2], su0[3]}; SU[1][0] = f32x2{su1[0], su1[1]}; SU[1][1] = f32x2{su1[2], su1[3]}; }
        float srow[8];
#pragma unroll
        for (int j = 0; j < 8; ++j) srow[j] = rsa[(j >> 2) * HALF + wr * 64 + (j & 3) * 16 + fr];
#pragma unroll
        for (int ai = 0; ai < 2; ++ai)
#pragma unroll
            for (int m = 0; m < 4; ++m) {
                const float s = srow[ai * 4 + m];
                const float tsc = s * -1.4426950408889634f; const f32x2 ts = {tsc, tsc};
                f32x2 hp[4];
#pragma unroll
                for (int n = 0; n < 2; ++n) { const i32x4 ig = __builtin_bit_cast(i32x4, acc[ai][0][m][n]), iu = __builtin_bit_cast(i32x4, acc[ai][1][m][n]);
#pragma unroll
                    for (int ep = 0; ep < 2; ++ep) {
                        const f32x2 G = f32x2{(float)ig[2 * ep], (float)ig[2 * ep + 1]} * SG[n][ep], U = f32x2{(float)iu[2 * ep], (float)iu[2 * ep + 1]} * SU[n][ep];
                        const f32x2 T = G * ts;
                        const f32x2 Dn = f32x2{__builtin_amdgcn_exp2f(T[0]), __builtin_amdgcn_exp2f(T[1])} + f32x2{1.f, 1.f};
                        const f32x2 R = {__builtin_amdgcn_rcpf(Dn[0]), __builtin_amdgcn_rcpf(Dn[1])};
                        hp[2 * n + ep] = (G * U) * R; } }
                float bm = __builtin_fmaxf(__builtin_fmaxf(__builtin_fabsf(hp[0][0]), __builtin_fabsf(hp[0][1])), __builtin_fmaxf(__builtin_fabsf(hp[1][0]), __builtin_fabsf(hp[1][1])));
                bm = __builtin_fmaxf(bm, __builtin_fmaxf(__builtin_fmaxf(__builtin_fabsf(hp[2][0]), __builtin_fabsf(hp[2][1])), __builtin_fmaxf(__builtin_fabsf(hp[3][0]), __builtin_fabsf(hp[3][1]))));
                bm = max32(max16(bm));
                const float inv = bm > 1e-30f ? 127.f * __builtin_amdgcn_rcpf(bm) : 0.f;
                const f32x2 iv = {inv, inv}, mg = {12582912.f, 12582912.f};
                u32x2 o;
#pragma unroll
                for (int hh = 0; hh < 2; ++hh) {
                    const f32x2 ta = hp[2 * hh] * iv + mg, tb = hp[2 * hh + 1] * iv + mg;
                    o[hh] = __builtin_amdgcn_perm(__builtin_amdgcn_perm(__float_as_uint(tb[1]), __float_as_uint(tb[0]), 0x0c0c0400u), __builtin_amdgcn_perm(__float_as_uint(ta[1]), __float_as_uint(ta[0]), 0x0c0c0400u), 0x05040100u); }
                const size_t row = (size_t)(row0 + ai * HALF + m * 16);
                *(u32x2*)(Q + row * ldc + col0) = o;
                if (fq == 0) BS[row * (ldc >> 5) + (col0 >> 5)] = bm > 1e-30f ? (s * s) * bm * (1.f / 127.f) : 0.f; }
    }
};
__device__ __forceinline__ float res_dec(unsigned hb16, int q) {
    const int E = (int)((hb16 >> 7) & 0xffu) - 15; const float sc = __uint_as_float((unsigned)(E > 0 ? E : 0) << 23);
    return __uint_as_float(hb16 << 16) + (float)q * sc;
}
__device__ __forceinline__ int res_enc(float v, unsigned hb16) {
    const int E = (int)((hb16 >> 7) & 0xffu); const float inv = __uint_as_float((unsigned)(269 - E) << 23);
    const float r = (v - __uint_as_float(hb16 << 16)) * inv; const float c = fminf(fmaxf(__builtin_rintf(r), -127.f), 127.f);
    return E >= 15 ? (int)c : 0;
}
#ifndef RES_LO
#define RES_LO 2
#endif
template <bool Q> struct EpiRes {
    static constexpr bool PERM = true, AFTER_DRAIN = false, INT8 = Q;
    bf16_t* xh; unsigned char* xl; float* ss; float alpha; const PG8_LAS float* rowsc; const float* colsc;
    __device__ __forceinline__ void operator()(const f32x4 (&acc)[2][2][4][2], const Unit& u_in, int wr, int wc, int fr, int fq) const {
        Unit u = u_in; asm volatile("" : "+s"(u.pm), "+s"(u.pn));
        const int row0 = u.pm * BM + wr * 64 + fr, col0 = u.pn * BM + wc * 32 + 8 * fq;
        f32x4 cs[2][2];
        if constexpr (Q) {
#pragma unroll
            for (int bj = 0; bj < 2; ++bj) { cs[bj][0] = *(const f32x4*)(colsc + col0 + bj * HALF); cs[bj][1] = *(const f32x4*)(colsc + col0 + bj * HALF + 4); } }
#pragma unroll
        for (int am = 0; am < 4; ++am) { const int ai = am >> 1, mb = (am & 1) * 2;
            u32x4 h[2][2]; u32x2 l[2][2];
#pragma unroll
            for (int mm = 0; mm < 2; ++mm)
#pragma unroll
                for (int bj = 0; bj < 2; ++bj) { const size_t off = (size_t)(row0 + ai * HALF + (mb + mm) * 16) * 2048 + col0 + bj * HALF;
                    h[mm][bj] = *(const u32x4*)(xh + off); if (RES_LO) l[mm][bj] = *(const u32x2*)(xl + off); }
#pragma unroll
            for (int mm = 0; mm < 2; ++mm) { const int m = mb + mm;
                const int row = row0 + ai * HALF + m * 16; float sq = 0.f;
#pragma unroll
                for (int bj = 0; bj < 2; ++bj) { const size_t off = (size_t)row * 2048 + col0 + bj * HALF;
                    float v[8];
#pragma unroll
                    for (int i = 0; i < 8; ++i) { const unsigned hb = (i & 1) ? (h[mm][bj][i >> 1] >> 16) : (h[mm][bj][i >> 1] & 0xffffu);
                        if (RES_LO == 2) v[i] = __uint_as_float(__builtin_amdgcn_perm(h[mm][bj][i >> 1], l[mm][bj][i >> 2], ((5u + 2u * (i & 1)) << 24) | ((4u + 2u * (i & 1)) << 16) | ((unsigned)(i & 3) << 8) | 0x0cu));
                        else if (RES_LO == 1) { const int q = (int)(l[mm][bj][i >> 2] << (24 - 8 * (i & 3))) >> 24; v[i] = res_dec(hb, q); }
                        else v[i] = __uint_as_float(hb << 16); }
                    if constexpr (Q) { const float rsc = rowsc[ai * HALF + wr * 64 + m * 16 + fr] * alpha; const i32x4 i0 = __builtin_bit_cast(i32x4, acc[ai][bj][m][0]), i1 = __builtin_bit_cast(i32x4, acc[ai][bj][m][1]);
#pragma unroll
                        for (int e2 = 0; e2 < 4; ++e2) { v[e2] += (float)i0[e2] * (rsc * cs[bj][0][e2]); v[4 + e2] += (float)i1[e2] * (rsc * cs[bj][1][e2]); } }
                    else {
#pragma unroll
                        for (int e2 = 0; e2 < 4; ++e2) { v[e2] += acc[ai][bj][m][0][e2] * alpha; v[4 + e2] += acc[ai][bj][m][1][e2] * alpha; } }
                    u32x4 nh; u32x2 nl = {0u, 0u};
                    if (RES_LO == 2) { unsigned uu[8];
#pragma unroll
                        for (int i = 0; i < 8; ++i) uu[i] = __float_as_uint(v[i]) + 0x80u;
#pragma unroll
                        for (int e2 = 0; e2 < 4; ++e2) nh[e2] = __builtin_amdgcn_perm(uu[2 * e2 + 1], uu[2 * e2], 0x07060302u);
#pragma unroll
                        for (int q2 = 0; q2 < 2; ++q2) nl[q2] = __builtin_amdgcn_perm(__builtin_amdgcn_perm(uu[4 * q2 + 3], uu[4 * q2 + 2], 0x0c0c0501u), __builtin_amdgcn_perm(uu[4 * q2 + 1], uu[4 * q2], 0x0c0c0501u), 0x05040100u);
                    } else {
#pragma unroll
                    for (int e2 = 0; e2 < 4; ++e2) nh[e2] = cvt_pk_bf16(v[2 * e2], v[2 * e2 + 1]); }
                    if (RES_LO == 1) {
#pragma unroll
                    for (int i = 0; i < 8; ++i) { const unsigned hb = (i & 1) ? (nh[i >> 1] >> 16) : (nh[i >> 1] & 0xffffu);
                        nl[i >> 2] |= ((unsigned)res_enc(v[i], hb) & 0xffu) << (8 * (i & 3)); } }
                    *(u32x4*)(xh + off) = nh; if (RES_LO) *(u32x2*)(xl + off) = nl;
                    sq += (v[0] * v[0] + v[1] * v[1]) + (v[2] * v[2] + v[3] * v[3]) + (v[4] * v[4] + v[5] * v[5]) + (v[6] * v[6] + v[7] * v[7]); }
                sq = add32(add16(sq));
                if (fq == 0) ss[(size_t)row * 32 + u.pn * 4 + wc] = sq; }
        }
    }
};
template <bool Q> struct EpiMix {
    static constexpr bool PERM = true, AFTER_DRAIN = false, INT8 = Q;
    bf16_t* P; int ldc; const PG8_LAS float* rs; float* F; const float* fb; const float* colsc; float* KN;
    __device__ __forceinline__ f32x4 val(const f32x4& a, float s, const f32x4& c) const {
        if constexpr (Q) { const i32x4 i = __builtin_bit_cast(i32x4, a); return (f32x4){(float)i[0], (float)i[1], (float)i[2], (float)i[3]} * (c * s); }
        else return a * s;
    }
    __device__ __forceinline__ void operator()(const f32x4 (&acc)[2][2][4][2], const Unit& u_in, int wr, int wc, int fr, int fq) const {
        Unit u = u_in; asm volatile("" : "+s"(u.pm), "+s"(u.pn));
        const int row0 = u.pm * BM + wr * 64 + fr, col0 = u.pn * BM + wc * 32 + 8 * fq;
        f32x4 cs[2][2];
#pragma unroll
        for (int bj = 0; bj < 2; ++bj) { cs[bj][0] = Q ? *(const f32x4*)(colsc + col0 + bj * HALF) : (f32x4){1.f, 1.f, 1.f, 1.f}; cs[bj][1] = Q ? *(const f32x4*)(colsc + col0 + bj * HALF + 4) : (f32x4){1.f, 1.f, 1.f, 1.f}; }
        if (u.pn < 22) {
#pragma unroll
            for (int ai = 0; ai < 2; ++ai)
#pragma unroll
                for (int m = 0; m < 4; ++m) { const float s = rs[ai * HALF + wr * 64 + m * 16 + fr]; bf16_t* rowp = P + (size_t)(row0 + ai * HALF + m * 16) * ldc + col0;
#pragma unroll
                    for (int bj = 0; bj < 2; ++bj) { const f32x4 v0 = val(acc[ai][bj][m][0], s, cs[bj][0]), v1 = val(acc[ai][bj][m][1], s, cs[bj][1]);
                        u32x4 w; w.x = cvt_pk_bf16(v0[0], v0[1]); w.y = cvt_pk_bf16(v0[2], v0[3]); w.z = cvt_pk_bf16(v1[0], v1[1]); w.w = cvt_pk_bf16(v1[2], v1[3]);
                        *(u32x4*)(rowp + bj * HALF) = w; } }
            if ((unsigned)(u.pn - 10) < 4u) {
#pragma unroll
                for (int ai = 0; ai < 2; ++ai)
#pragma unroll
                    for (int m = 0; m < 4; ++m) { const float s = rs[ai * HALF + wr * 64 + m * 16 + fr]; const int rw = row0 + ai * HALF + m * 16; float* kp = KN + ((size_t)((rw >> 12) * 8 + 2 * (u.pn - 10)) * 4 + wc) * 4096 + (rw & 4095);
#pragma unroll
                        for (int bj = 0; bj < 2; ++bj) { const f32x4 v0 = val(acc[ai][bj][m][0], s, cs[bj][0]), v1 = val(acc[ai][bj][m][1], s, cs[bj][1]);
                            float sq = ((v0[0] * v0[0] + v0[1] * v0[1]) + (v0[2] * v0[2] + v0[3] * v0[3])) + ((v1[0] * v1[0] + v1[1] * v1[1]) + (v1[2] * v1[2] + v1[3] * v1[3]));
                            sq = add32(add16(sq));
                            if (fq == 0) kp[4 * 4096 * bj] = sq; } }
            }
        } else if (wc == 0 && fq == 0) {
            const f32x4 b0 = *(const f32x4*)fb, b1 = *(const f32x4*)(fb + 4);
#pragma unroll
            for (int ai = 0; ai < 2; ++ai)
#pragma unroll
                for (int m = 0; m < 4; ++m) { const float s = rs[ai * HALF + wr * 64 + m * 16 + fr]; const int rw = row0 + ai * HALF + m * 16; float* fp = F + (size_t)((rw >> 12) * 8) * 4096 + (rw & 4095);
                    const f32x4 z0 = val(acc[ai][0][m][0], s, cs[0][0]) + b0, z1 = val(acc[ai][0][m][1], s, cs[0][1]) + b1; f32x4 l0, l1;
#pragma unroll
                    for (int e = 0; e < 4; ++e) { l0[e] = fminf(z0[e], 0.f) - log1p_small(__expf(-fabsf(z0[e]))); l1[e] = fminf(z1[e], 0.f) - log1p_small(__expf(-fabsf(z1[e]))); }

#pragma unroll
                    for (int e = 0; e < 4; ++e) { fp[e * 4096] = l0[e]; fp[(4 + e) * 4096] = l1[e]; } }
        }
    }
};

template <class Epi, class Sched, bool ALIGN_EPI = false, bool SP2 = false>
__device__ __forceinline__ void gemm_phase(PG8_LAS unsigned char* lds, const Gemm g, const Sched& S, const Epi& E, int wave_s) {
    const int tid = otid(wave_s), wid = __builtin_amdgcn_readfirstlane(tid >> 6), lane = tid & 63, wr = wid >> 2, wc = wid & 3, fr = lane & 15, fq = lane >> 4;
    const int K = g.K, nt = K / BK;
    unsigned voffA[2], voffB[2];
#pragma unroll
    for (int i = 0; i < 2; ++i) { int R, C; stage_rc(tid * 16 + i * 8192, R, C); const int Rb = Epi::PERM ? ((R & ~31) + perm32(R & 31)) : R;
        voffA[i] = (unsigned)(R * K + C) * 2u; voffB[i] = (unsigned)(Rb * K + C) * 2u; }
    const size_t kstep = (size_t)(BK * 2);
    const size_t hstep = (size_t)HALF * K * 2;
    const size_t tstep = 2 * hstep;
    const unsigned ldsw = (unsigned)wid * 1024u;
    const int aoff = lds_byte(wr * 64 + fr, fq * 8), boff = lds_byte(wc * 32 + fr, fq * 8);
#define PG8_SA(b, h) (((b) * 2 + (h)) * HTB)
#define PG8_SB(b, h) ((4 + (b) * 2 + (h)) * HTB)
#define PG8_STAGE(bufoff, gbase, voff) do { _Pragma("unroll") for (int _i = 0; _i < 2; ++_i) \
        __builtin_amdgcn_global_load_lds((const unsigned*)((const char*)(gbase) + (voff)[_i]), (PG8_LAS unsigned*)(lds + (bufoff) + ldsw + _i * 8192), 16, 0, 0); } while (0)
#define PG8_LDA(dst, b, h) do { _Pragma("unroll") for (int m = 0; m < 4; ++m) _Pragma("unroll") for (int k = 0; k < 2; ++k) dst[m][k] = *(const PG8_LAS bf16x8*)(lds + PG8_SA(b, h) + aoff + m * 2048 + k * 1024); } while (0)
#define PG8_LDB(dst, b, h) do { _Pragma("unroll") for (int n = 0; n < 2; ++n) _Pragma("unroll") for (int k = 0; k < 2; ++k) dst[n][k] = *(const PG8_LAS bf16x8*)(lds + PG8_SB(b, h) + boff + n * 2048 + k * 1024); } while (0)
#define PG8_MMA(ai, bj, At, Bt) do { __builtin_amdgcn_s_setprio(1); _Pragma("unroll") for (int m = 0; m < 4; ++m) _Pragma("unroll") for (int n = 0; n < 2; ++n) _Pragma("unroll") for (int k = 0; k < 2; ++k) \
        acc[ai][bj][m][n] = mma16<Epi::INT8>(Bt[n][k], At[m][k], acc[ai][bj][m][n]); __builtin_amdgcn_s_setprio(0); } while (0)
#define PG8_WAIT_V(n) asm volatile("s_waitcnt vmcnt(" #n ")" ::: "memory")
#define PG8_WAIT_L(n) asm volatile("s_waitcnt lgkmcnt(" #n ")" ::: "memory")
#define PG8_BAR __builtin_amdgcn_s_barrier()
#define PG8_SCHED __builtin_amdgcn_sched_barrier(0)
    Unit cur, nxt; int ui = 0;
    if (!S.next(0, cur)) return;
    f32x4 acc[2][2][4][2];
#pragma unroll
    for (int a = 0; a < 2; ++a)
#pragma unroll
        for (int b = 0; b < 2; ++b)
#pragma unroll
            for (int m = 0; m < 4; ++m)
#pragma unroll
                for (int n = 0; n < 2; ++n) acc[a][b][m][n] = (f32x4){0.f, 0.f, 0.f, 0.f};
    bf16x8 At[4][2], B0[2][2], B1[2][2];
    const char* cA = (const char*)g.A + (size_t)cur.pm * tstep; const char* cB = (const char*)g.Bt + (size_t)cur.pn * tstep;
    S.a_ready(cur);
    if constexpr (SP2) {
        PG8_STAGE(PG8_SB(0, 0), cB, voffB); PG8_STAGE(PG8_SB(0, 1), cB + hstep, voffB); PG8_STAGE(PG8_SA(0, 0), cA, voffA); PG8_STAGE(PG8_SA(0, 1), cA + hstep, voffA);
        if (wr == 1) PG8_BAR;
        PG8_WAIT_V(2); PG8_BAR;
        PG8_STAGE(PG8_SB(1, 0), cB + kstep, voffB); PG8_STAGE(PG8_SA(1, 0), cA + kstep, voffA); PG8_STAGE(PG8_SB(1, 1), cB + hstep + kstep, voffB);
        PG8_WAIT_V(6); PG8_BAR;
    } else {
        PG8_STAGE(PG8_SB(0, 0), cB, voffB); PG8_STAGE(PG8_SA(0, 0), cA, voffA); PG8_STAGE(PG8_SB(0, 1), cB + hstep, voffB); PG8_STAGE(PG8_SA(0, 1), cA + hstep, voffA);
        if (wr == 1) PG8_BAR;
        PG8_WAIT_V(4); PG8_BAR;
        PG8_STAGE(PG8_SB(1, 0), cB + kstep, voffB); PG8_STAGE(PG8_SA(1, 0), cA + kstep, voffA); PG8_STAGE(PG8_SB(1, 1), cB + hstep + kstep, voffB);
        PG8_WAIT_V(6); PG8_BAR;
    }
    for (;;) {
        const bool has_next = S.next(ui + 1, nxt);
        const char* nA = has_next ? (const char*)g.A + (size_t)nxt.pm * tstep : cA; const char* nB = has_next ? (const char*)g.Bt + (size_t)nxt.pn * tstep : cB;
        for (int t = 0; t < nt; t += 2) {
            const bool last = (t == nt - 2);
            const char* a1 = cA + (size_t)(t + 1) * kstep;
            const char* a2 = last ? nA : cA + (size_t)(t + 2) * kstep; const char* b2 = last ? nB : cB + (size_t)(t + 2) * kstep;
            const char* a3 = a2 + kstep; const char* b3 = b2 + kstep;
            if (last && has_next) S.a_ready(nxt);
            if constexpr (SP2) {
            PG8_LDB(B0, 0, 0); PG8_LDB(B1, 0, 1); PG8_SCHED; PG8_LDA(At, 0, 0); PG8_STAGE(PG8_SA(1, 1), a1 + hstep, voffA);
            PG8_WAIT_V(8); PG8_WAIT_L(0); PG8_BAR; PG8_MMA(0, 0, At, B0); PG8_MMA(0, 1, At, B1); PG8_BAR; PG8_SCHED;
            PG8_LDA(At, 0, 1); PG8_STAGE(PG8_SB(0, 0), b2, voffB); PG8_STAGE(PG8_SB(0, 1), b2 + hstep, voffB); PG8_STAGE(PG8_SA(0, 0), a2, voffA);
            PG8_WAIT_V(8); PG8_WAIT_L(0); PG8_BAR; PG8_MMA(1, 0, At, B0); PG8_MMA(1, 1, At, B1); PG8_BAR; PG8_SCHED;
            PG8_LDB(B0, 1, 0); PG8_LDB(B1, 1, 1); PG8_SCHED; PG8_LDA(At, 1, 0); PG8_STAGE(PG8_SA(0, 1), a2 + hstep, voffA);
            PG8_WAIT_V(8); PG8_WAIT_L(0); PG8_BAR; PG8_MMA(0, 0, At, B0); PG8_MMA(0, 1, At, B1); PG8_BAR; PG8_SCHED;
            PG8_LDA(At, 1, 1); PG8_STAGE(PG8_SB(1, 0), b3, voffB); PG8_STAGE(PG8_SB(1, 1), b3 + hstep, voffB); PG8_STAGE(PG8_SA(1, 0), a3, voffA);
            PG8_WAIT_V(8); PG8_WAIT_L(0); PG8_BAR; PG8_MMA(1, 0, At, B0); PG8_MMA(1, 1, At, B1); PG8_BAR; PG8_SCHED;
            } else {
            PG8_LDB(B0, 0, 0); PG8_SCHED; PG8_LDA(At, 0, 0); PG8_STAGE(PG8_SA(1, 1), a1 + hstep, voffA);
            PG8_WAIT_L(8); PG8_BAR; PG8_WAIT_L(0); PG8_MMA(0, 0, At, B0); PG8_BAR; PG8_SCHED;
            PG8_LDB(B1, 0, 1); PG8_STAGE(PG8_SB(0, 0), b2, voffB);
            PG8_BAR; PG8_WAIT_L(0); PG8_MMA(0, 1, At, B1); PG8_BAR;
            PG8_LDA(At, 0, 1); PG8_STAGE(PG8_SA(0, 0), a2, voffA);
            PG8_BAR; PG8_WAIT_L(0); PG8_MMA(1, 0, At, B0); PG8_BAR; PG8_SCHED;
            PG8_STAGE(PG8_SB(0, 1), b2 + hstep, voffB);
            PG8_WAIT_V(6); PG8_BAR; PG8_MMA(1, 1, At, B1); PG8_BAR;
            PG8_LDB(B0, 1, 0); PG8_SCHED; PG8_LDA(At, 1, 0); PG8_STAGE(PG8_SA(0, 1), a2 + hstep, voffA);
            PG8_WAIT_L(8); PG8_BAR; PG8_WAIT_L(0); PG8_MMA(0, 0, At, B0); PG8_BAR; PG8_SCHED;
            PG8_LDB(B1, 1, 1); PG8_STAGE(PG8_SB(1, 0), b3, voffB);
            PG8_BAR; PG8_WAIT_L(0); PG8_MMA(0, 1, At, B1); PG8_BAR;
            PG8_LDA(At, 1, 1); PG8_STAGE(PG8_SA(1, 0), a3, voffA);
            PG8_BAR; PG8_WAIT_L(0); PG8_MMA(1, 0, At, B0); PG8_BAR; PG8_SCHED;
            PG8_STAGE(PG8_SB(1, 1), b3 + hstep, voffB);
            PG8_WAIT_V(6); PG8_BAR; PG8_MMA(1, 1, At, B1); PG8_BAR;
            }
        }
        if constexpr (ALIGN_EPI) { if (wr == 0) PG8_BAR; }
        if constexpr (!Epi::AFTER_DRAIN) { E(acc, cur, wr, wc, fr, fq); S.done(cur); }
        if (!has_next) break;
#pragma unroll
        for (int a = 0; a < 2; ++a)
#pragma unroll
            for (int b = 0; b < 2; ++b)
#pragma unroll
                for (int m = 0; m < 4; ++m)
#pragma unroll
                    for (int n = 0; n < 2; ++n) acc[a][b][m][n] = (f32x4){0.f, 0.f, 0.f, 0.f};
        cur = nxt; cA = nA; cB = nB; ++ui;
        if constexpr (ALIGN_EPI) { if (wr == 1) PG8_BAR; }
    }
    PG8_WAIT_V(0);
    if constexpr (!ALIGN_EPI) { if (wr == 0) PG8_BAR; }
    PG8_BAR;
    if constexpr (Epi::AFTER_DRAIN) { E.fused(acc, cur, wr, wc, fr, fq, lds, wid, lane); S.done(cur); }
#undef PG8_SA
#undef PG8_SB
#undef PG8_STAGE
#undef PG8_LDA
#undef PG8_LDB
#undef PG8_MMA
#undef PG8_WAIT_V
#undef PG8_WAIT_L
#undef PG8_BAR
#undef PG8_SCHED
}
}
#ifndef ATT_QKT_SPLIT
#define ATT_QKT_SPLIT 4
#endif
#ifndef ATT_PP
#define ATT_PP 1
#endif
#ifndef ATT_PIPE
#define ATT_PIPE 0
#endif
#ifndef ATT_SEAM
#define ATT_SEAM 0
#endif
#ifndef ATT_NOTAB
#define ATT_NOTAB 0
#endif
#ifndef ATT_NOSQ
#define ATT_NOSQ 0
#endif
namespace att {
typedef unsigned short bf16;
typedef short bf16x8 __attribute__((ext_vector_type(8)));
typedef short s16x4 __attribute__((ext_vector_type(4)));
typedef float f32x16 __attribute__((ext_vector_type(16)));
typedef float f32x4 __attribute__((ext_vector_type(4)));
typedef unsigned u32x4 __attribute__((ext_vector_type(4)));
constexpr int D = 128, NW = 8, QBLK = 32, KVBLK = 64, QB = NW * QBLK;
constexpr int PITCH = 5632, OPITCH = 1024, SEQ = 4096;
constexpr int SHM_V = KVBLK * D * 2, SHM_K = KVBLK * D * 2;
constexpr int OFF_WS = 2 * SHM_V + 2 * SHM_K, OFF_TAB = OFF_WS + NW * 64 * 4, OFF_WT = OFF_TAB + SEQ * 4, OFF_OST = OFF_WT + 64, LDS_BYTES = OFF_OST + NW * 4096;
#ifndef ATT_THR
#define ATT_THR 8.f
#endif
constexpr float SCALE = 0.08838834764831845f, THR = ATT_THR;
constexpr unsigned WBIG = 0x40000000u;

#define KSWZ(row, colB) ((row) * 256 + ((colB) ^ (((row) & 7) << 4)))
#define SBAR() __builtin_amdgcn_sched_barrier(0)
__device__ __forceinline__ int v_st(int k, int c) { const int kk = (k & ~0xC) | ((k & 4) << 1) | ((k & 8) >> 1); return ((kk >> 3) * 4 + (c >> 5)) * 512 + ((kk & 7) * 32 + (c & 31)) * 2; }
__device__ __forceinline__ int v_rd_base(int lane) { return ((lane & 3) << 3) | (((lane >> 2) & 3) << 6) | (((lane >> 4) & 1) << 5) | (((lane >> 5) & 1) << 8); }
constexpr int v_rd_off(int d0, int ks, int half) { return d0 * 512 + ks * 4096 + half * 2048; }
__device__ __forceinline__ int crow(int r, int hi) { return (r & 3) + 8 * (r >> 2) + 4 * hi; }
__device__ __forceinline__ unsigned cvtpk(float lo, float hi) { unsigned r; asm volatile("v_cvt_pk_bf16_f32 %0, %1, %2" : "=v"(r) : "v"(lo), "v"(hi)); return r; }
__device__ __forceinline__ bf16x8 load8(const bf16* p) { return *reinterpret_cast<const bf16x8*>(p); }
__device__ __forceinline__ void mask_tile(f32x16& p0, f32x16& p1, int dq) {
    const float NEG = -__builtin_inff();
#pragma unroll
    for (int r = 0; r < 16; ++r) {
        const int c = (r & 3) + 8 * (r >> 2);
        if ((unsigned)(dq - c) >= WBIG) p0[r] = NEG;
        if ((unsigned)(dq - c - 32) >= WBIG) p1[r] = NEG;
    }
}
#ifndef ATT_VSKIP
#define ATT_VSKIP 20.f
#endif
template <bool VS = true> __device__ __forceinline__ void partialSM(f32x16& p0, f32x16& p1, float& m_reg, float& mn, float& alpha, bool& skip) {
    float pmax = p0[0];
#pragma unroll
    for (int r = 1; r < 16; ++r) pmax = fmaxf(pmax, p0[r]);
#pragma unroll
    for (int r = 0; r < 16; ++r) pmax = fmaxf(pmax, p1[r]);
    { auto rr = __builtin_amdgcn_permlane32_swap(__float_as_uint(pmax), __float_as_uint(pmax), false, false);
      pmax = fmaxf(__uint_as_float(rr[0]), __uint_as_float(rr[1])); }
    constexpr float C2 = 1.4426950408889634f * SCALE;
    skip = VS && __all((pmax - m_reg) * SCALE <= -ATT_VSKIP) != 0;
    if (skip) { mn = m_reg; alpha = 1.f; return; }
    if (__builtin_expect(__all((pmax - m_reg) * SCALE <= THR), 1)) { mn = m_reg; alpha = 1.f; }
    else { mn = fmaxf(m_reg, pmax); alpha = __builtin_amdgcn_exp2f((m_reg - mn) * C2); m_reg = mn; }
    const float mnL = -mn * C2;
#pragma unroll
    for (int r = 0; r < 16; ++r) p0[r] = fmaf(p0[r], C2, mnL);
#pragma unroll
    for (int r = 0; r < 16; ++r) p1[r] = fmaf(p1[r], C2, mnL);
#pragma unroll
    for (int r = 0; r < 16; ++r) p0[r] = __builtin_amdgcn_exp2f(p0[r]);
}
__device__ __forceinline__ void partialSM(f32x16& p0, f32x16& p1, float& m_reg, float& mn, float& alpha) { bool sk_; partialSM<false>(p0, p1, m_reg, mn, alpha, sk_); }
__device__ __forceinline__ void finishSM(f32x16& p0, f32x16& p1, float alpha, float& l_reg, bf16x8& pa0, bf16x8& pa1, bf16x8& pa2, bf16x8& pa3) {
#pragma unroll
    for (int r = 0; r < 16; ++r) p1[r] = __builtin_amdgcn_exp2f(p1[r]);
    float ps = 0;
#pragma unroll
    for (int r = 0; r < 16; ++r) ps += p0[r];
#pragma unroll
    for (int r = 0; r < 16; ++r) ps += p1[r];
    { auto rr = __builtin_amdgcn_permlane32_swap(__float_as_uint(ps), __float_as_uint(ps), false, false);
      ps = __uint_as_float(rr[0]) + __uint_as_float(rr[1]); }
    l_reg = l_reg * alpha + ps;
#define PK4(P, B_, OUT) do { unsigned a0 = cvtpk(P[B_+0], P[B_+1]), a1 = cvtpk(P[B_+2], P[B_+3]);                          \
        unsigned b0 = cvtpk(P[B_+4], P[B_+5]), b1 = cvtpk(P[B_+6], P[B_+7]);                                             \
        auto r0 = __builtin_amdgcn_permlane32_swap(a0, b0, false, false); auto r1 = __builtin_amdgcn_permlane32_swap(a1, b1, false, false); \
        u32x4 w = {r0[0], r1[0], r0[1], r1[1]}; OUT = *reinterpret_cast<bf16x8*>(&w); } while (0)
    PK4(p0, 0, pa0); PK4(p0, 8, pa1); PK4(p1, 0, pa2); PK4(p1, 8, pa3);
#undef PK4
}
template <int KB>
__device__ __forceinline__ void qkt(f32x16& p0, f32x16& p1, const int (&ka)[4], const bf16x8* qr, const float* bt) {
#pragma unroll
    for (int g = 0; g < 4; ++g) { const f32x4 t0 = *reinterpret_cast<const f32x4*>(bt + 8 * g), t1 = *reinterpret_cast<const f32x4*>(bt + 32 + 8 * g);
#pragma unroll
        for (int e = 0; e < 4; ++e) { p0[4 * g + e] = t0[e]; p1[4 * g + e] = t1[e]; } }
#define KRD(dst, d0, half) asm volatile("ds_read_b128 %0, %1 offset:%2" : "=v"(dst) : "v"(ka[(d0) & 3]), "i"(KB * SHM_K + ((d0) >> 2) * 128 + (half) * 32 * 256) : "memory")
#define KW(n) do { asm volatile("s_waitcnt lgkmcnt(" #n ")" ::: "memory"); SBAR(); } while (0)
#define KMM(S, d0) do { p0 = __builtin_amdgcn_mfma_f32_32x32x16_bf16(S##a, qr[d0], p0, 0, 0, 0); p1 = __builtin_amdgcn_mfma_f32_32x32x16_bf16(S##b, qr[d0], p1, 0, 0, 0); SBAR(); } while (0)
    bf16x8 Xa, Xb, Ya, Yb, Za, Zb;
    SBAR();
    KRD(Xa, 0, 0); KRD(Xb, 0, 1); KRD(Ya, 1, 0); KRD(Yb, 1, 1);
    KRD(Za, 2, 0); KRD(Zb, 2, 1); KW(4); KMM(X, 0);
    KRD(Xa, 3, 0); KRD(Xb, 3, 1); KW(4); KMM(Y, 1);
    KRD(Ya, 4, 0); KRD(Yb, 4, 1); KW(4); KMM(Z, 2);
    KRD(Za, 5, 0); KRD(Zb, 5, 1); KW(4); KMM(X, 3);
    KRD(Xa, 6, 0); KRD(Xb, 6, 1); KW(4); KMM(Y, 4);
    KRD(Ya, 7, 0); KRD(Yb, 7, 1); KW(4); KMM(Z, 5);
    KW(2); KMM(X, 6);
    KW(0); KMM(Y, 7);
#undef KRD
#undef KW
#undef KMM
}
template <int VB>
__device__ __forceinline__ void pv_tile(f32x16* o, int vb0, bf16x8 pa0, bf16x8 pa1, bf16x8 pa2, bf16x8 pa3) {
#define TRRD(dst, off) asm volatile("ds_read_b64_tr_b16 %0, %1 offset:%2" : "=&v"(dst) : "v"(vb0), "i"(off) : "memory")
#define PV_LD(S, d0) do { constexpr int b_ = VB * SHM_V + v_rd_off(d0, 0, 0); \
        TRRD(S##l0, b_); TRRD(S##h0, b_ + 2048); TRRD(S##l1, b_ + 4096); TRRD(S##h1, b_ + 6144); TRRD(S##l2, b_ + 8192); TRRD(S##h2, b_ + 10240); TRRD(S##l3, b_ + 12288); TRRD(S##h3, b_ + 14336); } while (0)
#define PV_MM(S, d0) do { \
        o[d0] = __builtin_amdgcn_mfma_f32_32x32x16_bf16(pa0, (bf16x8){S##l0[0], S##l0[1], S##l0[2], S##l0[3], S##h0[0], S##h0[1], S##h0[2], S##h0[3]}, o[d0], 0, 0, 0);   \
        o[d0] = __builtin_amdgcn_mfma_f32_32x32x16_bf16(pa1, (bf16x8){S##l1[0], S##l1[1], S##l1[2], S##l1[3], S##h1[0], S##h1[1], S##h1[2], S##h1[3]}, o[d0], 0, 0, 0);   \
        o[d0] = __builtin_amdgcn_mfma_f32_32x32x16_bf16(pa2, (bf16x8){S##l2[0], S##l2[1], S##l2[2], S##l2[3], S##h2[0], S##h2[1], S##h2[2], S##h2[3]}, o[d0], 0, 0, 0);   \
        o[d0] = __builtin_amdgcn_mfma_f32_32x32x16_bf16(pa3, (bf16x8){S##l3[0], S##l3[1], S##l3[2], S##l3[3], S##h3[0], S##h3[1], S##h3[2], S##h3[3]}, o[d0], 0, 0, 0); } while (0)
#define PV_W(n) do { asm volatile("s_waitcnt lgkmcnt(" #n ")" ::: "memory"); SBAR(); } while (0)
    s16x4 Al0, Al1, Al2, Al3, Ah0, Ah1, Ah2, Ah3, Bl0, Bl1, Bl2, Bl3, Bh0, Bh1, Bh2, Bh3;
    PV_LD(A, 0); PV_LD(B, 1); PV_W(8); PV_MM(A, 0); SBAR();
    PV_LD(A, 2); PV_W(8); PV_MM(B, 1); SBAR();
    PV_LD(B, 3); PV_W(8); PV_MM(A, 2); SBAR();
    PV_W(0); PV_MM(B, 3);
#undef PV_LD
#undef PV_MM
#undef PV_W
#undef TRRD
}
struct BlockRef { const bf16* Q; const bf16* K; const bf16* V; bf16* O; int P0; };
#define VMW() asm volatile("s_waitcnt vmcnt(0)" ::: "memory")
__device__ __forceinline__ void block(const BlockRef& cur, char* lds, int wave_s) {
    const int tid = pg8::otid(wave_s), wid = __builtin_amdgcn_readfirstlane(tid >> 6), lane = tid & 63, r32 = lane & 31, hi = lane >> 5;
    const int NT = cur.P0 / KVBLK + QB / KVBLK;
    const int qlo = cur.P0 + wid * QBLK, qm = qlo + r32 - 4 * hi;
    char* V_lds = lds; char* K_lds = lds + 2 * SHM_V;
    float* ws = (float*)(lds + OFF_WS) + wid * 64; float* li_l = ws, * al_l = ws + 32;
    const float* tab = (const float*)(lds + OFF_TAB) + 4 * hi;
    float m_reg = -1e30f, l_reg = 0; f32x16 o[4] = {};
    const int sr = tid >> 4, sc = (tid & 15) * 8, vst0 = v_st(sr, sc), vst1 = v_st(32 + sr, sc), kws = KSWZ(sr, sc * 2);
    const int vb0 = (int)(uintptr_t)V_lds + v_rd_base(lane);
    int ka[4];
#pragma unroll
    for (int dd = 0; dd < 4; ++dd) ka[dd] = (int)(uintptr_t)K_lds + KSWZ(r32, (dd * 16 + hi * 8) * 2);
    const unsigned toff = (unsigned)sr * PITCH + sc;
    const bf16* Kh = cur.K; const bf16* Vh = cur.V;
    bf16x8 qr[8], st_v0, st_v1, st_k0, st_k1;
    { const bf16* qp = cur.Q + (unsigned)(wid * QBLK + r32) * PITCH + hi * 8;
#pragma unroll
      for (int d0 = 0; d0 < 8; ++d0) qr[d0] = load8(qp + d0 * 16); }
#define SLOAD_H(t) do { const bf16* kp_ = Kh + (size_t)(t) * (KVBLK * PITCH); const bf16* vp_ = Vh + (size_t)(t) * (KVBLK * PITCH); \
        st_v0 = load8(vp_ + toff); st_v1 = load8(vp_ + 32 * PITCH + toff); st_k0 = load8(kp_ + toff); st_k1 = load8(kp_ + 32 * PITCH + toff); } while (0)
#define SWRITE_H(bf) do { *(bf16x8*)(V_lds + (bf) * SHM_V + vst0) = st_v0; *(bf16x8*)(V_lds + (bf) * SHM_V + vst1) = st_v1; \
        *(bf16x8*)(K_lds + (bf) * SHM_K + kws) = st_k0; *(bf16x8*)(K_lds + (bf) * SHM_K + kws + 32 * 256) = st_k1; } while (0)
#define RESC(a) do { if (__any((a) < 1.f)) { if (hi == 0) al_l[r32] = (a); asm volatile("s_waitcnt lgkmcnt(0)" ::: "memory");              \
                     _Pragma("unroll") for (int d_ = 0; d_ < 4; ++d_) _Pragma("unroll") for (int r = 0; r < 16; ++r) o[d_][r] *= al_l[crow(r, hi)]; } } while (0)
#define STEP(t, BF) do { f32x16 p0, p1; float mn, al; bf16x8 pa0, pa1, pa2, pa3; const int kb_ = (t) * KVBLK;                     \
        if ((t) + 1 < NT) SLOAD_H((t) + 1);                                                                                     \
        SBAR(); qkt<BF>(p0, p1, ka, qr, tab + kb_);                                                                 \
        if (kb_ + KVBLK - 1 > qlo) mask_tile(p0, p1, qm - kb_);                                                                 \
        partialSM(p0, p1, m_reg, mn, al); RESC(al); finishSM(p0, p1, al, l_reg, pa0, pa1, pa2, pa3); SBAR();                    \
        pv_tile<BF>(o, vb0, pa0, pa1, pa2, pa3); SBAR();                                                                        \
        if ((t) + 1 < NT) { VMW(); SWRITE_H(1 - (BF)); }                                                                        \
        __syncthreads(); } while (0)
    SLOAD_H(0); VMW(); SWRITE_H(0);
    __syncthreads();
    for (int t = 0; t < NT; t += 2) { STEP(t, 0); STEP(t + 1, 1); }
    if (hi == 0) li_l[r32] = l_reg; asm volatile("s_waitcnt lgkmcnt(0)" ::: "memory");
    bf16* Ow = cur.O + (size_t)(wid * QBLK) * OPITCH;
#pragma unroll
    for (int r = 0; r < 16; ++r) { const int orow = crow(r, hi); const float rl = __builtin_amdgcn_rcpf(li_l[orow]);
#pragma unroll
        for (int d0 = 0; d0 < 4; ++d0) { const float v = o[d0][r] * rl;
            const float vn = pg8::sx<1>(v);
            if ((r32 & 1) == 0) *(unsigned*)(Ow + (size_t)orow * OPITCH + d0 * 32 + r32) = cvtpk(v, vn); } }
    __syncthreads();
#undef SLOAD_H
#undef SWRITE_H
#undef RESC
#undef STEP
}
#undef VMW
#if ATT_PIPE
__device__ __forceinline__ void block_pipe(const BlockRef& cur, char* lds, int wave_s) {
    const int tid = pg8::otid(wave_s), wid = __builtin_amdgcn_readfirstlane(tid >> 6), lane = tid & 63, r32 = lane & 31, hi = lane >> 5;
    const int NT = cur.P0 / KVBLK + QB / KVBLK;
    const int qlo = cur.P0 + wid * QBLK, qm = qlo + r32 - 4 * hi;
    char* V_lds = lds; char* K_lds = lds + 2 * SHM_V;
    float* ws = (float*)(lds + OFF_WS) + wid * 64; float* li_l = ws, * al_l = ws + 32;
    const float* tab = (const float*)(lds + OFF_TAB) + 4 * hi;
    float m_reg = -1e30f, l_reg = 0; f32x16 o[4] = {};
    const int sr = tid >> 4, sc = (tid & 15) * 8, vst0 = v_st(sr, sc), vst1 = v_st(32 + sr, sc), kws = KSWZ(sr, sc * 2);
    const int vb0 = (int)(uintptr_t)V_lds + v_rd_base(lane);
    int ka[4];
#pragma unroll
    for (int dd = 0; dd < 4; ++dd) ka[dd] = (int)(uintptr_t)K_lds + KSWZ(r32, (dd * 16 + hi * 8) * 2);
    const unsigned toff = (unsigned)sr * PITCH + sc;
    const bf16* Kh = cur.K; const bf16* Vh = cur.V;
    bf16x8 qr[8], st_v0, st_v1, st_k0, st_k1;
    { const bf16* qp = cur.Q + (unsigned)(wid * QBLK + r32) * PITCH + hi * 8;
#pragma unroll
      for (int d0 = 0; d0 < 8; ++d0) qr[d0] = load8(qp + d0 * 16); }
#define VMW() asm volatile("s_waitcnt vmcnt(0)" ::: "memory")
#define SLOAD_H(t) do { const bf16* kp_ = Kh + (size_t)(t) * (KVBLK * PITCH); const bf16* vp_ = Vh + (size_t)(t) * (KVBLK * PITCH); \
        st_v0 = load8(vp_ + toff); st_v1 = load8(vp_ + 32 * PITCH + toff); st_k0 = load8(kp_ + toff); st_k1 = load8(kp_ + 32 * PITCH + toff); } while (0)
#define SWRITE_H(bf) do { *(bf16x8*)(V_lds + (bf) * SHM_V + vst0) = st_v0; *(bf16x8*)(V_lds + (bf) * SHM_V + vst1) = st_v1; \
        *(bf16x8*)(K_lds + (bf) * SHM_K + kws) = st_k0; *(bf16x8*)(K_lds + (bf) * SHM_K + kws + 32 * 256) = st_k1; } while (0)
#define RESC(a) do { if (__any((a) < 1.f)) { if (hi == 0) al_l[r32] = (a); asm volatile("s_waitcnt lgkmcnt(0)" ::: "memory");              \
                     _Pragma("unroll") for (int d_ = 0; d_ < 4; ++d_) _Pragma("unroll") for (int r = 0; r < 16; ++r) o[d_][r] *= al_l[crow(r, hi)]; } } while (0)
#define KBASE(t) ((t) * KVBLK)
#define MASKT(P0_, P1_, t) do { const int kb_ = KBASE(t); if (kb_ + KVBLK - 1 > qlo) mask_tile(P0_, P1_, qm - kb_); } while (0)
    f32x16 pA0, pA1, pB0, pB1; float mnA, mnB, alA, alB; bf16x8 pa0, pa1, pa2, pa3;
    SLOAD_H(0); VMW(); SWRITE_H(0);
    __syncthreads();
    SLOAD_H(1);
    SBAR(); qkt<0>(pA0, pA1, ka, qr, tab + KBASE(0));
    MASKT(pA0, pA1, 0); partialSM(pA0, pA1, m_reg, mnA, alA);
    VMW(); SWRITE_H(1);
    __syncthreads();
#define HALF_STEP(PX0, PX1, mnX, alX, PY0, PY1, alY, t, KB, VB, SB) do {                                                      \
        SBAR(); qkt<KB>(PX0, PX1, ka, qr, tab + KBASE(t));                                               \
        finishSM(PY0, PY1, alY, l_reg, pa0, pa1, pa2, pa3); SBAR();                                                           \
        if ((t) + 1 < NT) { SLOAD_H((t) + 1); SBAR(); }                                                              \
        pv_tile<VB>(o, vb0, pa0, pa1, pa2, pa3); MASKT(PX0, PX1, (t)); partialSM(PX0, PX1, m_reg, mnX, alX);                  \
        __syncthreads();                                                                                                      \
        if ((t) + 1 < NT) { VMW(); SWRITE_H(SB); }                                                                          \
        RESC(alX); __syncthreads(); } while (0)
    for (int t = 1; t + 1 < NT; t += 2) {
        HALF_STEP(pB0, pB1, mnB, alB, pA0, pA1, alA, t, 1, 0, 0);
        HALF_STEP(pA0, pA1, mnA, alA, pB0, pB1, alB, t + 1, 0, 1, 1);
    }
    SBAR(); qkt<1>(pB0, pB1, ka, qr, tab + KBASE(NT - 1)); SBAR();
    finishSM(pA0, pA1, alA, l_reg, pa0, pa1, pa2, pa3); SBAR();
    pv_tile<0>(o, vb0, pa0, pa1, pa2, pa3);
    MASKT(pB0, pB1, NT - 1); partialSM(pB0, pB1, m_reg, mnB, alB); RESC(alB);
    finishSM(pB0, pB1, alB, l_reg, pa0, pa1, pa2, pa3); SBAR(); pv_tile<1>(o, vb0, pa0, pa1, pa2, pa3);
    if (hi == 0) li_l[r32] = l_reg; asm volatile("s_waitcnt lgkmcnt(0)" ::: "memory");
    bf16* Ow = cur.O + (size_t)(wid * QBLK) * OPITCH;
#pragma unroll
    for (int r = 0; r < 16; ++r) { const int orow = crow(r, hi); const float rl = __builtin_amdgcn_rcpf(li_l[orow]);
#pragma unroll
        for (int d0 = 0; d0 < 4; ++d0) { const float v = o[d0][r] * rl;
            const float vn = pg8::sx<1>(v);
            if ((r32 & 1) == 0) *(unsigned*)(Ow + (size_t)orow * OPITCH + d0 * 32 + r32) = cvtpk(v, vn); } }
    __syncthreads();
#undef VMW
#undef SLOAD_H
#undef SWRITE_H
#undef RESC
#undef KBASE
#undef MASKT
#undef HALF_STEP
}
#endif
#if ATT_PP
#ifndef ATT_MARGIN
#define ATT_MARGIN 16.f
#endif
__device__ __forceinline__ void block_pp(const BlockRef& cur, char* lds, int wave_s, float kmax2, unsigned* qctr, volatile __attribute__((address_space(3))) unsigned* slot) {
    const int tid = pg8::otid(wave_s), wid = __builtin_amdgcn_readfirstlane(tid >> 6), lane = tid & 63, r32 = lane & 31, hi = lane >> 5;
    const int grp = wid >> 2;
    const int NT = cur.P0 / KVBLK + QB / KVBLK;
    const int qlo = cur.P0 + wid * QBLK, qm = qlo + r32 - 4 * hi;
    char* V_lds = lds; char* K_lds = lds + 2 * SHM_V;
    float* ws = (float*)(lds + OFF_WS) + wid * 64; float* li_l = ws, * al_l = ws + 32;
    const float* tab = (const float*)(lds + OFF_TAB) + 4 * hi;
    float m_reg = -1e30f, l_reg = 0; f32x16 o[4] = {};
    const int sr = tid >> 4, sc = (tid & 15) * 8, vst0 = v_st(sr, sc), vst1 = v_st(32 + sr, sc), kws = KSWZ(sr, sc * 2);
    const int vb0 = (int)(uintptr_t)V_lds + v_rd_base(lane);
    int ka[4];
#pragma unroll
    for (int dd = 0; dd < 4; ++dd) ka[dd] = (int)(uintptr_t)K_lds + KSWZ(r32, (dd * 16 + hi * 8) * 2);
    const unsigned toff = (unsigned)sr * PITCH + sc;
    const bf16* Kh = cur.K; const bf16* Vh = cur.V;
    bf16x8 qr[8], st_v0, st_v1, st_k0, st_k1;
    { const bf16* qp = cur.Q + (unsigned)(wid * QBLK + r32) * PITCH + hi * 8;
#pragma unroll
      for (int d0 = 0; d0 < 8; ++d0) qr[d0] = load8(qp + d0 * 16); }
    { const bf16* kd = cur.K + (size_t)(cur.P0 + wid * QBLK + r32) * PITCH + hi * 8;
      bf16x8 kv[8];
#pragma unroll
      for (int d0 = 0; d0 < 8; ++d0) kv[d0] = load8(kd + d0 * 16);
      float qn2 = 0.f, dqk = 0.f;
#pragma unroll
      for (int d0 = 0; d0 < 8; ++d0)
#pragma unroll
          for (int e = 0; e < 8; ++e) { const float qf = __uint_as_float((unsigned)(unsigned short)qr[d0][e] << 16), kf = __uint_as_float((unsigned)(unsigned short)kv[d0][e] << 16); qn2 = fmaf(qf, qf, qn2); dqk = fmaf(qf, kf, dqk); }
      qn2 = pg8::add32(qn2); dqk = pg8::add32(dqk);
      float Li = dqk + ((const float*)(lds + OFF_TAB))[cur.P0 + wid * QBLK + r32] - __builtin_sqrtf(qn2 * kmax2) * 1.001f - ATT_MARGIN / SCALE;
      Li = fminf(Li, pg8::sx<1>(Li)); Li = fminf(Li, pg8::sx<2>(Li)); Li = fminf(Li, pg8::sx<4>(Li)); Li = fminf(Li, pg8::sx<8>(Li)); Li = fminf(Li, pg8::sx<16>(Li));
      if (lane == 0) ((float*)(lds + OFF_WS))[wid * 64] = Li; }
#define SLOAD_H(t) do { const bf16* kp_ = Kh + (size_t)(t) * (KVBLK * PITCH); const bf16* vp_ = Vh + (size_t)(t) * (KVBLK * PITCH); \
        st_v0 = load8(vp_ + toff); st_v1 = load8(vp_ + 32 * PITCH + toff); st_k0 = load8(kp_ + toff); st_k1 = load8(kp_ + 32 * PITCH + toff); } while (0)
#define SWRITE_H(bf) do { *(bf16x8*)(V_lds + (bf) * SHM_V + vst0) = st_v0; *(bf16x8*)(V_lds + (bf) * SHM_V + vst1) = st_v1; \
        *(bf16x8*)(K_lds + (bf) * SHM_K + kws) = st_k0; *(bf16x8*)(K_lds + (bf) * SHM_K + kws + 32 * 256) = st_k1; } while (0)
#define RESC(a) do { if (__any((a) < 1.f)) { if (hi == 0) al_l[r32] = (a); asm volatile("s_waitcnt lgkmcnt(0)" ::: "memory");              \
                     _Pragma("unroll") for (int d_ = 0; d_ < 4; ++d_) _Pragma("unroll") for (int r = 0; r < 16; ++r) o[d_][r] *= al_l[crow(r, hi)]; } } while (0)
#define PPBAR() asm volatile("s_waitcnt lgkmcnt(0)\n\ts_barrier" ::: "memory")
#define SHALF(tt, BF) do { const int kb_ = (tt) * KVBLK; SBAR(); qkt<BF>(p0, p1, ka, qr, tab + kb_); if (kb_ + KVBLK - 1 > qlo) mask_tile(p0, p1, qm - kb_); partialSM(p0, p1, m_reg, mn, al, skv); } while (0)
#define VHALF(BF) do { if (!skv) { RESC(al); finishSM(p0, p1, al, l_reg, pa0, pa1, pa2, pa3); SBAR(); pv_tile<BF>(o, vb0, pa0, pa1, pa2, pa3); SBAR(); } } while (0)
#define STAGE(t, BF) do { if ((t) + 1 < NE) { SWRITE_H(1 - (BF)); if ((t) + 2 < NE) SLOAD_H(NT - 3 - (t)); } } while (0)
    f32x16 p0, p1; float mn, al = 1.f; bf16x8 pa0, pa1, pa2, pa3; bool skv = false;
    SLOAD_H(NT - 1); SWRITE_H(0); SLOAD_H(NT - 2);
    PPBAR();
    int NE;
    { const float* lw = (const float*)(lds + OFF_WS); float L = lw[0];
#pragma unroll
      for (int w = 1; w < NW; ++w) L = fminf(L, lw[w * 64]);
      const bool sk = lane < cur.P0 / KVBLK && ((const float*)(lds + OFF_TAB))[64 * lane + 63] <= L;
      NE = __builtin_amdgcn_readfirstlane(NT - (__popcll(__ballot(sk)) & ~1)); }
    if (grp == 0) {
        for (int t = 0; t < NE; t += 2) {
            SHALF(NT - 1 - t, 0); PPBAR(); VHALF(0); STAGE(t, 0); PPBAR();
            SHALF(NT - 2 - t, 1); PPBAR(); VHALF(1); STAGE(t + 1, 1); PPBAR();
        }
    } else {
        for (int t = 0; t < NE; t += 2) {
            if (t >= 1) VHALF(1);
            PPBAR(); SHALF(NT - 1 - t, 0); STAGE(t, 0); PPBAR();
            VHALF(0); PPBAR(); SHALF(NT - 2 - t, 1); STAGE(t + 1, 1); PPBAR();
        }
        VHALF(1);
    }
    unsigned ticket = 0u;
    if (wid == 0 && lane == 0) ticket = __hip_atomic_fetch_add(qctr, 1u, __ATOMIC_RELAXED, __HIP_MEMORY_SCOPE_AGENT);
    if (hi == 0) li_l[r32] = l_reg; asm volatile("s_waitcnt lgkmcnt(0)" ::: "memory");
    { char* stg = lds + OFF_OST + wid * 4096; bf16* Ow = cur.O + (size_t)(wid * QBLK) * OPITCH;
#pragma unroll
      for (int half = 0; half < 2; ++half) {
#pragma unroll
        for (int rr = 0; rr < 8; ++rr) { const int r = 8 * half + rr, rowl = (r & 3) + 8 * ((r >> 2) & 1) + 4 * hi; const float rl = __builtin_amdgcn_rcpf(li_l[crow(r, hi)]);
#pragma unroll
            for (int d0 = 0; d0 < 4; ++d0) { const float v = o[d0][r] * rl; *(unsigned short*)(stg + (rowl * 128 + d0 * 32 + r32) * 2) = (unsigned short)(cvtpk(v, v) & 0xffffu); } }
        asm volatile("s_waitcnt lgkmcnt(0)" ::: "memory");
#pragma unroll
        for (int i = 0; i < 4; ++i) { const int rowl = (lane >> 4) + 4 * i; const u32x4 w = *(const u32x4*)(stg + rowl * 256 + (lane & 15) * 16);
            *(u32x4*)(Ow + (size_t)(16 * half + rowl) * OPITCH + (lane & 15) * 8) = w; }
        asm volatile("s_waitcnt lgkmcnt(0)" ::: "memory");
      } }
    if (wid == 0 && lane == 0) *slot = ticket;
    __syncthreads();
#undef SLOAD_H
#undef SWRITE_H
#undef RESC
#undef PPBAR
#undef SHALF
#undef VHALF
#undef STAGE
}
#endif
__device__ __forceinline__ float fill_table(const float* Fh, const float* KNh, char* lds, int wave_s) {
    const int tid = pg8::otid(wave_s), wid = __builtin_amdgcn_readfirstlane(tid >> 6), lane = tid & 63;
    float* tab = (float*)(lds + OFF_TAB); float* wt = (float*)(lds + OFF_WT);
    f32x4 kn[8];
#pragma unroll
    for (int i = 0; i < 8; ++i) kn[i] = *reinterpret_cast<const f32x4*>(KNh + (size_t)(i >> 1) * SEQ + tid * 8 + 4 * (i & 1));
    float v[8];
    { const f32x4 f0 = *reinterpret_cast<const f32x4*>(Fh + tid * 8), f1 = *reinterpret_cast<const f32x4*>(Fh + tid * 8 + 4);
#pragma unroll
      for (int j = 0; j < 4; ++j) { v[j] = f0[j]; v[4 + j] = f1[j]; } }
#pragma unroll
    for (int j = 1; j < 8; ++j) v[j] += v[j - 1];
    const float tot = v[7]; float scn = tot;
#pragma unroll
    for (int o = 1; o < 64; o <<= 1) { const int src = lane >= o ? lane - o : lane; const float n = __int_as_float(__builtin_amdgcn_ds_bpermute(src << 2, __float_as_int(scn))); if (lane >= o) scn += n; }
    float mx = 0.f;
#pragma unroll
    for (int i = 0; i < 2; ++i) { const f32x4 t4 = (kn[i] + kn[2 + i]) + (kn[4 + i] + kn[6 + i]); mx = fmaxf(mx, fmaxf(fmaxf(t4[0], t4[1]), fmaxf(t4[2], t4[3]))); }
    mx = fmaxf(mx, pg8::sx<1>(mx)); mx = fmaxf(mx, pg8::sx<2>(mx)); mx = fmaxf(mx, pg8::sx<4>(mx)); mx = fmaxf(mx, pg8::sx<8>(mx)); mx = fmaxf(mx, pg8::sx<16>(mx));
    { auto rr = __builtin_amdgcn_permlane32_swap(__float_as_uint(mx), __float_as_uint(mx), false, false); mx = fmaxf(__uint_as_float(rr[0]), __uint_as_float(rr[1])); }
    if (lane == 63) wt[wid] = scn;
    if (lane == 0) wt[8 + wid] = mx;
    __syncthreads();
    float woff = 0.f;
    for (int w = 0; w < wid; ++w) woff += wt[w];
    float r = wt[8];
#pragma unroll
    for (int w = 1; w < NW; ++w) r = fmaxf(r, wt[8 + w]);
    const float base = woff + scn - tot;
#pragma unroll
    for (int j = 0; j < 8; ++j) tab[tid * 8 + j] = -(base + v[j]) * (1.f / SCALE);
    __syncthreads();
    return r * 1.02f;
}
#undef KSWZ
#undef SBAR
}

#ifndef DIAG_REGION
#define DIAG_REGION 0
#endif
constexpr int NWAVES = 8;
constexpr int BATCH = 4, T = 4096, D = 2048, DEPTH = 4, M = BATCH * T;
constexpr int FF = 5632, NFF = 2 * FF;
constexpr int DCONV = 512, DATT = 1024, DLRU = 512, NH = 8, HD = 128;
constexpr int DIN = 5640;
constexpr int PW = 5632;
constexpr int NMIX = 5888;
constexpr int PC_B = 0, PC_C = 512, PC_V = 1024, PC_Q = 1536, PC_K = 2560, PC_VV = 3584, PC_G = 4608, PC_X = 5120;
constexpr int LCH = 64, NCH = T / LCH;
constexpr float EPS = 1e-6f;
constexpr int N_PHASES = 2 + 12 * DEPTH;

constexpr size_t MiB = 1u << 20;
constexpr size_t WS_CTL = 0, CTL_ZERO_BYTES = 1 * MiB;
constexpr size_t SZ_W1 = (size_t)NFF * D * 2, SZ_W2 = (size_t)D * FF * 2, SZ_WM = (size_t)NMIX * D * 2, SZ_WO = (size_t)D * D * 2, SZ_WG = (size_t)2 * 4 * 128 * 128 * 2;
constexpr size_t SZ_W1Q = (size_t)NFF * D;
constexpr size_t WS_W1 = 1 * MiB;
constexpr size_t WS_HB = WS_W1;
constexpr size_t SZ_P = (size_t)M * FF * 2;
constexpr size_t WS_P  = WS_W1 + (size_t)M * FF * 2;
static_assert(2 * DEPTH * SZ_W1 >= (size_t)M * FF * 2 + (size_t)M * PW * 2, "HB and P fit in the dead bf16 FFN-in region");
constexpr size_t WS_W2 = WS_W1 + 2 * DEPTH * SZ_W1;
constexpr size_t WS_WM = WS_W2 + 2 * DEPTH * SZ_W2;
constexpr size_t WS_WO = WS_WM + DEPTH * SZ_WM;
constexpr size_t WS_WG = WS_WO + DEPTH * SZ_WO;
constexpr size_t WS_XB = WS_WG + DEPTH * SZ_WG;
constexpr size_t WS_W1Q = WS_XB + (size_t)M * D * 2;
constexpr size_t WS_SW = WS_W1Q + 2 * DEPTH * SZ_W1Q;
constexpr size_t WS_Q8 = WS_SW + (size_t)2 * DEPTH * NFF * 4;
constexpr size_t WS_RSA = WS_Q8 + (size_t)M * D;
constexpr size_t WS_W2Q = WS_RSA + (size_t)M * 4;
constexpr size_t WS_SW2 = WS_W2Q + (size_t)2 * DEPTH * D * FF;
constexpr size_t WS_HQ = WS_SW2 + (size_t)2 * DEPTH * D * 4;
constexpr size_t WS_SH = WS_HQ + (size_t)M * FF;
constexpr size_t WS_YA = WS_SH + (size_t)M * 4;
constexpr size_t WS_Y  = WS_YA + (size_t)M * DATT * 2;
constexpr size_t WS_F  = WS_Y + (size_t)M * D * 2;
constexpr size_t WS_SA = WS_F + (size_t)M * 8 * 4;
constexpr size_t WS_SS = WS_SA + (size_t)M * 8 * 4;
constexpr size_t WS_CS = WS_SS + (size_t)M * 32 * 4;
constexpr size_t WS_XL = WS_CS + (size_t)BATCH * NCH * DLRU * 2 * 4;
constexpr size_t WS_HL = WS_XL + (size_t)M * D;
constexpr size_t WS_CA = WS_HL + (size_t)M * DLRU * 4;
constexpr size_t WS_BS = WS_CA + (size_t)M * DLRU * 4;
constexpr size_t WS_KN = WS_BS + (size_t)M * (FF / 32) * 4;
constexpr size_t WS_WGF = WS_KN + (size_t)M * 32 * 4;
constexpr size_t WS_END = WS_WGF + DEPTH * SZ_WG;
static_assert(WS_W1 % 256 == 0 && WS_XB % 256 == 0 && WS_F % 256 == 0 && WS_CS % 256 == 0 && WS_W1Q % 256 == 0 && WS_Q8 % 256 == 0 && WS_SW % 256 == 0 && WS_RSA % 256 == 0 && WS_W2Q % 256 == 0 && WS_HQ % 256 == 0, "d_ws map alignment");
constexpr int CW_TMO = 0;
constexpr int CW_BAR = 4096;
constexpr int CW_BAR2 = 8192;
constexpr int CW_AMAX = 32768;
constexpr int CW_AMAXO = CW_AMAX + 2 * DEPTH * NFF;
constexpr int CW_AMAX2 = CW_AMAXO + DEPTH * D;
constexpr int CW_PCNT = 163840;
constexpr int CW_PMASK = CW_PCNT + 64 * 64;
constexpr int CW_ATQ = CW_PMASK + 64 * 64;
static_assert((size_t)(CW_ATQ + DEPTH * BATCH * 64) * 4 <= CTL_ZERO_BYTES, "attention queue counters inside the memset region");
constexpr int NOWN = 4;
static_assert(CW_AMAX2 + 2 * DEPTH * D <= CW_PCNT && (size_t)(CW_PMASK + 64 * 64) * 4 <= CTL_ZERO_BYTES, "control words inside the memset region");

constexpr int RING_OFF = 0, RING_BYTES = 131072;
constexpr int RS_OFF = RING_BYTES;
constexpr int LDSCTL_OFF = RS_OFF + 1024, MISC_OFF = LDSCTL_OFF + 320;
constexpr int LDS_BYTES = 147456;
static_assert(MISC_OFF + 128 <= LDS_BYTES, "LDS map");
constexpr int LRU_XF = 0;
constexpr int LRU_XH_PITCH = 1040;
constexpr int LRU_XH = 65536;
constexpr int LRU_SQ = LRU_XH + 32 * LRU_XH_PITCH;
static_assert(LRU_SQ + 8 * 32 * 4 <= RING_BYTES && att::LDS_BYTES <= RING_BYTES, "phase scratch inside the ring region");

#define GAS __attribute__((address_space(1)))
#define LAS __attribute__((address_space(3)))
typedef unsigned short bf16;
typedef unsigned v4u __attribute__((ext_vector_type(4)));
typedef unsigned v2u __attribute__((ext_vector_type(2)));
typedef float f32x4 __attribute__((ext_vector_type(4)));
typedef float f32x2 __attribute__((ext_vector_type(2)));
typedef float f32x16 __attribute__((ext_vector_type(16)));
typedef short bf16x8 __attribute__((ext_vector_type(8)));
typedef GAS unsigned gu32;
#define RLX_AGENT __ATOMIC_RELAXED, __HIP_MEMORY_SCOPE_AGENT
#define LDS_WAIT() asm volatile("s_waitcnt lgkmcnt(0)" ::: "memory")
#define VM_WAIT() asm volatile("s_waitcnt vmcnt(0)" ::: "memory")
__device__ __forceinline__ unsigned pk2(float lo, float hi) { return pg8::cvt_pk_bf16(lo, hi); }
__device__ __forceinline__ float bflo(unsigned w) { return __uint_as_float(w << 16); }
__device__ __forceinline__ float bfhi(unsigned w) { return __uint_as_float(w & 0xffff0000u); }
__device__ __forceinline__ float bf1(bf16 h) { return __uint_as_float((unsigned)h << 16); }
__device__ __forceinline__ float wave_sum(float v) {
    v += pg8::sx<1>(v); v += pg8::sx<2>(v); v += pg8::sx<4>(v); v += pg8::sx<8>(v); v += pg8::sx<16>(v); return pg8::add32(v);
}

#define XB_TMO      128
#define XB_XCNT(j)  (256  + 64 * (j))
#define XB_XSUB(j)  (1280 + 64 * (j))
#define XB_XGEN(j)  (2304 + 64 * (j))
#define XB_TOP      3328
#define XB_TOPGEN   3392
#define XCD_BAR_WORDS 3456
#define XB_SPIN_CAP (1u << 18)

__device__ __forceinline__ unsigned xb_ld(unsigned* p)              { return __hip_atomic_load(p, __ATOMIC_RELAXED, __HIP_MEMORY_SCOPE_AGENT); }
__device__ __forceinline__ unsigned xb_add(unsigned* p, unsigned v) { return __hip_atomic_fetch_add(p, v, __ATOMIC_RELAXED, __HIP_MEMORY_SCOPE_AGENT); }
__device__ __forceinline__ unsigned xb_xcc_id() { return (unsigned)__builtin_amdgcn_s_getreg((3 << 11) | 20) & 0xFu; }
#define XB_SPIN(cond, bar) do { unsigned _sp = 0; while (cond) { __builtin_amdgcn_s_sleep(1); \
    if ((++_sp & 255u) == 0u) { if (xb_ld(&(bar)[XB_TMO])) break; if (_sp > XB_SPIN_CAP) { atomicAdd(&(bar)[XB_TMO], 1u); break; } } } } while (0)

struct XcdBarrier {
    unsigned np;
    unsigned* bar; unsigned x; int w;
    volatile LAS unsigned* st;
};

__device__ __forceinline__ bool xb_thread0(int w) { return w == 0 && pg8::olane() == 0; }
__device__ __forceinline__ XcdBarrier xcd_barrier_post(unsigned* bar, volatile LAS unsigned* st, int w, unsigned np) {
    XcdBarrier b; b.bar = bar; b.x = xb_xcc_id(); b.st = st; b.w = w; b.np = np;
    if (xb_thread0(w)) (void)xb_add(&bar[XB_XCNT(b.x)], 1u);
    return b;
}
__device__ __forceinline__ void xcd_barrier_complete(unsigned* bar, unsigned x, unsigned& nloc, unsigned& nx, unsigned G) {
    asm volatile("" : "+s"(x));
    unsigned sum, cnt, mine, sp = 0u;
    for (;;) {
        sum = 0u; cnt = 0u; mine = 0u;
#pragma unroll
        for (unsigned j = 0; j < 16; ++j) { const unsigned c = xb_ld(&bar[XB_XCNT(j)]); sum += c; cnt += (c > 0u) ? 1u : 0u; mine = (j == x) ? c : mine; }
        if (sum == G) break;
        __builtin_amdgcn_s_sleep(1);
        if ((++sp & 255u) == 0u) { if (xb_ld(&bar[XB_TMO])) break; if (sp > XB_SPIN_CAP) { atomicAdd(&bar[XB_TMO], 1u); break; } }
    }
    nloc = mine > 0u ? mine : 1u; nx = cnt > 0u ? cnt : 1u;
}

__device__ __forceinline__ void xcd_barrier(const XcdBarrier& b_in) {
    XcdBarrier b = b_in; asm volatile("" : "+s"(b.bar), "+s"(b.x));
    asm volatile("s_waitcnt vmcnt(0)" ::: "memory");
    __syncthreads();
    if (xb_thread0(b.w)) {
        unsigned* bar = b.bar;
        __builtin_amdgcn_s_waitcnt(0);
        unsigned nloc = b.st[0], nx = b.st[1];
        if (nloc == 0u) { xcd_barrier_complete(bar, b.x, nloc, nx, b.np); b.st[0] = nloc; b.st[1] = nx; }
        const unsigned old = xb_add(&bar[XB_XSUB(b.x)], 1u);
        const unsigned gen = old / nloc;
        if (old + 1u == (gen + 1u) * nloc) {
            __builtin_amdgcn_fence(__ATOMIC_RELEASE, "agent");
            asm volatile("s_waitcnt vmcnt(0)" ::: "memory");
            const unsigned og = xb_add(&bar[XB_TOP], 1u);
            const unsigned tg = og / nx;
            if (og + 1u == (tg + 1u) * nx) xb_add(&bar[XB_TOPGEN], 1u);
            else XB_SPIN(xb_ld(&bar[XB_TOPGEN]) == tg, bar);
            __builtin_amdgcn_fence(__ATOMIC_ACQUIRE, "agent");
            xb_add(&bar[XB_XGEN(b.x)], 1u);
            asm volatile("s_waitcnt vmcnt(0)" ::: "memory");
        } else {
            XB_SPIN(xb_ld(&bar[XB_XGEN(b.x)]) == gen, bar);
            __builtin_amdgcn_fence(__ATOMIC_ACQUIRE, "agent");
            asm volatile("s_waitcnt vmcnt(0)" ::: "memory");
        }
    }
    __syncthreads();
}

__device__ __forceinline__ void panel_barrier(unsigned* ctl, int pm, unsigned target, volatile LAS unsigned* misc, int w) {
    asm volatile("" : "+s"(ctl), "+s"(pm), "+s"(target));
    asm volatile("s_waitcnt vmcnt(0)" ::: "memory");
    __syncthreads();
    if (xb_thread0(w)) {
        __builtin_amdgcn_s_waitcnt(0);
        unsigned* cnt = ctl + CW_PCNT + 64 * pm; unsigned* tmo = ctl + CW_BAR + XB_TMO;
        if (misc[12] != 1u) { __builtin_amdgcn_fence(__ATOMIC_RELEASE, "agent"); asm volatile("s_waitcnt vmcnt(0)" ::: "memory"); }
        (void)xb_add(cnt, 1u);
        unsigned sp = 0u;
        while (xb_ld(cnt) < target) { __builtin_amdgcn_s_sleep(1);
            if ((++sp & 255u) == 0u) { if (xb_ld(tmo)) break; if (sp > XB_SPIN_CAP) { atomicAdd(tmo, 1u); break; } } }
        __builtin_amdgcn_fence(__ATOMIC_ACQUIRE, "agent");
        asm volatile("s_waitcnt vmcnt(0)" ::: "memory");
    }
    __syncthreads();
}
template <int MODE> __device__ __forceinline__ int src_col(int n) {
    if (MODE == 1) { const int pn = n >> 8, bj = (n >> 7) & 1, jj = n & 127; return bj * FF + 128 * pn + jj; }
    if (MODE == 2) { if (n < 4608) return n; if (n < 5632) return n + 8; if (n < 5640) return n - 1024; return -1; }
    return n;
}
template <int MODE>
__device__ __forceinline__ void tr_item(const float* W, int K, int Nsrc, const float* gain, bf16* WT, int nblk, LAS unsigned* scr, int item, int lane, unsigned* amax = nullptr) {
    const int kb = item / nblk, nb = item % nblk, k0 = 64 * kb, n0 = 64 * nb;
    const int n4 = lane & 15, pr = lane >> 4;
    const int sc = src_col<MODE>(n0 + 4 * n4);
    f32x4 va[8], vb[8];
#pragma unroll
    for (int i = 0; i < 8; ++i) { const int p = 4 * i + pr;
        if (sc >= 0) { const float* s = W + (size_t)(k0 + 2 * p) * Nsrc + sc; va[i] = *(const f32x4*)s; vb[i] = *(const f32x4*)(s + Nsrc); }
        else { va[i] = (f32x4){0.f, 0.f, 0.f, 0.f}; vb[i] = va[i]; } }
#pragma unroll
    for (int i = 0; i < 8; ++i) { const int p = 4 * i + pr;
        float ga = 1.f, gb = 1.f; if (gain) { ga = gain[k0 + 2 * p]; gb = gain[k0 + 2 * p + 1]; }
        v4u w; w.x = pk2(va[i][0] * ga, vb[i][0] * gb); w.y = pk2(va[i][1] * ga, vb[i][1] * gb); w.z = pk2(va[i][2] * ga, vb[i][2] * gb); w.w = pk2(va[i][3] * ga, vb[i][3] * gb);
        *(LAS v4u*)(scr + p * 64 + 4 * (n4 ^ ((p >> 2) & 7))) = w; }
    LDS_WAIT(); asm volatile("" ::: "memory");
    const int c = lane & 7;
#pragma unroll
    for (int j = 0; j < 8; ++j) { const int n = (lane >> 3) + 8 * j;
        v4u o;
#pragma unroll
        for (int i = 0; i < 4; ++i) { const int p = 4 * c + i; o[i] = scr[p * 64 + (n ^ (((p >> 2) & 7) << 2))]; }
        *(GAS v4u*)(WT + (size_t)(n0 + n) * K + k0 + 8 * c) = o;
        if (amax) {
            float mx = 0.f;
#pragma unroll
            for (int i = 0; i < 4; ++i) mx = fmaxf(mx, fmaxf(fabsf(bflo(o[i])), fabsf(bfhi(o[i]))));
            mx = fmaxf(mx, pg8::sx<1>(mx)); mx = fmaxf(mx, pg8::sx<2>(mx)); mx = fmaxf(mx, pg8::sx<4>(mx));
            if (c == 0) atomicMax(amax + n0 + n, __float_as_uint(mx)); } }
    LDS_WAIT(); asm volatile("" ::: "memory");
}
template <int MODE>
__device__ __forceinline__ void tr_matrix(const float* W, int K, int Nsrc, const float* gain, bf16* WT, int Ndst, LAS unsigned* scr, int gw, int NGW, int lane, unsigned* amax = nullptr) {
    const int nblk = Ndst / 64, nitems = (K / 64) * nblk;
    for (int it = gw; it < nitems; it += NGW) tr_item<MODE>(W, K, Nsrc, gain, WT, nblk, scr, it, lane, amax);
}
__device__ __forceinline__ void w1_strip(const float* W, const float* gain, unsigned char* WQ, float* SWm, int strip, LAS unsigned char* lds, int wave, int tid, int lane_in) {
    int lane = lane_in; asm volatile("" : "+v"(lane));
    const int n0 = 64 * strip, n4 = lane & 15, pr = lane >> 4;
    const int sc = src_col<1>(n0 + 4 * n4);
    LAS unsigned* scr = (LAS unsigned*)(lds + RING_OFF + wave * 16384);
    LAS float* cinv = (LAS float*)(lds + RS_OFF);
    v4u w[3][8]; float cm[4] = {0.f, 0.f, 0.f, 0.f};
#pragma unroll
    for (int it = 0; it < 4; ++it) { const int k0 = 256 * wave + 64 * it;
#pragma unroll
        for (int hh = 0; hh < 2; ++hh) {
            f32x4 va[4], vb[4]; f32x2 gg[4];
#pragma unroll
            for (int i = 0; i < 4; ++i) { const int p = 4 * (4 * hh + i) + pr; const float* s = W + (size_t)(k0 + 2 * p) * NFF + sc; va[i] = *(const f32x4*)s; vb[i] = *(const f32x4*)(s + NFF); gg[i] = *(const f32x2*)(gain + k0 + 2 * p); }
#pragma unroll
            for (int i = 0; i < 4; ++i) { const float ga = gg[i].x, gb = gg[i].y; v4u x;
                x.x = pk2(va[i][0] * ga, vb[i][0] * gb); x.y = pk2(va[i][1] * ga, vb[i][1] * gb); x.z = pk2(va[i][2] * ga, vb[i][2] * gb); x.w = pk2(va[i][3] * ga, vb[i][3] * gb);
                if (it < 3) w[it][4 * hh + i] = x; else { const int p = 4 * (4 * hh + i) + pr; *(LAS v4u*)(scr + p * 64 + 4 * (n4 ^ ((p >> 2) & 7))) = x; }
#pragma unroll
                for (int c = 0; c < 4; ++c) cm[c] = fmaxf(cm[c], fmaxf(fabsf(bflo(x[c])), fabsf(bfhi(x[c])))); }
            asm volatile("" ::: "memory");
        }
    }
#pragma unroll
    for (int c = 0; c < 4; ++c) cm[c] = pg8::max32(pg8::max16(cm[c]));
    if (pr == 0) { f32x4 t4 = {cm[0], cm[1], cm[2], cm[3]}; *(LAS f32x4*)((LAS float*)scr + 2048 + 4 * n4) = t4; }
    __syncthreads();
    if (tid < 64) { float m = 0.f;
#pragma unroll
        for (int w8 = 0; w8 < 8; ++w8) m = fmaxf(m, ((const LAS float*)(lds + RING_OFF + w8 * 16384 + 8192))[tid]);
        cinv[tid] = m > 0.f ? 127.f / m : 0.f; SWm[n0 + tid] = m * (1.f / 127.f); }
    __syncthreads();
    const int c = lane & 7, nr = lane >> 3;
#pragma unroll
    for (int t4 = 0; t4 < 4; ++t4) { const int it = (t4 + 3) & 3;
        if (it < 3) {
#pragma unroll
            for (int i = 0; i < 8; ++i) { const int p = 4 * i + pr; *(LAS v4u*)(scr + p * 64 + 4 * (n4 ^ ((p >> 2) & 7))) = w[it][i]; } }
        LDS_WAIT(); asm volatile("" ::: "memory");
#pragma unroll
        for (int j = 0; j < 8; ++j) { const int n = nr + 8 * j; const float inv = cinv[n];
            unsigned o[4];
#pragma unroll
            for (int i = 0; i < 4; ++i) { const int p = 4 * c + i; o[i] = scr[p * 64 + (n ^ (((p >> 2) & 7) << 2))]; }
            v2u q;
            q.x = ((unsigned)(int)__builtin_rintf(bflo(o[0]) * inv) & 0xffu) | (((unsigned)(int)__builtin_rintf(bfhi(o[0]) * inv) & 0xffu) << 8)
                | (((unsigned)(int)__builtin_rintf(bflo(o[1]) * inv) & 0xffu) << 16) | (((unsigned)(int)__builtin_rintf(bfhi(o[1]) * inv) & 0xffu) << 24);
            q.y = ((unsigned)(int)__builtin_rintf(bflo(o[2]) * inv) & 0xffu) | (((unsigned)(int)__builtin_rintf(bfhi(o[2]) * inv) & 0xffu) << 8)
                | (((unsigned)(int)__builtin_rintf(bflo(o[3]) * inv) & 0xffu) << 16) | (((unsigned)(int)__builtin_rintf(bfhi(o[3]) * inv) & 0xffu) << 24);
            *(GAS v2u*)(WQ + (size_t)(n0 + n) * D + 256 * wave + 64 * it + 8 * c) = q; }
        LDS_WAIT(); asm volatile("" ::: "memory");
    }
}
__device__ __forceinline__ void w2_strip(const float* W, unsigned char* WQ, float* SWm, int strip, LAS unsigned char* lds, int wave, int tid, int lane_in) {
    int lane = lane_in; asm volatile("" : "+v"(lane));
    const int n0 = 16 * strip, n4 = lane & 3, pr = lane >> 2;
    LAS unsigned* scr = (LAS unsigned*)(lds + RING_OFF + wave * 16384);
    LAS float* cinv = (LAS float*)(lds + RS_OFF);
    v4u w[11][2]; float cm[4] = {0.f, 0.f, 0.f, 0.f};
    const float* src = W + (size_t)(704 * wave) * D + n0 + 4 * n4;
#pragma unroll
    for (int it = 0; it < 11; ++it) {
        f32x4 va[2], vb[2];
#pragma unroll
        for (int i = 0; i < 2; ++i) { const int p = pr + 16 * i; const float* s = src + (size_t)(64 * it + 2 * p) * D; va[i] = *(const f32x4*)s; vb[i] = *(const f32x4*)(s + D); }
#pragma unroll
        for (int i = 0; i < 2; ++i) { v4u x; x.x = pk2(va[i][0], vb[i][0]); x.y = pk2(va[i][1], vb[i][1]); x.z = pk2(va[i][2], vb[i][2]); x.w = pk2(va[i][3], vb[i][3]);
            w[it][i] = x;
#pragma unroll
            for (int c = 0; c < 4; ++c) cm[c] = fmaxf(cm[c], fmaxf(fabsf(bflo(x[c])), fabsf(bfhi(x[c])))); }
        if (it % 3 == 2) asm volatile("" ::: "memory");
    }
#pragma unroll
    for (int c = 0; c < 4; ++c) { float m = cm[c]; m = fmaxf(m, pg8::sx<4>(m)); m = fmaxf(m, pg8::sx<8>(m)); m = pg8::max32(pg8::max16(m)); cm[c] = m; }
    if (pr == 0) { f32x4 t4 = {cm[0], cm[1], cm[2], cm[3]}; *(LAS f32x4*)((LAS float*)scr + 2048 + 4 * n4) = t4; }
    __syncthreads();
    if (tid < 16) { float m = 0.f;
#pragma unroll
        for (int w8 = 0; w8 < 8; ++w8) m = fmaxf(m, ((const LAS float*)(lds + RING_OFF + w8 * 16384 + 8192))[tid]);
        cinv[tid] = m > 0.f ? 127.f / m : 0.f; SWm[n0 + tid] = m * (1.f / 127.f); }
    __syncthreads();
    const int nr = lane & 15, c = lane >> 4; const float inv = cinv[nr];
    unsigned char* drow = WQ + (size_t)(n0 + nr) * FF + 704 * wave + 16 * c;
#pragma unroll
    for (int it = 0; it < 11; ++it) {
#pragma unroll
        for (int i = 0; i < 2; ++i) { const int p = pr + 16 * i; *(LAS v4u*)(scr + p * 16 + 4 * n4) = w[it][i]; }
        LDS_WAIT(); asm volatile("" ::: "memory");
        unsigned o[8];
#pragma unroll
        for (int j = 0; j < 8; ++j) o[j] = scr[(8 * c + j) * 16 + nr];
        v4u q;
#pragma unroll
        for (int e = 0; e < 4; ++e)
            q[e] = ((unsigned)(int)__builtin_rintf(bflo(o[2 * e]) * inv) & 0xffu) | (((unsigned)(int)__builtin_rintf(bfhi(o[2 * e]) * inv) & 0xffu) << 8)
                 | (((unsigned)(int)__builtin_rintf(bflo(o[2 * e + 1]) * inv) & 0xffu) << 16) | (((unsigned)(int)__builtin_rintf(bfhi(o[2 * e + 1]) * inv) & 0xffu) << 24);
        *(GAS v4u*)(drow + 64 * it) = q;
        LDS_WAIT(); asm volatile("" ::: "memory");
    }
}
__device__ __forceinline__ void quant_wrow(const bf16* src, unsigned char* dst, float amax, float* sw_out, int lane) {
    const float inv = amax > 0.f ? 127.f / amax : 0.f;
    const v4u* s = (const v4u*)src + 4 * lane; v4u w[4];
#pragma unroll
    for (int i = 0; i < 4; ++i) w[i] = s[i];
    v4u o[2];
#pragma unroll
    for (int i = 0; i < 4; ++i)
#pragma unroll
        for (int e = 0; e < 4; ++e) { const int q0 = (int)__builtin_rintf(bflo(w[i][e]) * inv), q1 = (int)__builtin_rintf(bfhi(w[i][e]) * inv);
            const unsigned two = ((unsigned)q0 & 0xffu) | (((unsigned)q1 & 0xffu) << 8);
            const int pos = 8 * i + 2 * e;
            if ((pos & 3) == 0) o[pos >> 4][(pos >> 2) & 3] = two; else o[pos >> 4][(pos >> 2) & 3] |= two << 16; }
    v4u* d = (v4u*)dst + 2 * lane; d[0] = o[0]; d[1] = o[1];
    if (lane == 0) *sw_out = amax * (1.f / 127.f);
}
#ifndef Q1_HI_ONLY
#define Q1_HI_ONLY 1
#endif
__device__ __forceinline__ void quant_xrow_load(v4u (&h)[4], v4u (&l)[2], const bf16* xh, const unsigned char* xl, int lane) {
    const v4u* hp = (const v4u*)xh + 4 * lane; const v4u* lp = (const v4u*)xl + 2 * lane;
#pragma unroll
    for (int i = 0; i < 4; ++i) h[i] = hp[i];
#if !Q1_HI_ONLY
    l[0] = lp[0]; l[1] = lp[1];
#else
    (void)lp; (void)l;
#endif
}
__device__ __forceinline__ void quant_xrow(const v4u (&h)[4], const v4u (&l)[2], unsigned char* q8, float* rsa, int lane) {
    float v[32]; float mx = 0.f, sq = 0.f;
#pragma unroll
    for (int i = 0; i < 32; ++i) { const unsigned hw = h[i >> 3][(i >> 1) & 3]; const unsigned hb = (i & 1) ? (hw >> 16) : (hw & 0xffffu);
#if !Q1_HI_ONLY
        const int q = (int)(l[i >> 4][(i >> 2) & 3] << (24 - 8 * (i & 3))) >> 24;
        v[i] = pg8::res_dec(hb, q);
#else
        v[i] = __uint_as_float(hb << 16);
#endif
        mx = fmaxf(mx, fabsf(v[i])); sq += v[i] * v[i]; }
    mx = fmaxf(mx, pg8::sx<1>(mx)); mx = fmaxf(mx, pg8::sx<2>(mx)); mx = fmaxf(mx, pg8::sx<4>(mx)); mx = fmaxf(mx, pg8::sx<8>(mx)); mx = fmaxf(mx, pg8::sx<16>(mx));
    { auto rr = __builtin_amdgcn_permlane32_swap(__float_as_uint(mx), __float_as_uint(mx), false, false); mx = fmaxf(__uint_as_float(rr[0]), __uint_as_float(rr[1])); }
    sq = wave_sum(sq);
    const float inv = mx > 0.f ? 127.f / mx : 0.f;
    v4u o[2];
#pragma unroll
    for (int i = 0; i < 32; i += 4) { const unsigned b0 = (unsigned)(int)__builtin_rintf(v[i] * inv) & 0xffu, b1 = (unsigned)(int)__builtin_rintf(v[i + 1] * inv) & 0xffu,
                                                     b2 = (unsigned)(int)__builtin_rintf(v[i + 2] * inv) & 0xffu, b3 = (unsigned)(int)__builtin_rintf(v[i + 3] * inv) & 0xffu;
        o[i >> 4][(i >> 2) & 3] = b0 | (b1 << 8) | (b2 << 16) | (b3 << 24); }
    v4u* d = (v4u*)q8 + 2 * lane; d[0] = o[0]; d[1] = o[1];
    if (lane == 0) *rsa = __builtin_amdgcn_rsqf(sq * (1.f / D) + EPS) * mx * (1.f / 127.f);
}
template <int NP> __device__ __forceinline__ void quant_row_bf16(const bf16* src, unsigned char* dst, float amax_known, bool have_amax, float* step_out, int lane) {
    v4u w[NP]; float mx = 0.f;
#pragma unroll
    for (int p = 0; p < NP; ++p) w[p] = ((const v4u*)src)[p * 64 + lane];
    if (!have_amax) {
#pragma unroll
        for (int p = 0; p < NP; ++p)
#pragma unroll
            for (int e = 0; e < 4; ++e) mx = fmaxf(mx, fmaxf(fabsf(bflo(w[p][e])), fabsf(bfhi(w[p][e]))));
        mx = fmaxf(mx, pg8::sx<1>(mx)); mx = fmaxf(mx, pg8::sx<2>(mx)); mx = fmaxf(mx, pg8::sx<4>(mx)); mx = fmaxf(mx, pg8::sx<8>(mx)); mx = fmaxf(mx, pg8::sx<16>(mx));
        { auto rr = __builtin_amdgcn_permlane32_swap(__float_as_uint(mx), __float_as_uint(mx), false, false); mx = fmaxf(__uint_as_float(rr[0]), __uint_as_float(rr[1])); }
    } else mx = amax_known;
    const float inv = mx > 0.f ? 127.f / mx : 0.f;
#pragma unroll
    for (int p = 0; p < NP; ++p) { v2u o;
#pragma unroll
        for (int hh = 0; hh < 2; ++hh) { const unsigned a = w[p][2 * hh], b = w[p][2 * hh + 1];
            o[hh] = ((unsigned)(int)__builtin_rintf(bflo(a) * inv) & 0xffu) | (((unsigned)(int)__builtin_rintf(bfhi(a) * inv) & 0xffu) << 8)
                  | (((unsigned)(int)__builtin_rintf(bflo(b) * inv) & 0xffu) << 16) | (((unsigned)(int)__builtin_rintf(bfhi(b) * inv) & 0xffu) << 24); }
        ((v2u*)dst)[p * 64 + lane] = o; }
    if (lane == 0) *step_out = mx * (1.f / 127.f);
}
constexpr int NPC = FF / 512;
__device__ __forceinline__ void requant_row_load(v2u (&w)[NPC], float (&sb)[NPC], const unsigned char* q, const float* bs, int lane) {
#pragma unroll
    for (int p = 0; p < NPC; ++p) { w[p] = ((const v2u*)q)[p * 64 + lane]; sb[p] = bs[(p * 64 + lane) >> 2]; }
}
__device__ __forceinline__ void requant_row_blocks(const v2u (&w)[NPC], const float (&sb)[NPC], unsigned char* q, float* step_out, int lane) {
    float smax = 0.f;
#pragma unroll
    for (int p = 0; p < NPC; ++p) smax = fmaxf(smax, sb[p]);
    smax = fmaxf(smax, pg8::sx<1>(smax)); smax = fmaxf(smax, pg8::sx<2>(smax)); smax = fmaxf(smax, pg8::sx<4>(smax)); smax = fmaxf(smax, pg8::sx<8>(smax)); smax = fmaxf(smax, pg8::sx<16>(smax));
    { auto rr = __builtin_amdgcn_permlane32_swap(__float_as_uint(smax), __float_as_uint(smax), false, false); smax = fmaxf(__uint_as_float(rr[0]), __uint_as_float(rr[1])); }
    const float isx = smax > 0.f ? __builtin_amdgcn_rcpf(smax) : 0.f;
#pragma unroll
    for (int p = 0; p < NPC; ++p) { const float r = fminf(sb[p] * isx, 1.f); v2u o;
#pragma unroll
        for (int hh = 0; hh < 2; ++hh) { const unsigned a = w[p][hh];
            const float f0 = (float)((int)(a << 24) >> 24), f1 = (float)((int)(a << 16) >> 24), f2 = (float)((int)(a << 8) >> 24), f3 = (float)((int)a >> 24);
            o[hh] = ((unsigned)(int)__builtin_rintf(f0 * r) & 0xffu) | (((unsigned)(int)__builtin_rintf(f1 * r) & 0xffu) << 8)
                  | (((unsigned)(int)__builtin_rintf(f2 * r) & 0xffu) << 16) | (((unsigned)(int)__builtin_rintf(f3 * r) & 0xffu) << 24); }
        ((v2u*)q)[p * 64 + lane] = o; }
    if (lane == 0) *step_out = smax;
}
__device__ __forceinline__ void load_rsa(LAS unsigned char* lds, int pm, const float* RSA, int wave_s) {
    const int tid = pg8::otid(wave_s);
    if (tid < 256) ((LAS float*)(lds + RS_OFF))[tid] = RSA[pm * 256 + tid];
    __syncthreads();
}

__device__ __forceinline__ void compute_rs(LAS unsigned char* lds, int pm, const float* SS, int wave_s) {
    const int tid = pg8::otid(wave_s);
    const f32x4* p = (const f32x4*)(SS + (size_t)(pm * 256 + (tid >> 1)) * 32 + (tid & 1) * 16);
    const f32x4 a = p[0], b = p[1], c = p[2], d = p[3];
    float s = ((a[0] + a[1]) + (a[2] + a[3])) + ((b[0] + b[1]) + (b[2] + b[3])) + ((c[0] + c[1]) + (c[2] + c[3])) + ((d[0] + d[1]) + (d[2] + d[3]));
    s += pg8::sx<1>(s);
    if ((tid & 1) == 0) ((LAS float*)(lds + RS_OFF))[tid >> 1] = __builtin_amdgcn_rsqf(s * (1.f / D) + EPS);
    __syncthreads();
}

__device__ __forceinline__ float sigmoidf_(float z) { return __builtin_amdgcn_rcpf(1.f + __expf(-z)); }
__device__ __forceinline__ float gelu_tanh(float x) { const float z = 0.7978845608028654f * (x + 0.044715f * x * x * x); const float t = __expf(2.f * z); return 0.5f * x * (2.f - 2.f * __builtin_amdgcn_rcpf(t + 1.f)); }
__device__ __forceinline__ bf16 f2bf(float f) { unsigned u = __float_as_uint(f); return (bf16)((u + 0x7fffu + ((u >> 16) & 1u)) >> 16); }
__device__ __forceinline__ void lru_unit(LAS unsigned char* lds, int b, int ck, const bf16* P, const float* cw, const float* cbias, const bf16* WG,
                                         const float* b_a, const float* b_x, const float* lam, float* CS, float* HL, float* CA, int wave_s) {
    const int tid = pg8::otid(wave_s), wid = __builtin_amdgcn_readfirstlane(tid >> 6), lane = tid & 63, j = lane & 31, hi = lane >> 5;
    LAS float* XF = (LAS float*)(lds + LRU_XF); LAS unsigned char* XH = lds + LRU_XH;
    const int g = wid >> 1, cwv = 64 * wid;
    float A64[2] = {1.f, 1.f}, H64[2] = {0.f, 0.f};
    volatile LAS unsigned* MISCp = (volatile LAS unsigned*)(lds + MISC_OFF);
#define LT0(r) do { if (DIAG_REGION == (r) && xb_thread0(wave_s)) MISCp[19] = (unsigned)__builtin_amdgcn_s_memrealtime(); } while (0)
#define LT1(r) do { if (DIAG_REGION == (r) && xb_thread0(wave_s)) MISCp[18] += (unsigned)__builtin_amdgcn_s_memrealtime() - MISCp[19]; } while (0)
#pragma nounroll
    for (int sub = 0; sub < LCH / 32; ++sub) {
    const int t0 = ck * LCH + 32 * sub; const size_t m0 = (size_t)b * T + t0;
    LT0(5);
#pragma unroll
    for (int it = 0; it < 4; ++it) {
        const int idx = it * 512 + tid, tt = idx >> 6, c0 = (idx & 63) * 8;
        f32x4 a0 = *(const f32x4*)(cbias + c0), a1 = *(const f32x4*)(cbias + c0 + 4);
        v4u w[4];
#pragma unroll
        for (int k = 0; k < 4; ++k) { const int tr = t0 + tt - 3 + k; w[k] = *(const v4u*)(P + (m0 + (tr >= 0 ? tt - 3 + k : -t0)) * PW + PC_X + c0); }
#pragma unroll
        for (int k = 0; k < 4; ++k) { const float ok = (t0 + tt - 3 + k >= 0) ? 1.f : 0.f;
            const f32x4 w0 = *(const f32x4*)(cw + k * DLRU + c0) * ok, w1 = *(const f32x4*)(cw + k * DLRU + c0 + 4) * ok;
            a0[0] += w0[0] * bflo(w[k].x); a0[1] += w0[1] * bfhi(w[k].x); a0[2] += w0[2] * bflo(w[k].y); a0[3] += w0[3] * bfhi(w[k].y);
            a1[0] += w1[0] * bflo(w[k].z); a1[1] += w1[1] * bfhi(w[k].z); a1[2] += w1[2] * bflo(w[k].w); a1[3] += w1[3] * bfhi(w[k].w);
        }
        *(LAS f32x4*)(XF + tt * DLRU + c0) = a0; *(LAS f32x4*)(XF + tt * DLRU + c0 + 4) = a1;
        v4u hw; hw.x = pk2(a0[0], a0[1]); hw.y = pk2(a0[2], a0[3]); hw.z = pk2(a1[0], a1[1]); hw.w = pk2(a1[2], a1[3]);
        *(LAS v4u*)(XH + tt * LRU_XH_PITCH + c0 * 2) = hw;
    }
    __syncthreads();
    LT1(5); LT0(6);
    f32x16 acc[2][2];
#pragma unroll
    for (int ga = 0; ga < 2; ++ga)
#pragma unroll
        for (int nt = 0; nt < 2; ++nt)
#pragma unroll
            for (int r = 0; r < 16; ++r) acc[ga][nt][r] = 0.f;
#pragma unroll
    for (int ks = 0; ks < 8; ++ks) {
        const bf16x8 A = *(const LAS bf16x8*)(XH + j * LRU_XH_PITCH + (128 * g + 16 * ks + 8 * hi) * 2);
#pragma unroll
        for (int ga = 0; ga < 2; ++ga)
#pragma unroll
            for (int nt = 0; nt < 2; ++nt) {
                const bf16x8 Bf = *(const bf16x8*)(WG + ((size_t)((((ga * 4 + g) * 2 + (wid & 1)) * 2 + nt) * 8 + ks) * 64 + lane) * 8);
                acc[ga][nt] = __builtin_amdgcn_mfma_f32_32x32x16_bf16(A, Bf, acc[ga][nt], 0, 0, 0);
            }
    }
    if (DIAG_REGION == 6 || DIAG_REGION == 7) asm volatile("s_waitcnt vmcnt(0) lgkmcnt(0)" ::: "memory");
    LT1(6); LT0(7);
#pragma unroll
    for (int nt = 0; nt < 2; ++nt) {
        const int c = cwv + 32 * nt + j;
        const float ba = b_a[c], bx = b_x[c], nl = -lam[c], sp = nl > 20.f ? nl : pg8::log1p_small(__expf(nl));
#pragma unroll
        for (int r = 0; r < 16; ++r) { const int tt = (r & 3) + 8 * (r >> 2) + 4 * hi;
            const float xr = XF[tt * DLRU + c];
            const float rg = sigmoidf_(acc[0][nt][r] + ba), ig = sigmoidf_(acc[1][nt][r] + bx);
            const float la = -8.f * rg * sp, a = __expf(la), x2 = 2.f * la;
            const float ser = -x2 * (1.f + x2 * 0.5f * (1.f + x2 * (1.f / 3.f) * (1.f + x2 * 0.25f * (1.f + x2 * 0.2f * (1.f + x2 * (1.f / 6.f) * (1.f + x2 * (1.f / 7.f) * (1.f + x2 * 0.125f)))))));
            const float em = x2 < -0.5f ? 1.f - a * a : ser, mult = __builtin_amdgcn_sqrtf(em);
            acc[0][nt][r] = a; acc[1][nt][r] = mult * (ig * xr); }
        float Ae[4], He[4], pA[4], pH[4], cin[4], ain[4];
#pragma unroll
        for (int q = 0; q < 4; ++q) { float hl = 0.f, cA = 1.f;
#pragma unroll
            for (int e = 0; e < 4; ++e) { const int r = 4 * q + e; const float a = acc[0][nt][r], u = acc[1][nt][r]; hl = a * hl + u; cA *= a; acc[1][nt][r] = hl; acc[0][nt][r] = cA; }
            Ae[q] = cA; He[q] = hl; cin[q] = 0.f; ain[q] = 1.f; }
#pragma unroll
        for (int q = 0; q < 4; ++q) { pA[q] = pg8::other32(Ae[q], hi); pH[q] = pg8::other32(He[q], hi); }
        float carry = 0.f, Arun = 1.f;
#pragma unroll
        for (int G = 0; G < 8; ++G) { const int q = G >> 1; const bool mine = ((G & 1) == hi);
            const float Ag = mine ? Ae[q] : pA[q], Hg = mine ? He[q] : pH[q];
            cin[q] = mine ? carry : cin[q]; ain[q] = mine ? Arun : ain[q]; carry = Ag * carry + Hg; Arun *= Ag; }
#pragma unroll
        for (int r = 0; r < 16; ++r) { acc[1][nt][r] = acc[1][nt][r] + acc[0][nt][r] * cin[r >> 2]; acc[0][nt][r] = acc[0][nt][r] * ain[r >> 2]; }
        H64[nt] = Arun * H64[nt] + carry; A64[nt] *= Arun;
        if (sub == LCH / 32 - 1 && hi == 0) { f32x2 s; s.x = A64[nt]; s.y = H64[nt]; *(f32x2*)(CS + ((size_t)(b * NCH + ck) * DLRU + c) * 2) = s; }
    }
    __syncthreads();
    LT1(7); LT0(8);
    { LAS float* stg = XF + wid * 2048;
#pragma unroll
      for (int arr = 0; arr < 2; ++arr) {
#pragma unroll
        for (int nt = 0; nt < 2; ++nt)
#pragma unroll
            for (int r = 0; r < 16; ++r) stg[((r & 3) + 8 * (r >> 2) + 4 * hi) * 64 + 32 * nt + j] = acc[1 - arr][nt][r];
        LDS_WAIT(); asm volatile("" ::: "memory");
        bf16* dst = (bf16*)(arr == 0 ? HL : CA) + m0 * DLRU + cwv + (lane & 15) * 4;
#pragma unroll
        for (int i = 0; i < 8; ++i) { const int tt = (lane >> 4) + 4 * i; const f32x4 t4 = *(const LAS f32x4*)(stg + tt * 64 + (lane & 15) * 4);
            v2u o; o.x = pk2(t4[0], t4[1]); o.y = pk2(t4[2], t4[3]); *(v2u*)(dst + (size_t)tt * DLRU) = o; }
        LDS_WAIT(); asm volatile("" ::: "memory");
      } }
    __syncthreads();
    LT1(8);
    }
#undef LT0
#undef LT1
}

__device__ __forceinline__ void token_unit(int m, int lane, const bf16* P, const bf16* YA, const float* cw, bf16* Y, const float* HL, const float* CA, const LAS float* st) {
    const int t = m & (T - 1);
    const bf16* pr = P + (size_t)m * PW + 8 * lane;
    const v4u cb = *(const v4u*)(pr + PC_B), c0 = *(const v4u*)(pr + PC_C), v0 = *(const v4u*)(pr + PC_V);
    v4u c1 = {0u, 0u, 0u, 0u}, v1 = {0u, 0u, 0u, 0u}, c2 = {0u, 0u, 0u, 0u}, v2 = {0u, 0u, 0u, 0u};
    if (t >= 1) { c1 = *(const v4u*)(pr - PW + PC_C); v1 = *(const v4u*)(pr - PW + PC_V); }
    if (t >= 2) { c2 = *(const v4u*)(pr - 2 * PW + PC_C); v2 = *(const v4u*)(pr - 2 * PW + PC_V); }
    float y[8]; float s = 0.f;
#pragma unroll
    for (int e = 0; e < 4; ++e) {
        const int ch = 8 * lane + 2 * e;
        const float z0l = bflo(c0[e]) * bflo(v0[e]), z0h = bfhi(c0[e]) * bfhi(v0[e]);
        const float z1l = bflo(c1[e]) * bflo(v1[e]), z1h = bfhi(c1[e]) * bfhi(v1[e]);
        const float z2l = bflo(c2[e]) * bflo(v2[e]), z2h = bfhi(c2[e]) * bfhi(v2[e]);
        const f32x2 w0 = *(const f32x2*)(cw + ch), w1 = *(const f32x2*)(cw + DCONV + ch), w2 = *(const f32x2*)(cw + 2 * DCONV + ch);
        y[2 * e] = bflo(cb[e]) * (w0.x * z2l + w1.x * z1l + w2.x * z0l);
        y[2 * e + 1] = bfhi(cb[e]) * (w0.y * z2h + w1.y * z1h + w2.y * z0h);
        s += y[2 * e] * y[2 * e] + y[2 * e + 1] * y[2 * e + 1];
    }
    s = wave_sum(s);
    const float rsc = __builtin_amdgcn_rsqf(s * (1.f / DCONV) + EPS);
    v4u o; o.x = pk2(y[0] * rsc, y[1] * rsc); o.y = pk2(y[2] * rsc, y[3] * rsc); o.z = pk2(y[4] * rsc, y[5] * rsc); o.w = pk2(y[6] * rsc, y[7] * rsc);
    *(v4u*)(Y + (size_t)m * D + 8 * lane) = o;
    const v4u a0 = *(const v4u*)(YA + (size_t)m * DATT + 16 * lane), a1 = *(const v4u*)(YA + (size_t)m * DATT + 16 * lane + 8);
    float tot = 0.f;
#pragma unroll
    for (int e = 0; e < 4; ++e) { const float x0 = bflo(a0[e]), x1 = bfhi(a0[e]), x2 = bflo(a1[e]), x3 = bfhi(a1[e]); tot += (x0 * x0 + x1 * x1) + (x2 * x2 + x3 * x3); }
    tot = wave_sum(tot);
    const float rsa = __builtin_amdgcn_rsqf(tot * (1.f / DATT) + EPS);
    v4u q0, q1;
#pragma unroll
    for (int e = 0; e < 4; ++e) { q0[e] = pk2(bflo(a0[e]) * rsa, bfhi(a0[e]) * rsa); q1[e] = pk2(bflo(a1[e]) * rsa, bfhi(a1[e]) * rsa); }
    *(v4u*)(Y + (size_t)m * D + DCONV + 16 * lane) = q0; *(v4u*)(Y + (size_t)m * D + DCONV + 16 * lane + 8) = q1;
    { const f32x4 s0 = *(const LAS f32x4*)(st + 8 * lane), s1 = *(const LAS f32x4*)(st + 8 * lane + 4);
      const v4u hh = *(const v4u*)((const bf16*)HL + (size_t)m * DLRU + 8 * lane), aa = *(const v4u*)((const bf16*)CA + (size_t)m * DLRU + 8 * lane);
      const f32x4 h0 = {bflo(hh.x), bfhi(hh.x), bflo(hh.y), bfhi(hh.y)}, h1 = {bflo(hh.z), bfhi(hh.z), bflo(hh.w), bfhi(hh.w)};
      const f32x4 a0 = {bflo(aa.x), bfhi(aa.x), bflo(aa.y), bfhi(aa.y)}, a1 = {bflo(aa.z), bfhi(aa.z), bflo(aa.w), bfhi(aa.w)};
      const v4u gt = *(const v4u*)(pr + PC_G);
      float yl[8]; float sl = 0.f;
#pragma unroll
      for (int e = 0; e < 4; ++e) { const float hA = h0[e] + a0[e] * s0[e], hB = h1[e] + a1[e] * s1[e];
          const float gA = (e & 1) ? bfhi(gt[e >> 1]) : bflo(gt[e >> 1]), gB = (e & 1) ? bfhi(gt[2 + (e >> 1)]) : bflo(gt[2 + (e >> 1)]);
          yl[e] = gelu_tanh(gA) * hA; yl[4 + e] = gelu_tanh(gB) * hB; sl += yl[e] * yl[e] + yl[4 + e] * yl[4 + e]; }
      sl = wave_sum(sl);
      const float rsl = __builtin_amdgcn_rsqf(sl * (1.f / DLRU) + EPS);
      v4u ol; ol.x = pk2(yl[0] * rsl, yl[1] * rsl); ol.y = pk2(yl[2] * rsl, yl[3] * rsl); ol.z = pk2(yl[4] * rsl, yl[5] * rsl); ol.w = pk2(yl[6] * rsl, yl[7] * rsl);
      *(v4u*)(Y + (size_t)m * D + (DCONV + DATT) + 8 * lane) = ol; }
}

#ifndef DIAG_IDLE
#define DIAG_IDLE 0
#endif
#ifndef DIAG_XCDSKEW
#define DIAG_XCDSKEW 0
#endif
#ifndef DIAG_CLOCK
#define DIAG_CLOCK 0
#endif
#ifndef LAYER_UNROLL
#define LAYER_UNROLL 0
#endif
#ifndef DIAG_KMIN
#define DIAG_KMIN 1
#endif
#ifndef DIAG_BARTIME
#define DIAG_BARTIME 0
#endif
#ifndef DIAG_REGION
#define DIAG_REGION 0
#endif
#define RT0(r) do { if (DIAG_REGION == (r) && xb_thread0(wave_s)) MISC[19] = (unsigned)__builtin_amdgcn_s_memrealtime(); } while (0)
#define RT1(r) do { if (DIAG_REGION == (r) && xb_thread0(wave_s)) MISC[18] += (unsigned)__builtin_amdgcn_s_memrealtime() - MISC[19]; } while (0)
#ifndef DIAG_MASK
#define DIAG_MASK 0xff
#endif
#ifndef DIAG_SCALE
#define DIAG_SCALE 1.0f
#endif
#ifndef PG8_SP2
#define PG8_SP2 true
#endif
#ifndef PG8_ALIGN
#define PG8_ALIGN true
#endif
#ifndef REP_G2
#define REP_G2 1
#endif
#ifndef REP_G4
#define REP_G4 1
#endif
#ifndef REP_G6
#define REP_G6 1
#endif
#ifndef REP_P0
#define REP_P0 1
#endif
#ifndef REP_G1
#define REP_G1 1
#endif
#ifndef REP_G3
#define REP_G3 1
#endif
#ifndef REP_X1
#define REP_X1 1
#endif
#ifndef REP_X2
#define REP_X2 1
#endif
#ifndef EN_ALL
#define EN_ALL 1
#endif
#ifndef EN_P0
#define EN_P0 EN_ALL
#endif
#ifndef EN_G1
#define EN_G1 EN_ALL
#endif
#ifndef EN_G2
#define EN_G2 EN_ALL
#endif
#ifndef EN_G3
#define EN_G3 EN_ALL
#endif
#ifndef EN_X1
#define EN_X1 EN_ALL
#endif
#ifndef EN_X2
#define EN_X2 EN_ALL
#endif
#ifndef EN_G4
#define EN_G4 EN_ALL
#endif
#ifndef EN_G5
#define EN_G5 EN_ALL
#endif
#ifndef EN_G6
#define EN_G6 EN_ALL
#endif
#ifndef EN_ATT
#define EN_ATT 1
#endif
#ifndef EN_LRU
#define EN_LRU 1
#endif
#ifndef ATT_ONESITE
#define ATT_ONESITE 1
#endif
#ifndef EN_FN
#define EN_FN EN_ALL
#endif
#ifndef MK_SINGLE
#define MK_SINGLE 1
#endif
struct Args { const float* in[21]; float* out; unsigned char* ws; int ph_lo, ph_hi; };
typedef const __attribute__((address_space(4))) Args* CArgs;
__device__ __forceinline__ CArgs oargs(CArgs p) { asm volatile("" : "+s"(p)); return p; }
template <class T> __device__ __forceinline__ T* asglobal(T* p) { return (T*)(__attribute__((address_space(1))) T*)p; }
#define WSP(T, off) ((T*)(ws + (off)))
__global__ void __launch_bounds__(NWAVES * 64, 2) hymba_fwd(Args args_unused) {
    extern __shared__ __attribute__((aligned(16))) unsigned char lds_raw[];
    LAS unsigned char* lds = (LAS unsigned char*)lds_raw;
    volatile LAS unsigned* MISC = (volatile LAS unsigned*)(lds + MISC_OFF);
    const CArgs ap = (CArgs)__builtin_amdgcn_kernarg_segment_ptr();
    const int G0 = gridDim.x, bid0 = blockIdx.x;
    const int wave_s = __builtin_amdgcn_readfirstlane(threadIdx.x >> 6);
    { const int tid = pg8::otid(wave_s); for (int u = tid; u < (LDS_BYTES - LDSCTL_OFF) / 4; u += NWAVES * 64) ((LAS unsigned*)(lds + LDSCTL_OFF))[u] = 0u; }
    __syncthreads();
#if MK_SINGLE
    constexpr int lo = 0, hi = N_PHASES;
#else
    const int lo = ap->ph_lo, hi = ap->ph_hi;
#endif
    XcdBarrier bar; bar.bar = (unsigned*)(asglobal(ap->ws) + WS_CTL) + CW_BAR; bar.x = 0; bar.st = nullptr; bar.w = wave_s; bar.np = (unsigned)G0;
    if (hi - lo > 1) bar = xcd_barrier_post((unsigned*)(asglobal(ap->ws) + WS_CTL) + CW_BAR, MISC + 8, wave_s, (unsigned)G0);
#define IN(k) (lo <= (k) && (k) < hi)
#define MY_PANEL() pg8::StaticOrder Sp_; Sp_.init(M, D, G, bid); pg8::Unit up_; up_.pm = 0; up_.pn = 0; Sp_.next(0, up_); const int pmine = up_.pm, prank = up_.pn; (void)pmine; (void)prank
    if (xb_thread0(wave_s)) { int G = G0, bid = bid0; MY_PANEL(); (void)__hip_atomic_fetch_or((unsigned*)(asglobal(ap->ws) + WS_CTL) + CW_PMASK + 64 * pmine, 1u << (xb_xcc_id() & 15u), __ATOMIC_RELAXED, __HIP_MEMORY_SCOPE_AGENT); }
    int npb = 0;
    { int G = G0, bid = bid0; MY_PANEL(); (void)xcd_barrier_post((unsigned*)(asglobal(ap->ws) + WS_CTL) + CW_BAR2 + 4096 * (pmine >> 4), MISC + 10, wave_s, 64u); }
#define SEAM_B(k) do { if (IN((k) + 1)) { int G = G0, bid = bid0; asm volatile("" : "+s"(G), "+s"(bid)); MY_PANEL(); XcdBarrier bb_; bb_.np = 64u; bb_.bar = (unsigned*)(asglobal(oargs(ap)->ws) + WS_CTL) + CW_BAR2 + 4096 * (pmine >> 4); bb_.x = xb_xcc_id(); bb_.w = wave_s; bb_.st = MISC + 10; xcd_barrier(bb_); } } while (0)
#if DIAG_BARTIME || DIAG_XCDSKEW
#define SEAM(k) do { if (IN((k) + 1)) { if (xb_thread0(wave_s)) MISC[17] = (unsigned)__builtin_amdgcn_s_memrealtime(); xcd_barrier(bar); \
        if (xb_thread0(wave_s) && (k) >= DIAG_KMIN && DIAG_BARTIME == 1) MISC[16] += (unsigned)__builtin_amdgcn_s_memrealtime() - MISC[17]; } } while (0)
#elif DIAG_IDLE
#define SEAM(k) do { if (IN((k) + 1)) { const unsigned long long t0_ = __builtin_amdgcn_s_memrealtime(); while (__builtin_amdgcn_s_memrealtime() - t0_ < (unsigned long long)DIAG_IDLE) __builtin_amdgcn_s_sleep(16); xcd_barrier(bar); } } while (0)
#else
#define SEAM(k) do { if (IN((k) + 1)) xcd_barrier(bar); } while (0)
#endif
#define SEAM_P(k) do { if (IN((k) + 1)) { int G = G0, bid = bid0; asm volatile("" : "+s"(G), "+s"(bid)); MY_PANEL(); ++npb; if (DIAG_BARTIME == 2 && xb_thread0(wave_s)) MISC[17] = (unsigned)__builtin_amdgcn_s_memrealtime(); panel_barrier((unsigned*)(asglobal(oargs(ap)->ws) + WS_CTL), pmine, (unsigned)(NOWN * npb), MISC, wave_s); if (DIAG_BARTIME == 2 && xb_thread0(wave_s)) MISC[16] += (unsigned)__builtin_amdgcn_s_memrealtime() - MISC[17]; } } while (0)
#define PHASE_ENTRY() int G = G0, bid = bid0; asm volatile("" : "+s"(G), "+s"(bid)); const CArgs a = oargs(ap); unsigned char* const ws = asglobal(a->ws); const int tid = pg8::otid(wave_s), lane = tid & 63, wave = wave_s; \
        const int gw = bid * NWAVES + wave, NGW = G * NWAVES; (void)lane; (void)gw; (void)NGW; (void)ws; (void)G; (void)bid
    const LAS float* rs_lds = (const LAS float*)(lds + RS_OFF);

    if (EN_P0 && IN(0))
_Pragma("nounroll") for (int rep_ = 0; rep_ < REP_P0; ++rep_) {
        PHASE_ENTRY();
        LAS unsigned* scr = (LAS unsigned*)(lds + RING_OFF + wave * 8192);
        RT0(9);
        {
            for (int sidx = bid; sidx < 2 * DEPTH * (NFF / 64); sidx += G) { const int mat = sidx / (NFF / 64), strip = sidx % (NFF / 64), f = mat / DEPTH, lw = mat % DEPTH;
                w1_strip((f ? asglobal(a->in[18]) : asglobal(a->in[2])) + (size_t)lw * D * NFF, (f ? asglobal(a->in[17]) : asglobal(a->in[1])) + lw * D,
                         WSP(unsigned char, WS_W1Q) + (size_t)mat * SZ_W1Q, WSP(float, WS_SW) + (size_t)mat * NFF, strip, lds, wave, tid, lane); }
            for (int sidx = bid; sidx < 2 * DEPTH * (D / 16); sidx += G) { const int mat = sidx / (D / 16), strip = sidx % (D / 16), f = mat / DEPTH, lw = mat % DEPTH;
                w2_strip((f ? asglobal(a->in[19]) : asglobal(a->in[3])) + (size_t)lw * FF * D, WSP(unsigned char, WS_W2Q) + (size_t)mat * D * FF, WSP(float, WS_SW2) + (size_t)mat * D, strip, lds, wave, tid, lane); }
            __syncthreads();
        }
        for (int l = 0; l < DEPTH; ++l) {
            tr_matrix<2>(asglobal(a->in[5]) + (size_t)l * D * DIN, D, DIN, asglobal(a->in[4]) + l * D, WSP(bf16, WS_WM + (size_t)l * SZ_WM), NMIX, scr, gw, NGW, lane);
            tr_matrix<0>(asglobal(a->in[16]) + (size_t)l * D * D, D, D, asglobal(a->in[15]) + l * D, WSP(bf16, WS_WO + (size_t)l * SZ_WO), D, scr, gw, NGW, lane);
        }
        {
            v4u* dst = (v4u*)WSP(bf16, WS_WGF);
            for (int pc = gw * 64 + lane; pc < DEPTH * 8 * 2048; pc += NGW * 64) { const int lm = pc >> 11, l2 = lm >> 3, mat = lm & 7, ga = mat >> 2, g = mat & 3, d = pc & 2047, ln = d & 63, ks = (d >> 6) & 7, nt = (d >> 9) & 1, hf = (d >> 10) & 1;
                const float* sp = (ga ? asglobal(a->in[12]) : asglobal(a->in[10])) + ((size_t)(l2 * 4 + g) * 128 + 16 * ks + 8 * (ln >> 5)) * 128 + 64 * hf + 32 * nt + (ln & 31);
                v4u o;
#pragma unroll
                for (int e = 0; e < 4; ++e) o[e] = pk2(sp[(2 * e) * 128], sp[(2 * e + 1) * 128]);
                dst[pc] = o; }
        }
        RT1(9); RT0(10);
        const float* xin = asglobal(a->in[0]); bf16* XB = WSP(bf16, WS_XB); float* SS = WSP(float, WS_SS);
        for (int m = gw; m < M; m += NGW) {
            const GAS f32x4* xr = (const GAS f32x4*)(xin + (size_t)m * D) + lane; float s = 0.f;
            GAS v2u* o8 = (GAS v2u*)(XB + (size_t)m * D) + lane; GAS unsigned* l8 = (GAS unsigned*)(WSP(unsigned char, WS_XL) + (size_t)m * D) + lane;
#pragma unroll
            for (int jj = 0; jj < 8; ++jj) { const f32x4 v = xr[64 * jj]; s += (v[0] * v[0] + v[1] * v[1]) + (v[2] * v[2] + v[3] * v[3]);
                v2u w;
                if (RES_LO == 2) { const unsigned u0 = __float_as_uint(v[0]) + 0x80u, u1 = __float_as_uint(v[1]) + 0x80u, u2 = __float_as_uint(v[2]) + 0x80u, u3 = __float_as_uint(v[3]) + 0x80u;
                    w.x = __builtin_amdgcn_perm(u1, u0, 0x07060302u); w.y = __builtin_amdgcn_perm(u3, u2, 0x07060302u); o8[64 * jj] = w;
                    l8[64 * jj] = __builtin_amdgcn_perm(__builtin_amdgcn_perm(u3, u2, 0x0c0c0501u), __builtin_amdgcn_perm(u1, u0, 0x0c0c0501u), 0x05040100u); }
                else { w.x = pk2(v[0], v[1]); w.y = pk2(v[2], v[3]); o8[64 * jj] = w;
                if (RES_LO == 1) l8[64 * jj] = ((unsigned)pg8::res_enc(v[0], w.x & 0xffffu) & 0xffu) | (((unsigned)pg8::res_enc(v[1], w.x >> 16) & 0xffu) << 8)
                            | (((unsigned)pg8::res_enc(v[2], w.y & 0xffffu) & 0xffu) << 16) | (((unsigned)pg8::res_enc(v[3], w.y >> 16) & 0xffu) << 24); } }
            s = wave_sum(s);
            if (lane < 32) SS[(size_t)m * 32 + lane] = (lane == 0) ? s : 0.f;
        }
        RT1(10);
        SEAM(0);
        if (xb_thread0(wave_s)) { MY_PANEL(); const unsigned mk = xb_ld((unsigned*)(ws + WS_CTL) + CW_PMASK + 64 * pmine); MISC[12] = (mk != 0u && (mk & (mk - 1u)) == 0u) ? 1u : 0u; }
    }

#if LAYER_UNROLL
#pragma clang loop unroll(full)
#else
#pragma nounroll
#endif
    for (int l = 0; l < DEPTH; ++l) {
        const int pb = 1 + 12 * l;
        if (EN_G1 && IN(pb + 0)) {
            PHASE_ENTRY();
            MY_PANEL(); const int r0 = pmine * 256 + prank * 64 + wave;
            const bf16* XBp = WSP(bf16, WS_XB); const unsigned char* XLp = WSP(unsigned char, WS_XL); unsigned char* Q8p = WSP(unsigned char, WS_Q8); float* RSAp = WSP(float, WS_RSA);
            v4u hA[4], lA[2], hB[4], lB[2];
            quant_xrow_load(hA, lA, XBp + (size_t)r0 * D, XLp + (size_t)r0 * D, lane);
#pragma unroll
            for (int i = 0; i < 8; i += 2) { const int ma = r0 + 8 * i, mb = ma + 8;
                quant_xrow_load(hB, lB, XBp + (size_t)mb * D, XLp + (size_t)mb * D, lane);
                quant_xrow(hA, lA, Q8p + (size_t)ma * D, RSAp + ma, lane);
                if (i + 2 < 8) quant_xrow_load(hA, lA, XBp + (size_t)(mb + 8) * D, XLp + (size_t)(mb + 8) * D, lane);
                quant_xrow(hB, lB, Q8p + (size_t)mb * D, RSAp + mb, lane); }
            SEAM_P(pb + 0);
        }
        if (EN_G1 && IN(pb + 1))
_Pragma("nounroll") for (int rep_ = 0; rep_ < REP_G1; ++rep_) {
            PHASE_ENTRY();
            pg8::StaticOrder S; S.init(M, NFF, G, bid); pg8::Unit u0; u0.pm = 0; u0.pn = 0; S.next(0, u0); load_rsa(lds, u0.pm, WSP(float, WS_RSA), wave_s);
            pg8::Gemm g{WSP(bf16, WS_Q8), WSP(bf16, WS_W1Q + (size_t)(0 * DEPTH + l) * SZ_W1Q), M, NFF, D / 2}; pg8::EpiSwiGLUq E{WSP(unsigned char, WS_HQ), FF, rs_lds, WSP(float, WS_SW) + (0 * DEPTH + l) * NFF, WSP(float, WS_BS)};
            pg8::gemm_phase<pg8::EpiSwiGLUq, pg8::StaticOrder, PG8_ALIGN, PG8_SP2>(lds + RING_OFF, g, S, E, wave_s);
            SEAM_P(pb + 1);
        }
        if (EN_G2 && IN(pb + 2)) {
            PHASE_ENTRY();
            MY_PANEL(); const int r0 = pmine * 256 + prank * 64 + wave;
            unsigned char* HQp = WSP(unsigned char, WS_HQ); const float* BSp = WSP(float, WS_BS); float* SHp = WSP(float, WS_SH);
            v2u wA[NPC], wB[NPC]; float sA[NPC], sB[NPC];
            requant_row_load(wA, sA, HQp + (size_t)r0 * FF, BSp + (size_t)r0 * (FF / 32), lane);
#pragma unroll
            for (int i = 0; i < 8; i += 2) { const int ma = r0 + 8 * i, mb = ma + 8;
                requant_row_load(wB, sB, HQp + (size_t)mb * FF, BSp + (size_t)mb * (FF / 32), lane);
                requant_row_blocks(wA, sA, HQp + (size_t)ma * FF, SHp + ma, lane);
                if (i + 2 < 8) requant_row_load(wA, sA, HQp + (size_t)(mb + 8) * FF, BSp + (size_t)(mb + 8) * (FF / 32), lane);
                requant_row_blocks(wB, sB, HQp + (size_t)mb * FF, SHp + mb, lane); }
            SEAM_P(pb + 2);
        }
        if (EN_G2 && IN(pb + 3))
_Pragma("nounroll") for (int rep_ = 0; rep_ < REP_G2; ++rep_) {
            PHASE_ENTRY();
            pg8::StaticOrder S; S.init(M, D, G, bid); pg8::Unit u0; u0.pm = 0; u0.pn = 0; S.next(0, u0); load_rsa(lds, u0.pm, WSP(float, WS_SH), wave_s);
            pg8::Gemm g{WSP(bf16, WS_HQ), WSP(bf16, WS_W2Q + (size_t)(0 * DEPTH + l) * D * FF), M, D, FF / 2}; pg8::EpiRes<true> E{WSP(bf16, WS_XB), WSP(unsigned char, WS_XL), WSP(float, WS_SS), rep_ == REP_G2 - 1 ? 0.5f : 0.f, rs_lds, WSP(float, WS_SW2) + (0 * DEPTH + l) * D};
            pg8::gemm_phase<pg8::EpiRes<true>, pg8::StaticOrder, PG8_ALIGN, PG8_SP2>(lds + RING_OFF, g, S, E, wave_s);
            SEAM_P(pb + 3);
        }
        if (EN_G3 && IN(pb + 4))
_Pragma("nounroll") for (int rep_ = 0; rep_ < REP_G3; ++rep_) {
            PHASE_ENTRY();
            pg8::StaticOrder S; S.init(M, NMIX, G, bid); pg8::Unit u0; u0.pm = 0; u0.pn = 0; S.next(0, u0); compute_rs(lds, u0.pm, WSP(float, WS_SS), wave_s);
            pg8::Gemm g{WSP(bf16, WS_XB), WSP(bf16, WS_WM + (size_t)l * SZ_WM), M, NMIX, D}; pg8::EpiMix<false> E{WSP(bf16, WS_P - (size_t)(l & 1) * SZ_P), PW, rs_lds, WSP(float, WS_F), asglobal(a->in[7]) + l * NH, nullptr, WSP(float, WS_KN)};
            pg8::gemm_phase<pg8::EpiMix<false>, pg8::StaticOrder, PG8_ALIGN, PG8_SP2>(lds + RING_OFF, g, S, E, wave_s);
            SEAM_B(pb + 4);
        }
        if (EN_X1 && IN(pb + 5))
_Pragma("nounroll") for (int rep_ = 0; rep_ < REP_X1; ++rep_) {
            PHASE_ENTRY();
            const bf16* P = WSP(bf16, WS_P - (size_t)(l & 1) * SZ_P);
            RT0(1);
            MY_PANEL();
            if (EN_ATT) for (int once_ = 0; once_ < 1; ++once_) {
                const int wb = (pmine & 15) * NOWN + prank, b = pmine >> 4;
                unsigned* const qc = (unsigned*)(ws + WS_CTL) + CW_ATQ + (size_t)(l * BATCH + b) * 64;
                int cur_h = -1, h = wb & 7, qb = 15 - (wb >> 3); float kmax2 = 0.f;
#pragma nounroll
                for (;;) {
                    if (h != cur_h) { kmax2 = att::fill_table(WSP(float, WS_F) + (size_t)(b * 8 + h) * T, WSP(float, WS_KN) + (size_t)(b * 8 + h) * 4 * T, (char*)lds_raw + RING_OFF, wave_s); cur_h = h; }
                    const bf16* Pb = P + (size_t)b * T * PW + h * HD;
                    att::BlockRef r; r.P0 = qb * 256;
                    r.K = Pb + PC_K; r.V = Pb + PC_VV; r.Q = Pb + PC_Q + (size_t)r.P0 * PW;
                    r.O = WSP(bf16, WS_YA) + ((size_t)b * T + r.P0) * DATT + h * HD;
                    att::block_pp(r, (char*)lds_raw + RING_OFF, wave_s, kmax2, qc, MISC + 13);
                    const int idx = (int)MISC[13];
                    if (idx >= 64) break;
                    h = idx & 7; qb = 7 - (idx >> 3);
                }
                VM_WAIT(); __syncthreads();
            }
            RT1(1); RT0(2);
            if (EN_LRU) for (int u = NOWN * pmine + prank, once_ = 0; once_ < 1; ++once_)
                lru_unit(lds + RING_OFF, u / NCH, u % NCH, P, asglobal(a->in[8]) + l * 4 * DLRU, asglobal(a->in[9]) + l * DLRU, WSP(bf16, WS_WGF + (size_t)l * SZ_WG), asglobal(a->in[11]) + l * DLRU, asglobal(a->in[13]) + l * DLRU, asglobal(a->in[14]) + l * DLRU, WSP(float, WS_CS), WSP(float, WS_HL), WSP(float, WS_CA), wave_s);
            RT1(2);
            SEAM_B(pb + 5);
        }
        if (EN_X2 && IN(pb + 6))
_Pragma("nounroll") for (int rep_ = 0; rep_ < REP_X2; ++rep_) {
            PHASE_ENTRY();
            const bf16* P = WSP(bf16, WS_P - (size_t)(l & 1) * SZ_P);
            RT0(3);
            MY_PANEL();
            for (int u = NOWN * pmine + prank, once_ = 0; once_ < 1; ++once_) {
                const int b = u / NCH, ck = u % NCH; const size_t mc = (size_t)b * T + (size_t)ck * LCH;
                LAS float* st = (LAS float*)(lds + RING_OFF);
                const float* HLp = WSP(float, WS_HL); const float* CAp = WSP(float, WS_CA);
                { const int c = 64 * wave + lane; const f32x2* csp = (const f32x2*)WSP(float, WS_CS) + (size_t)b * NCH * DLRU + c; float h0 = 0.f; int k = 0;
                  for (; k + 16 <= ck; k += 16) { f32x2 sv[16];
#pragma unroll
                      for (int i = 0; i < 16; ++i) sv[i] = csp[(size_t)(k + i) * DLRU];
#pragma unroll
                      for (int i = 0; i < 16; ++i) h0 = sv[i].x * h0 + sv[i].y; }
                  for (; k < ck; ++k) { const f32x2 sv = csp[(size_t)k * DLRU]; h0 = sv.x * h0 + sv.y; }
                  st[c] = h0; st[512 + c] = bf1(((const bf16*)CAp)[(mc + 31) * DLRU + c]) * h0 + bf1(((const bf16*)HLp)[(mc + 31) * DLRU + c]); }
                __syncthreads();
                RT1(3); RT0(4);
#pragma nounroll
                for (int i = 0; i < 8; i += 2) {
                    token_unit((int)mc + 8 * wave + i, lane, P, WSP(bf16, WS_YA), asglobal(a->in[6]) + l * 3 * DCONV, WSP(bf16, WS_Y), HLp, CAp, st + 512 * (wave >> 2));
                    token_unit((int)mc + 8 * wave + i + 1, lane, P, WSP(bf16, WS_YA), asglobal(a->in[6]) + l * 3 * DCONV, WSP(bf16, WS_Y), HLp, CAp, st + 512 * (wave >> 2)); }
                __syncthreads();
            }
            RT1(4);
            SEAM_P(pb + 6);
        }
        if (EN_G4 && IN(pb + 7))
_Pragma("nounroll") for (int rep_ = 0; rep_ < REP_G4; ++rep_) {
            PHASE_ENTRY();
            pg8::StaticOrder S; S.init(M, D, G, bid);
            pg8::Gemm g{WSP(bf16, WS_Y), WSP(bf16, WS_WO + (size_t)l * SZ_WO), M, D, D}; pg8::EpiRes<false> E{WSP(bf16, WS_XB), WSP(unsigned char, WS_XL), WSP(float, WS_SS), rep_ == REP_G4 - 1 ? 1.0f : 0.f, nullptr, nullptr};
            pg8::gemm_phase<pg8::EpiRes<false>, pg8::StaticOrder, PG8_ALIGN, PG8_SP2>(lds + RING_OFF, g, S, E, wave_s);
            SEAM_P(pb + 7);
        }
        if (EN_G5 && IN(pb + 8)) {
            PHASE_ENTRY();
            MY_PANEL(); const int r0 = pmine * 256 + prank * 64 + wave;
            const bf16* XBp = WSP(bf16, WS_XB); const unsigned char* XLp = WSP(unsigned char, WS_XL); unsigned char* Q8p = WSP(unsigned char, WS_Q8); float* RSAp = WSP(float, WS_RSA);
            v4u hA[4], lA[2], hB[4], lB[2];
            quant_xrow_load(hA, lA, XBp + (size_t)r0 * D, XLp + (size_t)r0 * D, lane);
#pragma unroll
            for (int i = 0; i < 8; i += 2) { const int ma = r0 + 8 * i, mb = ma + 8;
                quant_xrow_load(hB, lB, XBp + (size_t)mb * D, XLp + (size_t)mb * D, lane);
                quant_xrow(hA, lA, Q8p + (size_t)ma * D, RSAp + ma, lane);
                if (i + 2 < 8) quant_xrow_load(hA, lA, XBp + (size_t)(mb + 8) * D, XLp + (size_t)(mb + 8) * D, lane);
                quant_xrow(hB, lB, Q8p + (size_t)mb * D, RSAp + mb, lane); }
            SEAM_P(pb + 8);
        }
        if (EN_G5 && IN(pb + 9)) {
            PHASE_ENTRY();
            pg8::StaticOrder S; S.init(M, NFF, G, bid); pg8::Unit u0; u0.pm = 0; u0.pn = 0; S.next(0, u0); load_rsa(lds, u0.pm, WSP(float, WS_RSA), wave_s);
            pg8::Gemm g{WSP(bf16, WS_Q8), WSP(bf16, WS_W1Q + (size_t)(1 * DEPTH + l) * SZ_W1Q), M, NFF, D / 2}; pg8::EpiSwiGLUq E{WSP(unsigned char, WS_HQ), FF, rs_lds, WSP(float, WS_SW) + (1 * DEPTH + l) * NFF, WSP(float, WS_BS)};
            pg8::gemm_phase<pg8::EpiSwiGLUq, pg8::StaticOrder, PG8_ALIGN, PG8_SP2>(lds + RING_OFF, g, S, E, wave_s);
            SEAM_P(pb + 9);
        }
        if (EN_G6 && IN(pb + 10)) {
            PHASE_ENTRY();
            MY_PANEL(); const int r0 = pmine * 256 + prank * 64 + wave;
            unsigned char* HQp = WSP(unsigned char, WS_HQ); const float* BSp = WSP(float, WS_BS); float* SHp = WSP(float, WS_SH);
            v2u wA[NPC], wB[NPC]; float sA[NPC], sB[NPC];
            requant_row_load(wA, sA, HQp + (size_t)r0 * FF, BSp + (size_t)r0 * (FF / 32), lane);
#pragma unroll
            for (int i = 0; i < 8; i += 2) { const int ma = r0 + 8 * i, mb = ma + 8;
                requant_row_load(wB, sB, HQp + (size_t)mb * FF, BSp + (size_t)mb * (FF / 32), lane);
                requant_row_blocks(wA, sA, HQp + (size_t)ma * FF, SHp + ma, lane);
                if (i + 2 < 8) requant_row_load(wA, sA, HQp + (size_t)(mb + 8) * FF, BSp + (size_t)(mb + 8) * (FF / 32), lane);
                requant_row_blocks(wB, sB, HQp + (size_t)mb * FF, SHp + mb, lane); }
            SEAM_P(pb + 10);
        }
        if (EN_G6 && IN(pb + 11))
_Pragma("nounroll") for (int rep_ = 0; rep_ < REP_G6; ++rep_) {
            PHASE_ENTRY();
            pg8::StaticOrder S; S.init(M, D, G, bid); pg8::Unit u0; u0.pm = 0; u0.pn = 0; S.next(0, u0); load_rsa(lds, u0.pm, WSP(float, WS_SH), wave_s);
            pg8::Gemm g{WSP(bf16, WS_HQ), WSP(bf16, WS_W2Q + (size_t)(1 * DEPTH + l) * D * FF), M, D, FF / 2}; pg8::EpiRes<true> E{WSP(bf16, WS_XB), WSP(unsigned char, WS_XL), WSP(float, WS_SS), rep_ == REP_G6 - 1 ? 0.5f : 0.f, rs_lds, WSP(float, WS_SW2) + (1 * DEPTH + l) * D};
            pg8::gemm_phase<pg8::EpiRes<true>, pg8::StaticOrder, PG8_ALIGN, PG8_SP2>(lds + RING_OFF, g, S, E, wave_s);
            SEAM_P(pb + 11);
        }
    }
    if (EN_FN && IN(N_PHASES - 1)) {
        PHASE_ENTRY();
        const float* gfin = asglobal(a->in[20]); float* X = asglobal(a->out); const float* SS = WSP(float, WS_SS);
        MY_PANEL();
        for (int m = pmine * 256 + prank * 64 + wave; m < pmine * 256 + prank * 64 + 64; m += NWAVES) {
            float s = lane < 32 ? SS[(size_t)m * 32 + lane] : 0.f; s = wave_sum(s);
            const float rsn = __builtin_amdgcn_rsqf(s * (1.f / D) + EPS);
            GAS f32x4* xr = (GAS f32x4*)(X + (size_t)m * D) + lane; const GAS f32x4* gr = (const GAS f32x4*)gfin + lane;
            const GAS v2u* h8 = (const GAS v2u*)(WSP(bf16, WS_XB) + (size_t)m * D) + lane; const GAS unsigned* l8 = (const GAS unsigned*)(WSP(unsigned char, WS_XL) + (size_t)m * D) + lane;
#pragma unroll
            for (int jj = 0; jj < 8; ++jj) { const v2u h = h8[64 * jj]; const unsigned lq = RES_LO ? l8[64 * jj] : 0u; const f32x4 gg = gr[64 * jj];
                f32x4 v;
                if (RES_LO == 2) { v[0] = __uint_as_float(__builtin_amdgcn_perm(h.x, lq, 0x0504000cu)); v[1] = __uint_as_float(__builtin_amdgcn_perm(h.x, lq, 0x0706010cu));
                                   v[2] = __uint_as_float(__builtin_amdgcn_perm(h.y, lq, 0x0504020cu)); v[3] = __uint_as_float(__builtin_amdgcn_perm(h.y, lq, 0x0706030cu)); }
                else { v[0] = pg8::res_dec(h.x & 0xffffu, (int)(lq << 24) >> 24); v[1] = pg8::res_dec(h.x >> 16, (int)(lq << 16) >> 24);
                v[2] = pg8::res_dec(h.y & 0xffffu, (int)(lq << 8) >> 24); v[3] = pg8::res_dec(h.y >> 16, (int)lq >> 24); }
                xr[64 * jj] = v * rsn * gg; }
        }
    }
#if DIAG_CLOCK
    if (bid0 == 0 && xb_thread0(wave_s)) { const float mhz = (float)MISC[20] / (float)MISC[18] * 100.f; const unsigned long long w = (unsigned long long)(mhz * 100.f);
        const unsigned long long t0 = __builtin_amdgcn_s_memrealtime(); while (__builtin_amdgcn_s_memrealtime() - t0 < w) __builtin_amdgcn_s_sleep(8); }
#endif
#if DIAG_XCDSKEW
    { const CArgs a = oargs(ap); unsigned* st = (unsigned*)(asglobal(a->ws) + WS_CTL) + 2048;
      __syncthreads(); if (xb_thread0(wave_s)) atomicAdd(st + 64 * (1 + bar.x), MISC[16]);
      xcd_barrier(bar);
      if (bid0 == 0 && xb_thread0(wave_s)) { unsigned mn = 0xffffffffu, mx = 0u;
        for (int j = 0; j < 8; ++j) { const unsigned v = __hip_atomic_load(st + 64 * (1 + j), __ATOMIC_RELAXED, __HIP_MEMORY_SCOPE_AGENT); mn = v < mn ? v : mn; mx = v > mx ? v : mx; }
        const unsigned long long w = (unsigned long long)((float)(DIAG_XCDSKEW == 1 ? mx - mn : (DIAG_XCDSKEW == 2 ? mn : mx)) * (1.f / 32.f) * DIAG_SCALE);
        const unsigned long long t0 = __builtin_amdgcn_s_memrealtime(); while (__builtin_amdgcn_s_memrealtime() - t0 < w) __builtin_amdgcn_s_sleep(8); } }
#endif
#if DIAG_BARTIME || DIAG_REGION
    { const CArgs a = oargs(ap); unsigned* st = (unsigned*)(asglobal(a->ws) + WS_CTL) + 2048;
      __syncthreads(); if (xb_thread0(wave_s)) atomicAdd(st, DIAG_REGION ? MISC[18] : MISC[16]);
      xcd_barrier(bar);
      if (bid0 == 0 && xb_thread0(wave_s)) { const unsigned tot = __hip_atomic_load(st, __ATOMIC_RELAXED, __HIP_MEMORY_SCOPE_AGENT); const unsigned long long w = (unsigned long long)((float)tot * (1.f / 256.f) * DIAG_SCALE);
        const unsigned long long t0 = __builtin_amdgcn_s_memrealtime(); while (__builtin_amdgcn_s_memrealtime() - t0 < w) __builtin_amdgcn_s_sleep(8); } }
#endif
#undef IN
#undef SEAM
#undef PHASE_ENTRY
}

extern "C" void kernel_launch(void* const* d_in, const int* in_sizes, int n_in, void* d_out, int out_size, void* d_ws, size_t ws_size, hipStream_t stream) {
    static int grid = 0;
    if (grid == 0) {
        if (n_in != 21 || in_sizes[0] != M * D || out_size != M * D || ws_size < WS_END) {
            fprintf(stderr, "kernel_launch: built for 21 inputs, x/out of %d floats, >= %zu bytes of workspace; got n_in %d, in0 %d, out %d, ws %zu; nothing launched\n", M * D, (size_t)WS_END, n_in, n_in > 0 ? in_sizes[0] : -1, out_size, ws_size);
            grid = -1; return; }
        int dev = 0, cus = 0, per_cu = 0;
        if (hipGetDevice(&dev) != hipSuccess || hipDeviceGetAttribute(&cus, hipDeviceAttributeMultiprocessorCount, dev) != hipSuccess) { fprintf(stderr, "kernel_launch: device query failed\n"); grid = -1; return; }
        if (hipFuncSetAttribute((const void*)hymba_fwd, hipFuncAttributeMaxDynamicSharedMemorySize, LDS_BYTES) != hipSuccess) { fprintf(stderr, "kernel_launch: hipFuncSetAttribute failed\n"); grid = -1; return; }
        if (hipOccupancyMaxActiveBlocksPerMultiprocessor(&per_cu, (const void*)hymba_fwd, NWAVES * 64, LDS_BYTES) != hipSuccess || per_cu < 1)
            fprintf(stderr, "kernel_launch: note: occupancy query reports %d workgroups per CU\n", per_cu);
        (void)hipGetLastError();
        grid = cus;
        if (grid != 256) fprintf(stderr, "kernel_launch: %d CUs; the row-scale tables assume a 256-workgroup grid\n", grid);
        if (grid != 256) { fprintf(stderr, "kernel_launch: built for a 256-CU device (panel ownership); nothing launched\n"); grid = -1; return; }
        { int seen[64] = {0};
          for (int c = 0; c < grid; ++c) { pg8::Unit u[3]; for (int k = 0; k < 3; ++k) { const int Nk = k == 0 ? D : (k == 1 ? NFF : NMIX); pg8::StaticOrder S; S.init(M, Nk, grid, c); u[k].pm = -1; u[k].pn = -1; S.next(0, u[k]); }
              if (u[0].pm < 0 || u[0].pm >= 64 || u[0].pm != u[1].pm || u[0].pm != u[2].pm || u[0].pn < 0 || u[0].pn >= NOWN || (seen[u[0].pm] >> u[0].pn & 1)) { fprintf(stderr, "kernel_launch: unit order does not give fixed panel owners (workgroup %d)\n", c); grid = -1; return; }
              seen[u[0].pm] |= 1 << u[0].pn; }
          for (int p = 0; p < 64; ++p) if (seen[p] != (1 << NOWN) - 1) { fprintf(stderr, "kernel_launch: panel %d lacks owners\n", p); grid = -1; return; } }
        const int Ns[3] = {NFF, D, NMIX};
        for (int k = 0; k < 3; ++k) for (int c = 0; c < grid; ++c) { pg8::StaticOrder S; S.init(M, Ns[k], grid, c); pg8::Unit u0, u; if (!S.next(0, u0)) continue;
            for (int i = 1; S.next(i, u); ++i) if (u.pm != u0.pm) { fprintf(stderr, "kernel_launch: unit order gives workgroup %d two row panels (N %d)\n", c, Ns[k]); grid = -1; return; } }
    }
    if (grid < 0) return;
    if (hipMemsetAsync((char*)d_ws + WS_CTL, 0, CTL_ZERO_BYTES, stream) != hipSuccess) { fprintf(stderr, "kernel_launch: hipMemsetAsync failed\n"); return; }
    Args a{};
    for (int i = 0; i < 21; ++i) a.in[i] = (const float*)d_in[i];
    a.out = (float*)d_out; a.ws = (unsigned char*)d_ws;
#if MK_SINGLE
    a.ph_lo = 0; a.ph_hi = N_PHASES;
    hipLaunchKernelGGL(hymba_fwd, dim3(grid), dim3(NWAVES * 64), LDS_BYTES, stream, a);
#else
    for (int p = 0; p < N_PHASES; ++p) { a.ph_lo = p; a.ph_hi = p + 1; hipLaunchKernelGGL(hymba_fwd, dim3(grid), dim3(NWAVES * 64), LDS_BYTES, stream, a); }
#endif
    const hipError_t le = hipPeekAtLastError();
    if (le != hipSuccess) fprintf(stderr, "kernel_launch: launch failed: %s\n", hipGetErrorName(le));
}
```

```cpp
#include <hip/hip_runtime.h>
#include <cstdio>
#include <cstdint>
namespace pg8 {
#define PG8_LAS __attribute__((address_space(3)))
typedef unsigned short bf16_t;
typedef short bf16x8 __attribute__((ext_vector_type(8)));
typedef float f32x4 __attribute__((ext_vector_type(4)));
typedef unsigned u32x4 __attribute__((ext_vector_type(4)));
typedef unsigned u32x2 __attribute__((ext_vector_type(2)));
constexpr int BM = 256, BK = 64, HALF = 128, HTB = HALF * BK * 2  , STAGE_BYTES = 8 * HTB, NXCD = 8, WGM = 8;

__host__ __device__ __forceinline__ int lds_byte(int r, int c) { const int st = (r >> 4) * 2 + (c >> 5), rr = r & 15, cc = c & 31, ob = rr * 64 + cc * 2; return st * 1024 + (ob ^ (((ob >> 9) & 1) << 5)); }
__host__ __device__ __forceinline__ void stage_rc(int b, int& R, int& C) { const int st = b / 1024, sb = b % 1024, swz = sb ^ (((sb >> 9) & 1) << 5); R = (st >> 1) * 16 + swz / 64; C = (st & 1) * 32 + (swz % 64) / 2; }
__host__ __device__ __forceinline__ int perm32(int rho) { const int n = rho >> 4, i = rho & 15; return 8 * (i >> 2) + 4 * n + (i & 3); }

struct Unit { int pm, pn; };
struct Gemm { const bf16_t* A; const bf16_t* Bt; int M, N, K; };

struct StaticOrder {
    int nM, nN, nwg, G, c;
    __host__ __device__ __forceinline__ void init(int M, int N, int G_, int c_) { nM = M / BM; nN = N / BM; nwg = nM * nN; G = G_; c = c_; }
    __host__ __device__ __forceinline__ bool next(int i, Unit& u) const {
        const long L = (long)i * G + c; if (L >= nwg) return false;
        int wgid = (int)L; { const int q = nwg / NXCD, r = nwg % NXCD, xcd = wgid % NXCD, off = wgid / NXCD; wgid = (xcd < r ? xcd * (q + 1) : r * (q + 1) + (xcd - r) * q) + off; }
        const int nig = WGM * nN, gid = wgid / nig, fm = gid * WGM, gsz = (nM - fm) < WGM ? (nM - fm) : WGM;
        u.pm = fm + ((wgid % nig) % gsz); u.pn = (wgid % nig) / gsz; return true;
    }
    __device__ __forceinline__ void a_ready(const Unit&) const {}
    __device__ __forceinline__ void done(const Unit&) const {}
};

__device__ __forceinline__ unsigned cvt_pk_bf16(float lo, float hi) { unsigned r; asm volatile("v_cvt_pk_bf16_f32 %0, %1, %2" : "=v"(r) : "v"(lo), "v"(hi)); return r; }
typedef float f32x2 __attribute__((ext_vector_type(2)));
#ifndef HB_NT
#define HB_NT 0
#endif
typedef unsigned u32x2 __attribute__((ext_vector_type(2)));
__device__ __forceinline__ int olane() { int lane; asm volatile("v_mbcnt_lo_u32_b32 %0, -1, 0\n\tv_mbcnt_hi_u32_b32 %0, -1, %0" : "=v"(lane)); return lane; }
__device__ __forceinline__ int otid(int wave_s) { return wave_s * 64 + olane(); }
template <int K> __device__ __forceinline__ float sx(float v) { static_assert(K > 0 && K < 32, "sx"); return __int_as_float(__builtin_amdgcn_ds_swizzle(__float_as_int(v), (K << 10) | 0x1f)); }
__device__ __forceinline__ float add32(float v) { auto rr = __builtin_amdgcn_permlane32_swap(__float_as_uint(v), __float_as_uint(v), false, false); return __uint_as_float(rr[0]) + __uint_as_float(rr[1]); }
__device__ __forceinline__ float max16(float v) { auto rr = __builtin_amdgcn_permlane16_swap(__float_as_uint(v), __float_as_uint(v), false, false); return __builtin_fmaxf(__uint_as_float(rr[0]), __uint_as_float(rr[1])); }
__device__ __forceinline__ float add16(float v) { auto rr = __builtin_amdgcn_permlane16_swap(__float_as_uint(v), __float_as_uint(v), false, false); return __uint_as_float(rr[0]) + __uint_as_float(rr[1]); }
__device__ __forceinline__ float max32(float v) { auto rr = __builtin_amdgcn_permlane32_swap(__float_as_uint(v), __float_as_uint(v), false, false); return __builtin_fmaxf(__uint_as_float(rr[0]), __uint_as_float(rr[1])); }
__device__ __forceinline__ float other32(float v, int hi) { auto rr = __builtin_amdgcn_permlane32_swap(__float_as_uint(v), __float_as_uint(v), false, false); return __uint_as_float(hi ? rr[0] : rr[1]); }
__device__ __forceinline__ float log1p_small(float e) { const float u = 1.f + e, d = u - 1.f; return d == 0.f ? e : __logf(u) * (e * __builtin_amdgcn_rcpf(d)); }
typedef int i32x4 __attribute__((ext_vector_type(4)));
template <bool INT8> __device__ __forceinline__ f32x4 mma16(bf16x8 b, bf16x8 a, f32x4 c) {
    if constexpr (INT8) return __builtin_bit_cast(f32x4, __builtin_amdgcn_mfma_i32_16x16x64_i8(__builtin_bit_cast(i32x4, b), __builtin_bit_cast(i32x4, a), __builtin_bit_cast(i32x4, c), 0, 0, 0));
    else return __builtin_amdgcn_mfma_f32_16x16x32_bf16(b, a, c, 0, 0, 0);
}
struct EpiSwiGLU {
    static constexpr bool PERM = true, AFTER_DRAIN = false, INT8 = false;
    bf16_t* O; int ldc; const PG8_LAS float* rs;
    __device__ __forceinline__ void operator()(const f32x4 (&acc)[2][2][4][2], const Unit& u_in, int wr, int wc, int fr, int fq) const {
        Unit u = u_in; asm volatile("" : "+s"(u.pm), "+s"(u.pn));
        const int row0 = u.pm * BM + wr * 64 + fr, col0 = u.pn * HALF + wc * 32 + 8 * fq;
#pragma unroll
        for (int ai = 0; ai < 2; ++ai)
#pragma unroll
            for (int m = 0; m < 4; ++m) {
                const float s = rs[ai * HALF + wr * 64 + m * 16 + fr];
                float h[8];
#pragma unroll
                for (int n = 0; n < 2; ++n)
#pragma unroll
                    for (int e = 0; e < 4; ++e) { const float g = acc[ai][0][m][n][e] * s, uu = acc[ai][1][m][n][e] * s;
                        h[4 * n + e] = g * __builtin_amdgcn_rcpf(1.f + __expf(-g)) * uu; }
                u32x4 w; w.x = cvt_pk_bf16(h[0], h[1]); w.y = cvt_pk_bf16(h[2], h[3]); w.z = cvt_pk_bf16(h[4], h[5]); w.w = cvt_pk_bf16(h[6], h[7]);
#if HB_NT
                __builtin_nontemporal_store(w, (u32x4*)(O + (size_t)(row0 + ai * HALF + m * 16) * ldc + col0)); }
#else
                *(u32x4*)(O + (size_t)(row0 + ai * HALF + m * 16) * ldc + col0) = w; }
#endif
    }
};
struct EpiSwiGLUq {
    static constexpr bool PERM = true, AFTER_DRAIN = false, INT8 = true;
    unsigned char* Q; int ldc; const PG8_LAS float* rsa; const float* sw; float* BS;
    __device__ __forceinline__ void operator()(const f32x4 (&acc)[2][2][4][2], const Unit& u_in, int wr, int wc, int fr, int fq) const {
        Unit u = u_in; asm volatile("" : "+s"(u.pm), "+s"(u.pn));
        const int row0 = u.pm * BM + wr * 64 + fr, col0 = u.pn * HALF + wc * 32 + 8 * fq, n0 = u.pn * BM + wc * 32 + 8 * fq;
        f32x2 SG[2][2], SU[2][2];
        { const f32x4 sg0 = *(const f32x4*)(sw + n0), sg1 = *(const f32x4*)(sw + n0 + 4), su0 = *(const f32x4*)(sw + n0 + HALF), su1 = *(const f32x4*)(sw + n0 + HALF + 4);
          SG[0][0] = f32x2{sg0[0], sg0[1]}; SG[0][1] = f32x2{sg0[2], sg0[3]}; SG[1][0] = f32x2{sg1[0], sg1[1]}; SG[1][1] = f32x2{sg1[2], sg1[3]};
          SU[0][0] = f32x2{su0[0], su0[1]}; SU[0][1] = f32x2{su0[2], su0[3]}; SU[1][0] = f32x2{su1[0], su1[1]}; SU[1][1] = f32x2{su1[2], su1[3]}; }
        float srow[8];
#pragma unroll
        for (int j = 0; j < 8; ++j) srow[j] = rsa[(j >> 2) * HALF + wr * 64 + (j & 3) * 16 + fr];
#pragma unroll
        for (int ai = 0; ai < 2; ++ai)
#pragma unroll
            for (int m = 0; m < 4; ++m) {
                const float s = srow[ai * 4 + m];
                const float tsc = s * -1.4426950408889634f; const f32x2 ts = {tsc, tsc};
                f32x2 hp[4];
#pragma unroll
                for (int n = 0; n < 2; ++n) { const i32x4 ig = __builtin_bit_cast(i32x4, acc[ai][0][m][n]), iu = __builtin_bit_cast(i32x4, acc[ai][1][m][n]);
#pragma unroll
                    for (int ep = 0; ep < 2; ++ep) {
                        const f32x2 G = f32x2{(float)ig[2 * ep], (float)ig[2 * ep + 1]} * SG[n][ep], U = f32x2{(float)iu[2 * ep], (float)iu[2 * ep + 1]} * SU[n][ep];
                        const f32x2 T = G * ts;
                        const f32x2 Dn = f32x2{__builtin_amdgcn_exp2f(T[0]), __builtin_amdgcn_exp2f(T[1])} + f32x2{1.f, 1.f};
                        const f32x2 R = {__builtin_amdgcn_rcpf(Dn[0]), __builtin_amdgcn_rcpf(Dn[1])};
                        hp[2 * n + ep] = (G * U) * R; } }
                float bm = __builtin_fmaxf(__builtin_fmaxf(__builtin_fabsf(hp[0][0]), __builtin_fabsf(hp[0][1])), __builtin_fmaxf(__builtin_fabsf(hp[1][0]), __builtin_fabsf(hp[1][1])));
                bm = __builtin_fmaxf(bm, __builtin_fmaxf(__builtin_fmaxf(__builtin_fabsf(hp[2][0]), __builtin_fabsf(hp[2][1])), __builtin_fmaxf(__builtin_fabsf(hp[3][0]), __builtin_fabsf(hp[3][1]))));
                bm = max32(max16(bm));
                const float inv = bm > 1e-30f ? 127.f * __builtin_amdgcn_rcpf(bm) : 0.f;
                const f32x2 iv = {inv, inv}, mg = {12582912.f, 12582912.f};
                u32x2 o;
#pragma unroll
                for (int hh = 0; hh < 2; ++hh) {
                    const f32x2 ta = hp[2 * hh] * iv + mg, tb = hp[2 * hh + 1] * iv + mg;
                    o[hh] = __builtin_amdgcn_perm(__builtin_amdgcn_perm(__float_as_uint(tb[1]), __float_as_uint(tb[0]), 0x0c0c0400u), __builtin_amdgcn_perm(__float_as_uint(ta[1]), __float_as_uint(ta[0]), 0x0c0c0400u), 0x05040100u); }
                const size_t row = (size_t)(row0 + ai * HALF + m * 16);
                *(u32x2*)(Q + row * ldc + col0) = o;
                if (fq == 0) BS[row * (ldc >> 5) + (col0 >> 5)] = bm > 1e-30f ? (s * s) * bm * (1.f / 127.f) : 0.f; }
    }
};
__device__ __forceinline__ float res_dec(unsigned hb16, int q) {
    const int E = (int)((hb16 >> 7) & 0xffu) - 15; const float sc = __uint_as_float((unsigned)(E > 0 ? E : 0) << 23);
    return __uint_as_float(hb16 << 16) + (float)q * sc;
}
__device__ __forceinline__ int res_enc(float v, unsigned hb16) {
    const int E = (int)((hb16 >> 7) & 0xffu); const float inv = __uint_as_float((unsigned)(269 - E) << 23);
    const float r = (v - __uint_as_float(hb16 << 16)) * inv; const float c = fminf(fmaxf(__builtin_rintf(r), -127.f), 127.f);
    return E >= 15 ? (int)c : 0;
}
#ifndef RES_LO
#define RES_LO 2
#endif
template <bool Q> struct EpiRes {
    static constexpr bool PERM = true, AFTER_DRAIN = false, INT8 = Q;
    bf16_t* xh; unsigned char* xl; float* ss; float alpha; const PG8_LAS float* rowsc; const float* colsc; bool rd_lo, wr_lo;
    __device__ __forceinline__ void operator()(const f32x4 (&acc)[2][2][4][2], const Unit& u_in, int wr, int wc, int fr, int fq) const {
        Unit u = u_in; asm volatile("" : "+s"(u.pm), "+s"(u.pn));
        const int row0 = u.pm * BM + wr * 64 + fr, col0 = u.pn * BM + wc * 32 + 8 * fq;
        f32x4 cs[2][2];
        if constexpr (Q) {
#pragma unroll
            for (int bj = 0; bj < 2; ++bj) { cs[bj][0] = *(const f32x4*)(colsc + col0 + bj * HALF); cs[bj][1] = *(const f32x4*)(colsc + col0 + bj * HALF + 4); } }
#pragma unroll
        for (int am = 0; am < 4; ++am) { const int ai = am >> 1, mb = (am & 1) * 2;
            u32x4 h[2][2]; u32x2 l[2][2];
#pragma unroll
            for (int mm = 0; mm < 2; ++mm)
#pragma unroll
                for (int bj = 0; bj < 2; ++bj) { const size_t off = (size_t)(row0 + ai * HALF + (mb + mm) * 16) * 2048 + col0 + bj * HALF;
                    h[mm][bj] = *(const u32x4*)(xh + off); if (RES_LO && rd_lo) l[mm][bj] = *(const u32x2*)(xl + off); else l[mm][bj] = (u32x2){0u, 0u}; }
#pragma unroll
            for (int mm = 0; mm < 2; ++mm) { const int m = mb + mm;
                const int row = row0 + ai * HALF + m * 16; float sq = 0.f;
#pragma unroll
                for (int bj = 0; bj < 2; ++bj) { const size_t off = (size_t)row * 2048 + col0 + bj * HALF;
                    float v[8];
#pragma unroll
                    for (int i = 0; i < 8; ++i) { const unsigned hb = (i & 1) ? (h[mm][bj][i >> 1] >> 16) : (h[mm][bj][i >> 1] & 0xffffu);
                        if (RES_LO == 2) v[i] = __uint_as_float(__builtin_amdgcn_perm(h[mm][bj][i >> 1], l[mm][bj][i >> 2], ((5u + 2u * (i & 1)) << 24) | ((4u + 2u * (i & 1)) << 16) | ((unsigned)(i & 3) << 8) | 0x0cu));
                        else if (RES_LO == 1) { const int q = (int)(l[mm][bj][i >> 2] << (24 - 8 * (i & 3))) >> 24; v[i] = res_dec(hb, q); }
                        else v[i] = __uint_as_float(hb << 16); }
                    if constexpr (Q) { const float rsc = rowsc[ai * HALF + wr * 64 + m * 16 + fr] * alpha; const i32x4 i0 = __builtin_bit_cast(i32x4, acc[ai][bj][m][0]), i1 = __builtin_bit_cast(i32x4, acc[ai][bj][m][1]);
#pragma unroll
                        for (int e2 = 0; e2 < 4; ++e2) { v[e2] += (float)i0[e2] * (rsc * cs[bj][0][e2]); v[4 + e2] += (float)i1[e2] * (rsc * cs[bj][1][e2]); } }
                    else {
#pragma unroll
                        for (int e2 = 0; e2 < 4; ++e2) { v[e2] += acc[ai][bj][m][0][e2] * alpha; v[4 + e2] += acc[ai][bj][m][1][e2] * alpha; } }
                    u32x4 nh; u32x2 nl = {0u, 0u};
                    if (RES_LO == 2 && wr_lo) { unsigned uu[8];
#pragma unroll
                        for (int i = 0; i < 8; ++i) uu[i] = __float_as_uint(v[i]) + 0x80u;
#pragma unroll
                        for (int e2 = 0; e2 < 4; ++e2) nh[e2] = __builtin_amdgcn_perm(uu[2 * e2 + 1], uu[2 * e2], 0x07060302u);
#pragma unroll
                        for (int q2 = 0; q2 < 2; ++q2) nl[q2] = __builtin_amdgcn_perm(__builtin_amdgcn_perm(uu[4 * q2 + 3], uu[4 * q2 + 2], 0x0c0c0501u), __builtin_amdgcn_perm(uu[4 * q2 + 1], uu[4 * q2], 0x0c0c0501u), 0x05040100u);
                    } else {
#pragma unroll
                    for (int e2 = 0; e2 < 4; ++e2) nh[e2] = cvt_pk_bf16(v[2 * e2], v[2 * e2 + 1]); }
                    if (RES_LO == 1) {
#pragma unroll
                    for (int i = 0; i < 8; ++i) { const unsigned hb = (i & 1) ? (nh[i >> 1] >> 16) : (nh[i >> 1] & 0xffffu);
                        nl[i >> 2] |= ((unsigned)res_enc(v[i], hb) & 0xffu) << (8 * (i & 3)); } }
                    *(u32x4*)(xh + off) = nh; if (RES_LO && wr_lo) *(u32x2*)(xl + off) = nl;
                    sq += (v[0] * v[0] + v[1] * v[1]) + (v[2] * v[2] + v[3] * v[3]) + (v[4] * v[4] + v[5] * v[5]) + (v[6] * v[6] + v[7] * v[7]); }
                sq = add32(add16(sq));
                if (fq == 0) ss[(size_t)row * 32 + u.pn * 4 + wc] = sq; }
        }
    }
};
template <bool Q> struct EpiMix {
    static constexpr bool PERM = true, AFTER_DRAIN = false, INT8 = Q;
    bf16_t* P; int ldc; const PG8_LAS float* rs; float* F; const float* fb; const float* colsc; float* KN;
    __device__ __forceinline__ f32x4 val(const f32x4& a, float s, const f32x4& c) const {
        if constexpr (Q) { const i32x4 i = __builtin_bit_cast(i32x4, a); return (f32x4){(float)i[0], (float)i[1], (float)i[2], (float)i[3]} * (c * s); }
        else return a * s;
    }
    __device__ __forceinline__ void operator()(const f32x4 (&acc)[2][2][4][2], const Unit& u_in, int wr, int wc, int fr, int fq) const {
        Unit u = u_in; asm volatile("" : "+s"(u.pm), "+s"(u.pn));
        const int row0 = u.pm * BM + wr * 64 + fr, col0 = u.pn * BM + wc * 32 + 8 * fq;
        f32x4 cs[2][2];
#pragma unroll
        for (int bj = 0; bj < 2; ++bj) { cs[bj][0] = Q ? *(const f32x4*)(colsc + col0 + bj * HALF) : (f32x4){1.f, 1.f, 1.f, 1.f}; cs[bj][1] = Q ? *(const f32x4*)(colsc + col0 + bj * HALF + 4) : (f32x4){1.f, 1.f, 1.f, 1.f}; }
        if (u.pn < 22) {
#pragma unroll
            for (int ai = 0; ai < 2; ++ai)
#pragma unroll
                for (int m = 0; m < 4; ++m) { const float s = rs[ai * HALF + wr * 64 + m * 16 + fr]; bf16_t* rowp = P + (size_t)(row0 + ai * HALF + m * 16) * ldc + col0;
#pragma unroll
                    for (int bj = 0; bj < 2; ++bj) { const f32x4 v0 = val(acc[ai][bj][m][0], s, cs[bj][0]), v1 = val(acc[ai][bj][m][1], s, cs[bj][1]);
                        u32x4 w; w.x = cvt_pk_bf16(v0[0], v0[1]); w.y = cvt_pk_bf16(v0[2], v0[3]); w.z = cvt_pk_bf16(v1[0], v1[1]); w.w = cvt_pk_bf16(v1[2], v1[3]);
                        *(u32x4*)(rowp + bj * HALF) = w; } }
            if ((unsigned)(u.pn - 10) < 4u) {
#pragma unroll
                for (int ai = 0; ai < 2; ++ai)
#pragma unroll
                    for (int m = 0; m < 4; ++m) { const float s = rs[ai * HALF + wr * 64 + m * 16 + fr]; const int rw = row0 + ai * HALF + m * 16; float* kp = KN + ((size_t)((rw >> 12) * 8 + 2 * (u.pn - 10)) * 4 + wc) * 4096 + (rw & 4095);
#pragma unroll
                        for (int bj = 0; bj < 2; ++bj) { const f32x4 v0 = val(acc[ai][bj][m][0], s, cs[bj][0]), v1 = val(acc[ai][bj][m][1], s, cs[bj][1]);
                            float sq = ((v0[0] * v0[0] + v0[1] * v0[1]) + (v0[2] * v0[2] + v0[3] * v0[3])) + ((v1[0] * v1[0] + v1[1] * v1[1]) + (v1[2] * v1[2] + v1[3] * v1[3]));
                            sq = add32(add16(sq));
                            if (fq == 0) kp[4 * 4096 * bj] = sq; } }
            }
        } else if (wc == 0 && fq == 0) {
            const f32x4 b0 = *(const f32x4*)fb, b1 = *(const f32x4*)(fb + 4);
#pragma unroll
            for (int ai = 0; ai < 2; ++ai)
#pragma unroll
                for (int m = 0; m < 4; ++m) { const float s = rs[ai * HALF + wr * 64 + m * 16 + fr]; const int rw = row0 + ai * HALF + m * 16; float* fp = F + (size_t)((rw >> 12) * 8) * 4096 + (rw & 4095);
                    const f32x4 z0 = val(acc[ai][0][m][0], s, cs[0][0]) + b0, z1 = val(acc[ai][0][m][1], s, cs[0][1]) + b1; f32x4 l0, l1;
#pragma unroll
                    for (int e = 0; e < 4; ++e) { l0[e] = fminf(z0[e], 0.f) - log1p_small(__expf(-fabsf(z0[e]))); l1[e] = fminf(z1[e], 0.f) - log1p_small(__expf(-fabsf(z1[e]))); }

#pragma unroll
                    for (int e = 0; e < 4; ++e) { fp[e * 4096] = l0[e]; fp[(4 + e) * 4096] = l1[e]; } }
        }
    }
};

template <class Epi, class Sched, bool ALIGN_EPI = false, bool SP2 = false>
__device__ __forceinline__ void gemm_phase(PG8_LAS unsigned char* lds, const Gemm g, const Sched& S, const Epi& E, int wave_s) {
    const int tid = otid(wave_s), wid = __builtin_amdgcn_readfirstlane(tid >> 6), lane = tid & 63, wr = wid >> 2, wc = wid & 3, fr = lane & 15, fq = lane >> 4;
    const int K = g.K, nt = K / BK;
    unsigned voffA[2], voffB[2];
#pragma unroll
    for (int i = 0; i < 2; ++i) { int R, C; stage_rc(tid * 16 + i * 8192, R, C); const int Rb = Epi::PERM ? ((R & ~31) + perm32(R & 31)) : R;
        voffA[i] = (unsigned)(R * K + C) * 2u; voffB[i] = (unsigned)(Rb * K + C) * 2u; }
    const size_t kstep = (size_t)(BK * 2);
    const size_t hstep = (size_t)HALF * K * 2;
    const size_t tstep = 2 * hstep;
    const unsigned ldsw = (unsigned)wid * 1024u;
    const int aoff = lds_byte(wr * 64 + fr, fq * 8), boff = lds_byte(wc * 32 + fr, fq * 8);
#define PG8_SA(b, h) (((b) * 2 + (h)) * HTB)
#define PG8_SB(b, h) ((4 + (b) * 2 + (h)) * HTB)
#define PG8_STAGE(bufoff, gbase, voff) do { _Pragma("unroll") for (int _i = 0; _i < 2; ++_i) \
        __builtin_amdgcn_global_load_lds((const unsigned*)((const char*)(gbase) + (voff)[_i]), (PG8_LAS unsigned*)(lds + (bufoff) + ldsw + _i * 8192), 16, 0, 0); } while (0)
#define PG8_LDA(dst, b, h) do { _Pragma("unroll") for (int m = 0; m < 4; ++m) _Pragma("unroll") for (int k = 0; k < 2; ++k) dst[m][k] = *(const PG8_LAS bf16x8*)(lds + PG8_SA(b, h) + aoff + m * 2048 + k * 1024); } while (0)
#define PG8_LDB(dst, b, h) do { _Pragma("unroll") for (int n = 0; n < 2; ++n) _Pragma("unroll") for (int k = 0; k < 2; ++k) dst[n][k] = *(const PG8_LAS bf16x8*)(lds + PG8_SB(b, h) + boff + n * 2048 + k * 1024); } while (0)
#define PG8_MMA(ai, bj, At, Bt) do { __builtin_amdgcn_s_setprio(1); _Pragma("unroll") for (int m = 0; m < 4; ++m) _Pragma("unroll") for (int n = 0; n < 2; ++n) _Pragma("unroll") for (int k = 0; k < 2; ++k) \
        acc[ai][bj][m][n] = mma16<Epi::INT8>(Bt[n][k], At[m][k], acc[ai][bj][m][n]); __builtin_amdgcn_s_setprio(0); } while (0)
#define PG8_WAIT_V(n) asm volatile("s_waitcnt vmcnt(" #n ")" ::: "memory")
#define PG8_WAIT_L(n) asm volatile("s_waitcnt lgkmcnt(" #n ")" ::: "memory")
#define PG8_BAR __builtin_amdgcn_s_barrier()
#define PG8_SCHED __builtin_amdgcn_sched_barrier(0)
    Unit cur, nxt; int ui = 0;
    if (!S.next(0, cur)) return;
    f32x4 acc[2][2][4][2];
#pragma unroll
    for (int a = 0; a < 2; ++a)
#pragma unroll
        for (int b = 0; b < 2; ++b)
#pragma unroll
            for (int m = 0; m < 4; ++m)
#pragma unroll
                for (int n = 0; n < 2; ++n) acc[a][b][m][n] = (f32x4){0.f, 0.f, 0.f, 0.f};
    bf16x8 At[4][2], B0[2][2], B1[2][2];
    const char* cA = (const char*)g.A + (size_t)cur.pm * tstep; const char* cB = (const char*)g.Bt + (size_t)cur.pn * tstep;
    S.a_ready(cur);
    if constexpr (SP2) {
        PG8_STAGE(PG8_SB(0, 0), cB, voffB); PG8_STAGE(PG8_SB(0, 1), cB + hstep, voffB); PG8_STAGE(PG8_SA(0, 0), cA, voffA); PG8_STAGE(PG8_SA(0, 1), cA + hstep, voffA);
        if (wr == 1) PG8_BAR;
        PG8_WAIT_V(2); PG8_BAR;
        PG8_STAGE(PG8_SB(1, 0), cB + kstep, voffB); PG8_STAGE(PG8_SA(1, 0), cA + kstep, voffA); PG8_STAGE(PG8_SB(1, 1), cB + hstep + kstep, voffB);
        PG8_WAIT_V(6); PG8_BAR;
    } else {
        PG8_STAGE(PG8_SB(0, 0), cB, voffB); PG8_STAGE(PG8_SA(0, 0), cA, voffA); PG8_STAGE(PG8_SB(0, 1), cB + hstep, voffB); PG8_STAGE(PG8_SA(0, 1), cA + hstep, voffA);
        if (wr == 1) PG8_BAR;
        PG8_WAIT_V(4); PG8_BAR;
        PG8_STAGE(PG8_SB(1, 0), cB + kstep, voffB); PG8_STAGE(PG8_SA(1, 0), cA + kstep, voffA); PG8_STAGE(PG8_SB(1, 1), cB + hstep + kstep, voffB);
        PG8_WAIT_V(6); PG8_BAR;
    }
    for (;;) {
        const bool has_next = S.next(ui + 1, nxt);
        const char* nA = has_next ? (const char*)g.A + (size_t)nxt.pm * tstep : cA; const char* nB = has_next ? (const char*)g.Bt + (size_t)nxt.pn * tstep : cB;
        for (int t = 0; t < nt; t += 2) {
            const bool last = (t == nt - 2);
            const char* a1 = cA + (size_t)(t + 1) * kstep;
            const char* a2 = last ? nA : cA + (size_t)(t + 2) * kstep; const char* b2 = last ? nB : cB + (size_t)(t + 2) * kstep;
            const char* a3 = a2 + kstep; const char* b3 = b2 + kstep;
            if (last && has_next) S.a_ready(nxt);
            if constexpr (SP2) {
            PG8_LDB(B0, 0, 0); PG8_LDB(B1, 0, 1); PG8_SCHED; PG8_LDA(At, 0, 0); PG8_STAGE(PG8_SA(1, 1), a1 + hstep, voffA);
            PG8_WAIT_V(8); PG8_WAIT_L(0); PG8_BAR; PG8_MMA(0, 0, At, B0); PG8_MMA(0, 1, At, B1); PG8_BAR; PG8_SCHED;
            PG8_LDA(At, 0, 1); PG8_STAGE(PG8_SB(0, 0), b2, voffB); PG8_STAGE(PG8_SB(0, 1), b2 + hstep, voffB); PG8_STAGE(PG8_SA(0, 0), a2, voffA);
            PG8_WAIT_V(8); PG8_WAIT_L(0); PG8_BAR; PG8_MMA(1, 0, At, B0); PG8_MMA(1, 1, At, B1); PG8_BAR; PG8_SCHED;
            PG8_LDB(B0, 1, 0); PG8_LDB(B1, 1, 1); PG8_SCHED; PG8_LDA(At, 1, 0); PG8_STAGE(PG8_SA(0, 1), a2 + hstep, voffA);
            PG8_WAIT_V(8); PG8_WAIT_L(0); PG8_BAR; PG8_MMA(0, 0, At, B0); PG8_MMA(0, 1, At, B1); PG8_BAR; PG8_SCHED;
            PG8_LDA(At, 1, 1); PG8_STAGE(PG8_SB(1, 0), b3, voffB); PG8_STAGE(PG8_SB(1, 1), b3 + hstep, voffB); PG8_STAGE(PG8_SA(1, 0), a3, voffA);
            PG8_WAIT_V(8); PG8_WAIT_L(0); PG8_BAR; PG8_MMA(1, 0, At, B0); PG8_MMA(1, 1, At, B1); PG8_BAR; PG8_SCHED;
            } else {
            PG8_LDB(B0, 0, 0); PG8_SCHED; PG8_LDA(At, 0, 0); PG8_STAGE(PG8_SA(1, 1), a1 + hstep, voffA);
            PG8_WAIT_L(8); PG8_BAR; PG8_WAIT_L(0); PG8_MMA(0, 0, At, B0); PG8_BAR; PG8_SCHED;
            PG8_LDB(B1, 0, 1); PG8_STAGE(PG8_SB(0, 0), b2, voffB);
            PG8_BAR; PG8_WAIT_L(0); PG8_MMA(0, 1, At, B1); PG8_BAR;
            PG8_LDA(At, 0, 1); PG8_STAGE(PG8_SA(0, 0), a2, voffA);
            PG8_BAR; PG8_WAIT_L(0); PG8_MMA(1, 0, At, B0); PG8_BAR; PG8_SCHED;
            PG8_STAGE(PG8_SB(0, 1), b2 + hstep, voffB);
            PG8_WAIT_V(6); PG8_BAR; PG8_MMA(1, 1, At, B1); PG8_BAR;
            PG8_LDB(B0, 1, 0); PG8_SCHED; PG8_LDA(At, 1, 0); PG8_STAGE(PG8_SA(0, 1), a2 + hstep, voffA);
            PG8_WAIT_L(8); PG8_BAR; PG8_WAIT_L(0); PG8_MMA(0, 0, At, B0); PG8_BAR; PG8_SCHED;
            PG8_LDB(B1, 1, 1); PG8_STAGE(PG8_SB(1, 0), b3, voffB);
            PG8_BAR; PG8_WAIT_L(0); PG8_MMA(0, 1, At, B1); PG8_BAR;
            PG8_LDA(At, 1, 1); PG8_STAGE(PG8_SA(1, 0), a3, voffA);
            PG8_BAR; PG8_WAIT_L(0); PG8_MMA(1, 0, At, B0); PG8_BAR; PG8_SCHED;
            PG8_STAGE(PG8_SB(1, 1), b3 + hstep, voffB);
            PG8_WAIT_V(6); PG8_BAR; PG8_MMA(1, 1, At, B1); PG8_BAR;
            }
        }
        if constexpr (ALIGN_EPI) { if (wr == 0) PG8_BAR; }
        if constexpr (!Epi::AFTER_DRAIN) { E(acc, cur, wr, wc, fr, fq); S.done(cur); }
        if (!has_next) break;
#pragma unroll
        for (int a = 0; a < 2; ++a)
#pragma unroll
            for (int b = 0; b < 2; ++b)
#pragma unroll
                for (int m = 0; m < 4; ++m)
#pragma unroll
                    for (int n = 0; n < 2; ++n) acc[a][b][m][n] = (f32x4){0.f, 0.f, 0.f, 0.f};
        cur = nxt; cA = nA; cB = nB; ++ui;
        if constexpr (ALIGN_EPI) { if (wr == 1) PG8_BAR; }
    }
    PG8_WAIT_V(0);
    if constexpr (!ALIGN_EPI) { if (wr == 0) PG8_BAR; }
    PG8_BAR;
    if constexpr (Epi::AFTER_DRAIN) { E.fused(acc, cur, wr, wc, fr, fq, lds, wid, lane); S.done(cur); }
#undef PG8_SA
#undef PG8_SB
#undef PG8_STAGE
#undef PG8_LDA
#undef PG8_LDB
#undef PG8_MMA
#undef PG8_WAIT_V
#undef PG8_WAIT_L
#undef PG8_BAR
#undef PG8_SCHED
}
}
#ifndef ATT_QKT_SPLIT
#define ATT_QKT_SPLIT 4
#endif
#ifndef ATT_PP
#define ATT_PP 1
#endif
#ifndef ATT_PIPE
#define ATT_PIPE 0
#endif
#ifndef ATT_SEAM
#define ATT_SEAM 0
#endif
#ifndef ATT_NOTAB
#define ATT_NOTAB 0
#endif
#ifndef ATT_NOSQ
#define ATT_NOSQ 0
#endif
namespace att {
typedef unsigned short bf16;
typedef short bf16x8 __attribute__((ext_vector_type(8)));
typedef short s16x4 __attribute__((ext_vector_type(4)));
typedef float f32x16 __attribute__((ext_vector_type(16)));
typedef float f32x4 __attribute__((ext_vector_type(4)));
typedef unsigned u32x4 __attribute__((ext_vector_type(4)));
constexpr int D = 128, NW = 8, QBLK = 32, KVBLK = 64, QB = NW * QBLK;
constexpr int PITCH = 5632, OPITCH = 1024, SEQ = 4096;
constexpr int SHM_V = KVBLK * D * 2, SHM_K = KVBLK * D * 2;
constexpr int OFF_WS = 2 * SHM_V + 2 * SHM_K, OFF_TAB = OFF_WS + NW * 64 * 4, OFF_WT = OFF_TAB + SEQ * 4, OFF_OST = OFF_WT + 64, LDS_BYTES = OFF_OST + NW * 4096;
#ifndef ATT_THR
#define ATT_THR 8.f
#endif
constexpr float SCALE = 0.08838834764831845f, THR = ATT_THR;
constexpr unsigned WBIG = 0x40000000u;

#define KSWZ(row, colB) ((row) * 256 + ((colB) ^ (((row) & 7) << 4)))
#define SBAR() __builtin_amdgcn_sched_barrier(0)
__device__ __forceinline__ int v_st(int k, int c) { const int kk = (k & ~0xC) | ((k & 4) << 1) | ((k & 8) >> 1); return ((kk >> 3) * 4 + (c >> 5)) * 512 + ((kk & 7) * 32 + (c & 31)) * 2; }
__device__ __forceinline__ int v_rd_base(int lane) { return ((lane & 3) << 3) | (((lane >> 2) & 3) << 6) | (((lane >> 4) & 1) << 5) | (((lane >> 5) & 1) << 8); }
constexpr int v_rd_off(int d0, int ks, int half) { return d0 * 512 + ks * 4096 + half * 2048; }
__device__ __forceinline__ int crow(int r, int hi) { return (r & 3) + 8 * (r >> 2) + 4 * hi; }
__device__ __forceinline__ unsigned cvtpk(float lo, float hi) { unsigned r; asm volatile("v_cvt_pk_bf16_f32 %0, %1, %2" : "=v"(r) : "v"(lo), "v"(hi)); return r; }
__device__ __forceinline__ bf16x8 load8(const bf16* p) { return *reinterpret_cast<const bf16x8*>(p); }
__device__ __forceinline__ void mask_tile(f32x16& p0, f32x16& p1, int dq) {
    const float NEG = -__builtin_inff();
#pragma unroll
    for (int r = 0; r < 16; ++r) {
        const int c = (r & 3) + 8 * (r >> 2);
        if ((unsigned)(dq - c) >= WBIG) p0[r] = NEG;
        if ((unsigned)(dq - c - 32) >= WBIG) p1[r] = NEG;
    }
}
#ifndef ATT_VSKIP
#define ATT_VSKIP 20.f
#endif
template <bool VS = true> __device__ __forceinline__ void partialSM(f32x16& p0, f32x16& p1, float& m_reg, float& mn, float& alpha, bool& skip) {
    float pmax = p0[0];
#pragma unroll
    for (int r = 1; r < 16; ++r) pmax = fmaxf(pmax, p0[r]);
#pragma unroll
    for (int r = 0; r < 16; ++r) pmax = fmaxf(pmax, p1[r]);
    { auto rr = __builtin_amdgcn_permlane32_swap(__float_as_uint(pmax), __float_as_uint(pmax), false, false);
      pmax = fmaxf(__uint_as_float(rr[0]), __uint_as_float(rr[1])); }
    constexpr float C2 = 1.4426950408889634f * SCALE;
    skip = VS && __all((pmax - m_reg) * SCALE <= -ATT_VSKIP) != 0;
    if (skip) { mn = m_reg; alpha = 1.f; return; }
    if (__builtin_expect(__all((pmax - m_reg) * SCALE <= THR), 1)) { mn = m_reg; alpha = 1.f; }
    else { mn = fmaxf(m_reg, pmax); alpha = __builtin_amdgcn_exp2f((m_reg - mn) * C2); m_reg = mn; }
    const float mnL = -mn * C2;
#pragma unroll
    for (int r = 0; r < 16; ++r) p0[r] = fmaf(p0[r], C2, mnL);
#pragma unroll
    for (int r = 0; r < 16; ++r) p1[r] = fmaf(p1[r], C2, mnL);
#pragma unroll
    for (int r = 0; r < 16; ++r) p0[r] = __builtin_amdgcn_exp2f(p0[r]);
}
__device__ __forceinline__ void partialSM(f32x16& p0, f32x16& p1, float& m_reg, float& mn, float& alpha) { bool sk_; partialSM<false>(p0, p1, m_reg, mn, alpha, sk_); }
__device__ __forceinline__ void finishSM(f32x16& p0, f32x16& p1, float alpha, float& l_reg, bf16x8& pa0, bf16x8& pa1, bf16x8& pa2, bf16x8& pa3) {
#pragma unroll
    for (int r = 0; r < 16; ++r) p1[r] = __builtin_amdgcn_exp2f(p1[r]);
    float ps = 0;
#pragma unroll
    for (int r = 0; r < 16; ++r) ps += p0[r];
#pragma unroll
    for (int r = 0; r < 16; ++r) ps += p1[r];
    { auto rr = __builtin_amdgcn_permlane32_swap(__float_as_uint(ps), __float_as_uint(ps), false, false);
      ps = __uint_as_float(rr[0]) + __uint_as_float(rr[1]); }
    l_reg = l_reg * alpha + ps;
#define PK4(P, B_, OUT) do { unsigned a0 = cvtpk(P[B_+0], P[B_+1]), a1 = cvtpk(P[B_+2], P[B_+3]);                          \
        unsigned b0 = cvtpk(P[B_+4], P[B_+5]), b1 = cvtpk(P[B_+6], P[B_+7]);                                             \
        auto r0 = __builtin_amdgcn_permlane32_swap(a0, b0, false, false); auto r1 = __builtin_amdgcn_permlane32_swap(a1, b1, false, false); \
        u32x4 w = {r0[0], r1[0], r0[1], r1[1]}; OUT = *reinterpret_cast<bf16x8*>(&w); } while (0)
    PK4(p0, 0, pa0); PK4(p0, 8, pa1); PK4(p1, 0, pa2); PK4(p1, 8, pa3);
#undef PK4
}
template <int KB>
__device__ __forceinline__ void qkt(f32x16& p0, f32x16& p1, const int (&ka)[4], const bf16x8* qr, const float* bt) {
#pragma unroll
    for (int g = 0; g < 4; ++g) { const f32x4 t0 = *reinterpret_cast<const f32x4*>(bt + 8 * g), t1 = *reinterpret_cast<const f32x4*>(bt + 32 + 8 * g);
#pragma unroll
        for (int e = 0; e < 4; ++e) { p0[4 * g + e] = t0[e]; p1[4 * g + e] = t1[e]; } }
#define KRD(dst, d0, half) asm volatile("ds_read_b128 %0, %1 offset:%2" : "=v"(dst) : "v"(ka[(d0) & 3]), "i"(KB * SHM_K + ((d0) >> 2) * 128 + (half) * 32 * 256) : "memory")
#define KW(n) do { asm volatile("s_waitcnt lgkmcnt(" #n ")" ::: "memory"); SBAR(); } while (0)
#define KMM(S, d0) do { p0 = __builtin_amdgcn_mfma_f32_32x32x16_bf16(S##a, qr[d0], p0, 0, 0, 0); p1 = __builtin_amdgcn_mfma_f32_32x32x16_bf16(S##b, qr[d0], p1, 0, 0, 0); SBAR(); } while (0)
    bf16x8 Xa, Xb, Ya, Yb, Za, Zb;
    SBAR();
    KRD(Xa, 0, 0); KRD(Xb, 0, 1); KRD(Ya, 1, 0); KRD(Yb, 1, 1);
    KRD(Za, 2, 0); KRD(Zb, 2, 1); KW(4); KMM(X, 0);
    KRD(Xa, 3, 0); KRD(Xb, 3, 1); KW(4); KMM(Y, 1);
    KRD(Ya, 4, 0); KRD(Yb, 4, 1); KW(4); KMM(Z, 2);
    KRD(Za, 5, 0); KRD(Zb, 5, 1); KW(4); KMM(X, 3);
    KRD(Xa, 6, 0); KRD(Xb, 6, 1); KW(4); KMM(Y, 4);
    KRD(Ya, 7, 0); KRD(Yb, 7, 1); KW(4); KMM(Z, 5);
    KW(2); KMM(X, 6);
    KW(0); KMM(Y, 7);
#undef KRD
#undef KW
#undef KMM
}
template <int VB>
__device__ __forceinline__ void pv_tile(f32x16* o, int vb0, bf16x8 pa0, bf16x8 pa1, bf16x8 pa2, bf16x8 pa3) {
#define TRRD(dst, off) asm volatile("ds_read_b64_tr_b16 %0, %1 offset:%2" : "=&v"(dst) : "v"(vb0), "i"(off) : "memory")
#define PV_LD(S, d0) do { constexpr int b_ = VB * SHM_V + v_rd_off(d0, 0, 0); \
        TRRD(S##l0, b_); TRRD(S##h0, b_ + 2048); TRRD(S##l1, b_ + 4096); TRRD(S##h1, b_ + 6144); TRRD(S##l2, b_ + 8192); TRRD(S##h2, b_ + 10240); TRRD(S##l3, b_ + 12288); TRRD(S##h3, b_ + 14336); } while (0)
#define PV_MM(S, d0) do { \
        o[d0] = __builtin_amdgcn_mfma_f32_32x32x16_bf16(pa0, (bf16x8){S##l0[0], S##l0[1], S##l0[2], S##l0[3], S##h0[0], S##h0[1], S##h0[2], S##h0[3]}, o[d0], 0, 0, 0);   \
        o[d0] = __builtin_amdgcn_mfma_f32_32x32x16_bf16(pa1, (bf16x8){S##l1[0], S##l1[1], S##l1[2], S##l1[3], S##h1[0], S##h1[1], S##h1[2], S##h1[3]}, o[d0], 0, 0, 0);   \
        o[d0] = __builtin_amdgcn_mfma_f32_32x32x16_bf16(pa2, (bf16x8){S##l2[0], S##l2[1], S##l2[2], S##l2[3], S##h2[0], S##h2[1], S##h2[2], S##h2[3]}, o[d0], 0, 0, 0);   \
        o[d0] = __builtin_amdgcn_mfma_f32_32x32x16_bf16(pa3, (bf16x8){S##l3[0], S##l3[1], S##l3[2], S##l3[3], S##h3[0], S##h3[1], S##h3[2], S##h3[3]}, o[d0], 0, 0, 0); } while (0)
#define PV_W(n) do { asm volatile("s_waitcnt lgkmcnt(" #n ")" ::: "memory"); SBAR(); } while (0)
    s16x4 Al0, Al1, Al2, Al3, Ah0, Ah1, Ah2, Ah3, Bl0, Bl1, Bl2, Bl3, Bh0, Bh1, Bh2, Bh3;
    PV_LD(A, 0); PV_LD(B, 1); PV_W(8); PV_MM(A, 0); SBAR();
    PV_LD(A, 2); PV_W(8); PV_MM(B, 1); SBAR();
    PV_LD(B, 3); PV_W(8); PV_MM(A, 2); SBAR();
    PV_W(0); PV_MM(B, 3);
#undef PV_LD
#undef PV_MM
#undef PV_W
#undef TRRD
}
struct BlockRef { const bf16* Q; const bf16* K; const bf16* V; bf16* O; int P0; };
#define VMW() asm volatile("s_waitcnt vmcnt(0)" ::: "memory")
__device__ __forceinline__ void block(const BlockRef& cur, char* lds, int wave_s) {
    const int tid = pg8::otid(wave_s), wid = __builtin_amdgcn_readfirstlane(tid >> 6), lane = tid & 63, r32 = lane & 31, hi = lane >> 5;
    const int NT = cur.P0 / KVBLK + QB / KVBLK;
    const int qlo = cur.P0 + wid * QBLK, qm = qlo + r32 - 4 * hi;
    char* V_lds = lds; char* K_lds = lds + 2 * SHM_V;
    float* ws = (float*)(lds + OFF_WS) + wid * 64; float* li_l = ws, * al_l = ws + 32;
    const float* tab = (const float*)(lds + OFF_TAB) + 4 * hi;
    float m_reg = -1e30f, l_reg = 0; f32x16 o[4] = {};
    const int sr = tid >> 4, sc = (tid & 15) * 8, vst0 = v_st(sr, sc), vst1 = v_st(32 + sr, sc), kws = KSWZ(sr, sc * 2);
    const int vb0 = (int)(uintptr_t)V_lds + v_rd_base(lane);
    int ka[4];
#pragma unroll
    for (int dd = 0; dd < 4; ++dd) ka[dd] = (int)(uintptr_t)K_lds + KSWZ(r32, (dd * 16 + hi * 8) * 2);
    const unsigned toff = (unsigned)sr * PITCH + sc;
    const bf16* Kh = cur.K; const bf16* Vh = cur.V;
    bf16x8 qr[8], st_v0, st_v1, st_k0, st_k1;
    { const bf16* qp = cur.Q + (unsigned)(wid * QBLK + r32) * PITCH + hi * 8;
#pragma unroll
      for (int d0 = 0; d0 < 8; ++d0) qr[d0] = load8(qp + d0 * 16); }
#define SLOAD_H(t) do { const bf16* kp_ = Kh + (size_t)(t) * (KVBLK * PITCH); const bf16* vp_ = Vh + (size_t)(t) * (KVBLK * PITCH); \
        st_v0 = load8(vp_ + toff); st_v1 = load8(vp_ + 32 * PITCH + toff); st_k0 = load8(kp_ + toff); st_k1 = load8(kp_ + 32 * PITCH + toff); } while (0)
#define SWRITE_H(bf) do { *(bf16x8*)(V_lds + (bf) * SHM_V + vst0) = st_v0; *(bf16x8*)(V_lds + (bf) * SHM_V + vst1) = st_v1; \
        *(bf16x8*)(K_lds + (bf) * SHM_K + kws) = st_k0; *(bf16x8*)(K_lds + (bf) * SHM_K + kws + 32 * 256) = st_k1; } while (0)
#define RESC(a) do { if (__any((a) < 1.f)) { if (hi == 0) al_l[r32] = (a); asm volatile("s_waitcnt lgkmcnt(0)" ::: "memory");              \
                     _Pragma("unroll") for (int d_ = 0; d_ < 4; ++d_) _Pragma("unroll") for (int r = 0; r < 16; ++r) o[d_][r] *= al_l[crow(r, hi)]; } } while (0)
#define STEP(t, BF) do { f32x16 p0, p1; float mn, al; bf16x8 pa0, pa1, pa2, pa3; const int kb_ = (t) * KVBLK;                     \
        if ((t) + 1 < NT) SLOAD_H((t) + 1);                                                                                     \
        SBAR(); qkt<BF>(p0, p1, ka, qr, tab + kb_);                                                                 \
        if (kb_ + KVBLK - 1 > qlo) mask_tile(p0, p1, qm - kb_);                                                                 \
        partialSM(p0, p1, m_reg, mn, al); RESC(al); finishSM(p0, p1, al, l_reg, pa0, pa1, pa2, pa3); SBAR();                    \
        pv_tile<BF>(o, vb0, pa0, pa1, pa2, pa3); SBAR();                                                                        \
        if ((t) + 1 < NT) { VMW(); SWRITE_H(1 - (BF)); }                                                                        \
        __syncthreads(); } while (0)
    SLOAD_H(0); VMW(); SWRITE_H(0);
    __syncthreads();
    for (int t = 0; t < NT; t += 2) { STEP(t, 0); STEP(t + 1, 1); }
    if (hi == 0) li_l[r32] = l_reg; asm volatile("s_waitcnt lgkmcnt(0)" ::: "memory");
    bf16* Ow = cur.O + (size_t)(wid * QBLK) * OPITCH;
#pragma unroll
    for (int r = 0; r < 16; ++r) { const int orow = crow(r, hi); const float rl = __builtin_amdgcn_rcpf(li_l[orow]);
#pragma unroll
        for (int d0 = 0; d0 < 4; ++d0) { const float v = o[d0][r] * rl;
            const float vn = pg8::sx<1>(v);
            if ((r32 & 1) == 0) *(unsigned*)(Ow + (size_t)orow * OPITCH + d0 * 32 + r32) = cvtpk(v, vn); } }
    __syncthreads();
#undef SLOAD_H
#undef SWRITE_H
#undef RESC
#undef STEP
}
#undef VMW
#if ATT_PIPE
__device__ __forceinline__ void block_pipe(const BlockRef& cur, char* lds, int wave_s) {
    const int tid = pg8::otid(wave_s), wid = __builtin_amdgcn_readfirstlane(tid >> 6), lane = tid & 63, r32 = lane & 31, hi = lane >> 5;
    const int NT = cur.P0 / KVBLK + QB / KVBLK;
    const int qlo = cur.P0 + wid * QBLK, qm = qlo + r32 - 4 * hi;
    char* V_lds = lds; char* K_lds = lds + 2 * SHM_V;
    float* ws = (float*)(lds + OFF_WS) + wid * 64; float* li_l = ws, * al_l = ws + 32;
    const float* tab = (const float*)(lds + OFF_TAB) + 4 * hi;
    float m_reg = -1e30f, l_reg = 0; f32x16 o[4] = {};
    const int sr = tid >> 4, sc = (tid & 15) * 8, vst0 = v_st(sr, sc), vst1 = v_st(32 + sr, sc), kws = KSWZ(sr, sc * 2);
    const int vb0 = (int)(uintptr_t)V_lds + v_rd_base(lane);
    int ka[4];
#pragma unroll
    for (int dd = 0; dd < 4; ++dd) ka[dd] = (int)(uintptr_t)K_lds + KSWZ(r32, (dd * 16 + hi * 8) * 2);
    const unsigned toff = (unsigned)sr * PITCH + sc;
    const bf16* Kh = cur.K; const bf16* Vh = cur.V;
    bf16x8 qr[8], st_v0, st_v1, st_k0, st_k1;
    { const bf16* qp = cur.Q + (unsigned)(wid * QBLK + r32) * PITCH + hi * 8;
#pragma unroll
      for (int d0 = 0; d0 < 8; ++d0) qr[d0] = load8(qp + d0 * 16); }
#define VMW() asm volatile("s_waitcnt vmcnt(0)" ::: "memory")
#define SLOAD_H(t) do { const bf16* kp_ = Kh + (size_t)(t) * (KVBLK * PITCH); const bf16* vp_ = Vh + (size_t)(t) * (KVBLK * PITCH); \
        st_v0 = load8(vp_ + toff); st_v1 = load8(vp_ + 32 * PITCH + toff); st_k0 = load8(kp_ + toff); st_k1 = load8(kp_ + 32 * PITCH + toff); } while (0)
#define SWRITE_H(bf) do { *(bf16x8*)(V_lds + (bf) * SHM_V + vst0) = st_v0; *(bf16x8*)(V_lds + (bf) * SHM_V + vst1) = st_v1; \
        *(bf16x8*)(K_lds + (bf) * SHM_K + kws) = st_k0; *(bf16x8*)(K_lds + (bf) * SHM_K + kws + 32 * 256) = st_k1; } while (0)
#define RESC(a) do { if (__any((a) < 1.f)) { if (hi == 0) al_l[r32] = (a); asm volatile("s_waitcnt lgkmcnt(0)" ::: "memory");              \
                     _Pragma("unroll") for (int d_ = 0; d_ < 4; ++d_) _Pragma("unroll") for (int r = 0; r < 16; ++r) o[d_][r] *= al_l[crow(r, hi)]; } } while (0)
#define KBASE(t) ((t) * KVBLK)
#define MASKT(P0_, P1_, t) do { const int kb_ = KBASE(t); if (kb_ + KVBLK - 1 > qlo) mask_tile(P0_, P1_, qm - kb_); } while (0)
    f32x16 pA0, pA1, pB0, pB1; float mnA, mnB, alA, alB; bf16x8 pa0, pa1, pa2, pa3;
    SLOAD_H(0); VMW(); SWRITE_H(0);
    __syncthreads();
    SLOAD_H(1);
    SBAR(); qkt<0>(pA0, pA1, ka, qr, tab + KBASE(0));
    MASKT(pA0, pA1, 0); partialSM(pA0, pA1, m_reg, mnA, alA);
    VMW(); SWRITE_H(1);
    __syncthreads();
#define HALF_STEP(PX0, PX1, mnX, alX, PY0, PY1, alY, t, KB, VB, SB) do {                                                      \
        SBAR(); qkt<KB>(PX0, PX1, ka, qr, tab + KBASE(t));                                               \
        finishSM(PY0, PY1, alY, l_reg, pa0, pa1, pa2, pa3); SBAR();                                                           \
        if ((t) + 1 < NT) { SLOAD_H((t) + 1); SBAR(); }                                                              \
        pv_tile<VB>(o, vb0, pa0, pa1, pa2, pa3); MASKT(PX0, PX1, (t)); partialSM(PX0, PX1, m_reg, mnX, alX);                  \
        __syncthreads();                                                                                                      \
        if ((t) + 1 < NT) { VMW(); SWRITE_H(SB); }                                                                          \
        RESC(alX); __syncthreads(); } while (0)
    for (int t = 1; t + 1 < NT; t += 2) {
        HALF_STEP(pB0, pB1, mnB, alB, pA0, pA1, alA, t, 1, 0, 0);
        HALF_STEP(pA0, pA1, mnA, alA, pB0, pB1, alB, t + 1, 0, 1, 1);
    }
    SBAR(); qkt<1>(pB0, pB1, ka, qr, tab + KBASE(NT - 1)); SBAR();
    finishSM(pA0, pA1, alA, l_reg, pa0, pa1, pa2, pa3); SBAR();
    pv_tile<0>(o, vb0, pa0, pa1, pa2, pa3);
    MASKT(pB0, pB1, NT - 1); partialSM(pB0, pB1, m_reg, mnB, alB); RESC(alB);
    finishSM(pB0, pB1, alB, l_reg, pa0, pa1, pa2, pa3); SBAR(); pv_tile<1>(o, vb0, pa0, pa1, pa2, pa3);
    if (hi == 0) li_l[r32] = l_reg; asm volatile("s_waitcnt lgkmcnt(0)" ::: "memory");
    bf16* Ow = cur.O + (size_t)(wid * QBLK) * OPITCH;
#pragma unroll
    for (int r = 0; r < 16; ++r) { const int orow = crow(r, hi); const float rl = __builtin_amdgcn_rcpf(li_l[orow]);
#pragma unroll
        for (int d0 = 0; d0 < 4; ++d0) { const float v = o[d0][r] * rl;
            const float vn = pg8::sx<1>(v);
            if ((r32 & 1) == 0) *(unsigned*)(Ow + (size_t)orow * OPITCH + d0 * 32 + r32) = cvtpk(v, vn); } }
    __syncthreads();
#undef VMW
#undef SLOAD_H
#undef SWRITE_H
#undef RESC
#undef KBASE
#undef MASKT
#undef HALF_STEP
}
#endif
#if ATT_PP
#ifndef ATT_MARGIN
#define ATT_MARGIN 16.f
#endif
__device__ __forceinline__ void block_pp(const BlockRef& cur, char* lds, int wave_s, float kmax2, unsigned* qctr, volatile __attribute__((address_space(3))) unsigned* slot) {
    const int tid = pg8::otid(wave_s), wid = __builtin_amdgcn_readfirstlane(tid >> 6), lane = tid & 63, r32 = lane & 31, hi = lane >> 5;
    const int grp = wid >> 2;
    const int NT = cur.P0 / KVBLK + QB / KVBLK;
    const int qlo = cur.P0 + wid * QBLK, qm = qlo + r32 - 4 * hi;
    char* V_lds = lds; char* K_lds = lds + 2 * SHM_V;
    float* ws = (float*)(lds + OFF_WS) + wid * 64; float* li_l = ws, * al_l = ws + 32;
    const float* tab = (const float*)(lds + OFF_TAB) + 4 * hi;
    float m_reg = -1e30f, l_reg = 0; f32x16 o[4] = {};
    const int sr = tid >> 4, sc = (tid & 15) * 8, vst0 = v_st(sr, sc), vst1 = v_st(32 + sr, sc), kws = KSWZ(sr, sc * 2);
    const int vb0 = (int)(uintptr_t)V_lds + v_rd_base(lane);
    int ka[4];
#pragma unroll
    for (int dd = 0; dd < 4; ++dd) ka[dd] = (int)(uintptr_t)K_lds + KSWZ(r32, (dd * 16 + hi * 8) * 2);
    const unsigned toff = (unsigned)sr * PITCH + sc;
    const bf16* Kh = cur.K; const bf16* Vh = cur.V;
    bf16x8 qr[8], st_v0, st_v1, st_k0, st_k1;
    { const bf16* qp = cur.Q + (unsigned)(wid * QBLK + r32) * PITCH + hi * 8;
#pragma unroll
      for (int d0 = 0; d0 < 8; ++d0) qr[d0] = load8(qp + d0 * 16); }
    { const bf16* kd = cur.K + (size_t)(cur.P0 + wid * QBLK + r32) * PITCH + hi * 8;
      bf16x8 kv[8];
#pragma unroll
      for (int d0 = 0; d0 < 8; ++d0) kv[d0] = load8(kd + d0 * 16);
      float qn2 = 0.f, dqk = 0.f;
#pragma unroll
      for (int d0 = 0; d0 < 8; ++d0)
#pragma unroll
          for (int e = 0; e < 8; ++e) { const float qf = __uint_as_float((unsigned)(unsigned short)qr[d0][e] << 16), kf = __uint_as_float((unsigned)(unsigned short)kv[d0][e] << 16); qn2 = fmaf(qf, qf, qn2); dqk = fmaf(qf, kf, dqk); }
      qn2 = pg8::add32(qn2); dqk = pg8::add32(dqk);
      float Li = dqk + ((const float*)(lds + OFF_TAB))[cur.P0 + wid * QBLK + r32] - __builtin_sqrtf(qn2 * kmax2) * 1.001f - ATT_MARGIN / SCALE;
      Li = fminf(Li, pg8::sx<1>(Li)); Li = fminf(Li, pg8::sx<2>(Li)); Li = fminf(Li, pg8::sx<4>(Li)); Li = fminf(Li, pg8::sx<8>(Li)); Li = fminf(Li, pg8::sx<16>(Li));
      if (lane == 0) ((float*)(lds + OFF_WS))[wid * 64] = Li; }
#define SLOAD_H(t) do { const bf16* kp_ = Kh + (size_t)(t) * (KVBLK * PITCH); const bf16* vp_ = Vh + (size_t)(t) * (KVBLK * PITCH); \
        st_v0 = load8(vp_ + toff); st_v1 = load8(vp_ + 32 * PITCH + toff); st_k0 = load8(kp_ + toff); st_k1 = load8(kp_ + 32 * PITCH + toff); } while (0)
#define SWRITE_H(bf) do { *(bf16x8*)(V_lds + (bf) * SHM_V + vst0) = st_v0; *(bf16x8*)(V_lds + (bf) * SHM_V + vst1) = st_v1; \
        *(bf16x8*)(K_lds + (bf) * SHM_K + kws) = st_k0; *(bf16x8*)(K_lds + (bf) * SHM_K + kws + 32 * 256) = st_k1; } while (0)
#define RESC(a) do { if (__any((a) < 1.f)) { if (hi == 0) al_l[r32] = (a); asm volatile("s_waitcnt lgkmcnt(0)" ::: "memory");              \
                     _Pragma("unroll") for (int d_ = 0; d_ < 4; ++d_) _Pragma("unroll") for (int r = 0; r < 16; ++r) o[d_][r] *= al_l[crow(r, hi)]; } } while (0)
#define PPBAR() asm volatile("s_waitcnt lgkmcnt(0)\n\ts_barrier" ::: "memory")
#define SHALF(tt, BF) do { const int kb_ = (tt) * KVBLK; SBAR(); qkt<BF>(p0, p1, ka, qr, tab + kb_); if (kb_ + KVBLK - 1 > qlo) mask_tile(p0, p1, qm - kb_); partialSM(p0, p1, m_reg, mn, al, skv); } while (0)
#define VHALF(BF) do { if (!skv) { RESC(al); finishSM(p0, p1, al, l_reg, pa0, pa1, pa2, pa3); SBAR(); pv_tile<BF>(o, vb0, pa0, pa1, pa2, pa3); SBAR(); } } while (0)
#define STAGE(t, BF) do { if ((t) + 1 < NE) { SWRITE_H(1 - (BF)); if ((t) + 2 < NE) SLOAD_H(NT - 3 - (t)); } } while (0)
    f32x16 p0, p1; float mn, al = 1.f; bf16x8 pa0, pa1, pa2, pa3; bool skv = false;
    SLOAD_H(NT - 1); SWRITE_H(0); SLOAD_H(NT - 2);
    PPBAR();
    int NE;
    { const float* lw = (const float*)(lds + OFF_WS); float L = lw[0];
#pragma unroll
      for (int w = 1; w < NW; ++w) L = fminf(L, lw[w * 64]);
      const bool sk = lane < cur.P0 / KVBLK && ((const float*)(lds + OFF_TAB))[64 * lane + 63] <= L;
      NE = __builtin_amdgcn_readfirstlane(NT - (__popcll(__ballot(sk)) & ~1)); }
    if (grp == 0) {
        for (int t = 0; t < NE; t += 2) {
            SHALF(NT - 1 - t, 0); PPBAR(); VHALF(0); STAGE(t, 0); PPBAR();
            SHALF(NT - 2 - t, 1); PPBAR(); VHALF(1); STAGE(t + 1, 1); PPBAR();
        }
    } else {
        for (int t = 0; t < NE; t += 2) {
            if (t >= 1) VHALF(1);
            PPBAR(); SHALF(NT - 1 - t, 0); STAGE(t, 0); PPBAR();
            VHALF(0); PPBAR(); SHALF(NT - 2 - t, 1); STAGE(t + 1, 1); PPBAR();
        }
        VHALF(1);
    }
    unsigned ticket = 0u;
    if (wid == 0 && lane == 0) ticket = __hip_atomic_fetch_add(qctr, 1u, __ATOMIC_RELAXED, __HIP_MEMORY_SCOPE_AGENT);
    if (hi == 0) li_l[r32] = l_reg; asm volatile("s_waitcnt lgkmcnt(0)" ::: "memory");
    { char* stg = lds + OFF_OST + wid * 4096; bf16* Ow = cur.O + (size_t)(wid * QBLK) * OPITCH;
#pragma unroll
      for (int half = 0; half < 2; ++half) {
#pragma unroll
        for (int rr = 0; rr < 8; ++rr) { const int r = 8 * half + rr, rowl = (r & 3) + 8 * ((r >> 2) & 1) + 4 * hi; const float rl = __builtin_amdgcn_rcpf(li_l[crow(r, hi)]);
#pragma unroll
            for (int d0 = 0; d0 < 4; ++d0) { const float v = o[d0][r] * rl; *(unsigned short*)(stg + (rowl * 128 + d0 * 32 + r32) * 2) = (unsigned short)(cvtpk(v, v) & 0xffffu); } }
        asm volatile("s_waitcnt lgkmcnt(0)" ::: "memory");
#pragma unroll
        for (int i = 0; i < 4; ++i) { const int rowl = (lane >> 4) + 4 * i; const u32x4 w = *(const u32x4*)(stg + rowl * 256 + (lane & 15) * 16);
            *(u32x4*)(Ow + (size_t)(16 * half + rowl) * OPITCH + (lane & 15) * 8) = w; }
        asm volatile("s_waitcnt lgkmcnt(0)" ::: "memory");
      } }
    if (wid == 0 && lane == 0) *slot = ticket;
    __syncthreads();
#undef SLOAD_H
#undef SWRITE_H
#undef RESC
#undef PPBAR
#undef SHALF
#undef VHALF
#undef STAGE
}
#endif
__device__ __forceinline__ float fill_table(const float* Fh, const float* KNh, char* lds, int wave_s) {
    const int tid = pg8::otid(wave_s), wid = __builtin_amdgcn_readfirstlane(tid >> 6), lane = tid & 63;
    float* tab = (float*)(lds + OFF_TAB); float* wt = (float*)(lds + OFF_WT);
    f32x4 kn[8];
#pragma unroll
    for (int i = 0; i < 8; ++i) kn[i] = *reinterpret_cast<const f32x4*>(KNh + (size_t)(i >> 1) * SEQ + tid * 8 + 4 * (i & 1));
    float v[8];
    { const f32x4 f0 = *reinterpret_cast<const f32x4*>(Fh + tid * 8), f1 = *reinterpret_cast<const f32x4*>(Fh + tid * 8 + 4);
#pragma unroll
      for (int j = 0; j < 4; ++j) { v[j] = f0[j]; v[4 + j] = f1[j]; } }
#pragma unroll
    for (int j = 1; j < 8; ++j) v[j] += v[j - 1];
    const float tot = v[7]; float scn = tot;
#pragma unroll
    for (int o = 1; o < 64; o <<= 1) { const int src = lane >= o ? lane - o : lane; const float n = __int_as_float(__builtin_amdgcn_ds_bpermute(src << 2, __float_as_int(scn))); if (lane >= o) scn += n; }
    float mx = 0.f;
#pragma unroll
    for (int i = 0; i < 2; ++i) { const f32x4 t4 = (kn[i] + kn[2 + i]) + (kn[4 + i] + kn[6 + i]); mx = fmaxf(mx, fmaxf(fmaxf(t4[0], t4[1]), fmaxf(t4[2], t4[3]))); }
    mx = fmaxf(mx, pg8::sx<1>(mx)); mx = fmaxf(mx, pg8::sx<2>(mx)); mx = fmaxf(mx, pg8::sx<4>(mx)); mx = fmaxf(mx, pg8::sx<8>(mx)); mx = fmaxf(mx, pg8::sx<16>(mx));
    { auto rr = __builtin_amdgcn_permlane32_swap(__float_as_uint(mx), __float_as_uint(mx), false, false); mx = fmaxf(__uint_as_float(rr[0]), __uint_as_float(rr[1])); }
    if (lane == 63) wt[wid] = scn;
    if (lane == 0) wt[8 + wid] = mx;
    __syncthreads();
    float woff = 0.f;
    for (int w = 0; w < wid; ++w) woff += wt[w];
    float r = wt[8];
#pragma unroll
    for (int w = 1; w < NW; ++w) r = fmaxf(r, wt[8 + w]);
    const float base = woff + scn - tot;
#pragma unroll
    for (int j = 0; j < 8; ++j) tab[tid * 8 + j] = -(base + v[j]) * (1.f / SCALE);
    __syncthreads();
    return r * 1.02f;
}
#undef KSWZ
#undef SBAR
}

#ifndef DIAG_REGION
#define DIAG_REGION 0
#endif
constexpr int NWAVES = 8;
constexpr int BATCH = 4, T = 4096, D = 2048, DEPTH = 4, M = BATCH * T;
constexpr int FF = 5632, NFF = 2 * FF;
constexpr int DCONV = 512, DATT = 1024, DLRU = 512, NH = 8, HD = 128;
constexpr int DIN = 5640;
constexpr int PW = 5632;
constexpr int NMIX = 5888;
constexpr int PC_B = 0, PC_C = 512, PC_V = 1024, PC_Q = 1536, PC_K = 2560, PC_VV = 3584, PC_G = 4608, PC_X = 5120;
constexpr int LCH = 64, NCH = T / LCH;
constexpr float EPS = 1e-6f;
constexpr int N_PHASES = 2 + 12 * DEPTH;

constexpr size_t MiB = 1u << 20;
constexpr size_t WS_CTL = 0, CTL_ZERO_BYTES = 1 * MiB;
constexpr size_t SZ_W1 = (size_t)NFF * D * 2, SZ_W2 = (size_t)D * FF * 2, SZ_WM = (size_t)NMIX * D * 2, SZ_WO = (size_t)D * D * 2, SZ_WG = (size_t)2 * 4 * 128 * 128 * 2;
constexpr size_t SZ_W1Q = (size_t)NFF * D;
constexpr size_t WS_W1 = 1 * MiB;
constexpr size_t WS_HB = WS_W1;
constexpr size_t SZ_P = (size_t)M * FF * 2;
constexpr size_t WS_P  = WS_W1 + (size_t)M * FF * 2;
static_assert(2 * DEPTH * SZ_W1 >= (size_t)M * FF * 2 + (size_t)M * PW * 2, "HB and P fit in the dead bf16 FFN-in region");
constexpr size_t WS_W2 = WS_W1 + 2 * DEPTH * SZ_W1;
constexpr size_t WS_WM = WS_W2 + 2 * DEPTH * SZ_W2;
constexpr size_t WS_WO = WS_WM + DEPTH * SZ_WM;
constexpr size_t WS_WG = WS_WO + DEPTH * SZ_WO;
constexpr size_t WS_XB = WS_WG + DEPTH * SZ_WG;
constexpr size_t WS_W1Q = WS_XB + (size_t)M * D * 2;
constexpr size_t WS_SW = WS_W1Q + 2 * DEPTH * SZ_W1Q;
constexpr size_t WS_Q8 = WS_SW + (size_t)2 * DEPTH * NFF * 4;
constexpr size_t WS_RSA = WS_Q8 + (size_t)M * D;
constexpr size_t WS_W2Q = WS_RSA + (size_t)M * 4;
constexpr size_t WS_SW2 = WS_W2Q + (size_t)2 * DEPTH * D * FF;
constexpr size_t WS_HQ = WS_SW2 + (size_t)2 * DEPTH * D * 4;
constexpr size_t WS_SH = WS_HQ + (size_t)M * FF;
constexpr size_t WS_YA = WS_SH + (size_t)M * 4;
constexpr size_t WS_Y  = WS_YA + (size_t)M * DATT * 2;
constexpr size_t WS_F  = WS_Y + (size_t)M * D * 2;
constexpr size_t WS_SA = WS_F + (size_t)M * 8 * 4;
constexpr size_t WS_SS = WS_SA + (size_t)M * 8 * 4;
constexpr size_t WS_CS = WS_SS + (size_t)M * 32 * 4;
constexpr size_t WS_XL = WS_CS + (size_t)BATCH * NCH * DLRU * 2 * 4;
constexpr size_t WS_HL = WS_XL + (size_t)M * D;
constexpr size_t WS_CA = WS_HL + (size_t)M * DLRU * 4;
constexpr size_t WS_BS = WS_CA + (size_t)M * DLRU * 4;
constexpr size_t WS_KN = WS_BS + (size_t)M * (FF / 32) * 4;
constexpr size_t WS_WGF = WS_KN + (size_t)M * 32 * 4;
constexpr size_t WS_END = WS_WGF + DEPTH * SZ_WG;
static_assert(WS_W1 % 256 == 0 && WS_XB % 256 == 0 && WS_F % 256 == 0 && WS_CS % 256 == 0 && WS_W1Q % 256 == 0 && WS_Q8 % 256 == 0 && WS_SW % 256 == 0 && WS_RSA % 256 == 0 && WS_W2Q % 256 == 0 && WS_HQ % 256 == 0, "d_ws map alignment");
constexpr int CW_TMO = 0;
constexpr int CW_BAR = 4096;
constexpr int CW_BAR2 = 8192;
constexpr int CW_AMAX = 32768;
constexpr int CW_AMAXO = CW_AMAX + 2 * DEPTH * NFF;
constexpr int CW_AMAX2 = CW_AMAXO + DEPTH * D;
constexpr int CW_PCNT = 163840;
constexpr int CW_PMASK = CW_PCNT + 64 * 64;
constexpr int CW_ATQ = CW_PMASK + 64 * 64;
static_assert((size_t)(CW_ATQ + DEPTH * BATCH * 64) * 4 <= CTL_ZERO_BYTES, "attention queue counters inside the memset region");
constexpr int NOWN = 4;
static_assert(CW_AMAX2 + 2 * DEPTH * D <= CW_PCNT && (size_t)(CW_PMASK + 64 * 64) * 4 <= CTL_ZERO_BYTES, "control words inside the memset region");

constexpr int RING_OFF = 0, RING_BYTES = 131072;
constexpr int RS_OFF = RING_BYTES;
constexpr int LDSCTL_OFF = RS_OFF + 1024, MISC_OFF = LDSCTL_OFF + 320;
constexpr int LDS_BYTES = 147456;
static_assert(MISC_OFF + 128 <= LDS_BYTES, "LDS map");
constexpr int LRU_XF = 0;
constexpr int LRU_XH_PITCH = 1040;
constexpr int LRU_XH = 65536;
constexpr int LRU_SQ = LRU_XH + 32 * LRU_XH_PITCH;
static_assert(LRU_SQ + 8 * 32 * 4 <= RING_BYTES && att::LDS_BYTES <= RING_BYTES, "phase scratch inside the ring region");

#define GAS __attribute__((address_space(1)))
#define LAS __attribute__((address_space(3)))
typedef unsigned short bf16;
typedef unsigned v4u __attribute__((ext_vector_type(4)));
typedef unsigned v2u __attribute__((ext_vector_type(2)));
typedef float f32x4 __attribute__((ext_vector_type(4)));
typedef float f32x2 __attribute__((ext_vector_type(2)));
typedef float f32x16 __attribute__((ext_vector_type(16)));
typedef short bf16x8 __attribute__((ext_vector_type(8)));
typedef GAS unsigned gu32;
#define RLX_AGENT __ATOMIC_RELAXED, __HIP_MEMORY_SCOPE_AGENT
#define LDS_WAIT() asm volatile("s_waitcnt lgkmcnt(0)" ::: "memory")
#define VM_WAIT() asm volatile("s_waitcnt vmcnt(0)" ::: "memory")
__device__ __forceinline__ unsigned pk2(float lo, float hi) { return pg8::cvt_pk_bf16(lo, hi); }
__device__ __forceinline__ float bflo(unsigned w) { return __uint_as_float(w << 16); }
__device__ __forceinline__ float bfhi(unsigned w) { return __uint_as_float(w & 0xffff0000u); }
__device__ __forceinline__ float bf1(bf16 h) { return __uint_as_float((unsigned)h << 16); }
__device__ __forceinline__ float wave_sum(float v) {
    v += pg8::sx<1>(v); v += pg8::sx<2>(v); v += pg8::sx<4>(v); v += pg8::sx<8>(v); v += pg8::sx<16>(v); return pg8::add32(v);
}

#define XB_TMO      128
#define XB_XCNT(j)  (256  + 64 * (j))
#define XB_XSUB(j)  (1280 + 64 * (j))
#define XB_XGEN(j)  (2304 + 64 * (j))
#define XB_TOP      3328
#define XB_TOPGEN   3392
#define XCD_BAR_WORDS 3456
#define XB_SPIN_CAP (1u << 18)

__device__ __forceinline__ unsigned xb_ld(unsigned* p)              { return __hip_atomic_load(p, __ATOMIC_RELAXED, __HIP_MEMORY_SCOPE_AGENT); }
__device__ __forceinline__ unsigned xb_add(unsigned* p, unsigned v) { return __hip_atomic_fetch_add(p, v, __ATOMIC_RELAXED, __HIP_MEMORY_SCOPE_AGENT); }
__device__ __forceinline__ unsigned xb_xcc_id() { return (unsigned)__builtin_amdgcn_s_getreg((3 << 11) | 20) & 0xFu; }
#define XB_SPIN(cond, bar) do { unsigned _sp = 0; while (cond) { __builtin_amdgcn_s_sleep(1); \
    if ((++_sp & 255u) == 0u) { if (xb_ld(&(bar)[XB_TMO])) break; if (_sp > XB_SPIN_CAP) { atomicAdd(&(bar)[XB_TMO], 1u); break; } } } } while (0)

struct XcdBarrier {
    unsigned np;
    unsigned* bar; unsigned x; int w;
    volatile LAS unsigned* st;
};

__device__ __forceinline__ bool xb_thread0(int w) { return w == 0 && pg8::olane() == 0; }
__device__ __forceinline__ XcdBarrier xcd_barrier_post(unsigned* bar, volatile LAS unsigned* st, int w, unsigned np) {
    XcdBarrier b; b.bar = bar; b.x = xb_xcc_id(); b.st = st; b.w = w; b.np = np;
    if (xb_thread0(w)) (void)xb_add(&bar[XB_XCNT(b.x)], 1u);
    return b;
}
__device__ __forceinline__ void xcd_barrier_complete(unsigned* bar, unsigned x, unsigned& nloc, unsigned& nx, unsigned G) {
    asm volatile("" : "+s"(x));
    unsigned sum, cnt, mine, sp = 0u;
    for (;;) {
        sum = 0u; cnt = 0u; mine = 0u;
#pragma unroll
        for (unsigned j = 0; j < 16; ++j) { const unsigned c = xb_ld(&bar[XB_XCNT(j)]); sum += c; cnt += (c > 0u) ? 1u : 0u; mine = (j == x) ? c : mine; }
        if (sum == G) break;
        __builtin_amdgcn_s_sleep(1);
        if ((++sp & 255u) == 0u) { if (xb_ld(&bar[XB_TMO])) break; if (sp > XB_SPIN_CAP) { atomicAdd(&bar[XB_TMO], 1u); break; } }
    }
    nloc = mine > 0u ? mine : 1u; nx = cnt > 0u ? cnt : 1u;
}

__device__ __forceinline__ void xcd_barrier(const XcdBarrier& b_in) {
    XcdBarrier b = b_in; asm volatile("" : "+s"(b.bar), "+s"(b.x));
    asm volatile("s_waitcnt vmcnt(0)" ::: "memory");
    __syncthreads();
    if (xb_thread0(b.w)) {
        unsigned* bar = b.bar;
        __builtin_amdgcn_s_waitcnt(0);
        unsigned nloc = b.st[0], nx = b.st[1];
        if (nloc == 0u) { xcd_barrier_complete(bar, b.x, nloc, nx, b.np); b.st[0] = nloc; b.st[1] = nx; }
        const unsigned old = xb_add(&bar[XB_XSUB(b.x)], 1u);
        const unsigned gen = old / nloc;
        if (old + 1u == (gen + 1u) * nloc) {
            __builtin_amdgcn_fence(__ATOMIC_RELEASE, "agent");
            asm volatile("s_waitcnt vmcnt(0)" ::: "memory");
            const unsigned og = xb_add(&bar[XB_TOP], 1u);
            const unsigned tg = og / nx;
            if (og + 1u == (tg + 1u) * nx) xb_add(&bar[XB_TOPGEN], 1u);
            else XB_SPIN(xb_ld(&bar[XB_TOPGEN]) == tg, bar);
            __builtin_amdgcn_fence(__ATOMIC_ACQUIRE, "agent");
            xb_add(&bar[XB_XGEN(b.x)], 1u);
            asm volatile("s_waitcnt vmcnt(0)" ::: "memory");
        } else {
            XB_SPIN(xb_ld(&bar[XB_XGEN(b.x)]) == gen, bar);
            __builtin_amdgcn_fence(__ATOMIC_ACQUIRE, "agent");
            asm volatile("s_waitcnt vmcnt(0)" ::: "memory");
        }
    }
    __syncthreads();
}

__device__ __forceinline__ void panel_barrier(unsigned* ctl, int pm, unsigned target, volatile LAS unsigned* misc, int w) {
    asm volatile("" : "+s"(ctl), "+s"(pm), "+s"(target));
    asm volatile("s_waitcnt vmcnt(0)" ::: "memory");
    __syncthreads();
    if (xb_thread0(w)) {
        __builtin_amdgcn_s_waitcnt(0);
        unsigned* cnt = ctl + CW_PCNT + 64 * pm; unsigned* tmo = ctl + CW_BAR + XB_TMO;
        if (misc[12] != 1u) { __builtin_amdgcn_fence(__ATOMIC_RELEASE, "agent"); asm volatile("s_waitcnt vmcnt(0)" ::: "memory"); }
        (void)xb_add(cnt, 1u);
        unsigned sp = 0u;
        while (xb_ld(cnt) < target) { __builtin_amdgcn_s_sleep(1);
            if ((++sp & 255u) == 0u) { if (xb_ld(tmo)) break; if (sp > XB_SPIN_CAP) { atomicAdd(tmo, 1u); break; } } }
        __builtin_amdgcn_fence(__ATOMIC_ACQUIRE, "agent");
        asm volatile("s_waitcnt vmcnt(0)" ::: "memory");
    }
    __syncthreads();
}
template <int MODE> __device__ __forceinline__ int src_col(int n) {
    if (MODE == 1) { const int pn = n >> 8, bj = (n >> 7) & 1, jj = n & 127; return bj * FF + 128 * pn + jj; }
    if (MODE == 2) { if (n < 4608) return n; if (n < 5632) return n + 8; if (n < 5640) return n - 1024; return -1; }
    return n;
}
template <int MODE>
__device__ __forceinline__ void tr_item(const float* W, int K, int Nsrc, const float* gain, bf16* WT, int nblk, LAS unsigned* scr, int item, int lane, unsigned* amax = nullptr) {
    const int kb = item / nblk, nb = item % nblk, k0 = 64 * kb, n0 = 64 * nb;
    const int n4 = lane & 15, pr = lane >> 4;
    const int sc = src_col<MODE>(n0 + 4 * n4);
    f32x4 va[8], vb[8];
#pragma unroll
    for (int i = 0; i < 8; ++i) { const int p = 4 * i + pr;
        if (sc >= 0) { const float* s = W + (size_t)(k0 + 2 * p) * Nsrc + sc; va[i] = *(const f32x4*)s; vb[i] = *(const f32x4*)(s + Nsrc); }
        else { va[i] = (f32x4){0.f, 0.f, 0.f, 0.f}; vb[i] = va[i]; } }
#pragma unroll
    for (int i = 0; i < 8; ++i) { const int p = 4 * i + pr;
        float ga = 1.f, gb = 1.f; if (gain) { ga = gain[k0 + 2 * p]; gb = gain[k0 + 2 * p + 1]; }
        v4u w; w.x = pk2(va[i][0] * ga, vb[i][0] * gb); w.y = pk2(va[i][1] * ga, vb[i][1] * gb); w.z = pk2(va[i][2] * ga, vb[i][2] * gb); w.w = pk2(va[i][3] * ga, vb[i][3] * gb);
        *(LAS v4u*)(scr + p * 64 + 4 * (n4 ^ ((p >> 2) & 7))) = w; }
    LDS_WAIT(); asm volatile("" ::: "memory");
    const int c = lane & 7;
#pragma unroll
    for (int j = 0; j < 8; ++j) { const int n = (lane >> 3) + 8 * j;
        v4u o;
#pragma unroll
        for (int i = 0; i < 4; ++i) { const int p = 4 * c + i; o[i] = scr[p * 64 + (n ^ (((p >> 2) & 7) << 2))]; }
        *(GAS v4u*)(WT + (size_t)(n0 + n) * K + k0 + 8 * c) = o;
        if (amax) {
            float mx = 0.f;
#pragma unroll
            for (int i = 0; i < 4; ++i) mx = fmaxf(mx, fmaxf(fabsf(bflo(o[i])), fabsf(bfhi(o[i]))));
            mx = fmaxf(mx, pg8::sx<1>(mx)); mx = fmaxf(mx, pg8::sx<2>(mx)); mx = fmaxf(mx, pg8::sx<4>(mx));
            if (c == 0) atomicMax(amax + n0 + n, __float_as_uint(mx)); } }
    LDS_WAIT(); asm volatile("" ::: "memory");
}
template <int MODE>
__device__ __forceinline__ void tr_matrix(const float* W, int K, int Nsrc, const float* gain, bf16* WT, int Ndst, LAS unsigned* scr, int gw, int NGW, int lane, unsigned* amax = nullptr) {
    const int nblk = Ndst / 64, nitems = (K / 64) * nblk;
    for (int it = gw; it < nitems; it += NGW) tr_item<MODE>(W, K, Nsrc, gain, WT, nblk, scr, it, lane, amax);
}
__device__ __forceinline__ void w1_strip(const float* W, const float* gain, unsigned char* WQ, float* SWm, int strip, LAS unsigned char* lds, int wave, int tid, int lane_in) {
    int lane = lane_in; asm volatile("" : "+v"(lane));
    const int n0 = 64 * strip, n4 = lane & 15, pr = lane >> 4;
    const int sc = src_col<1>(n0 + 4 * n4);
    LAS unsigned* scr = (LAS unsigned*)(lds + RING_OFF + wave * 16384);
    LAS float* cinv = (LAS float*)(lds + RS_OFF);
    v4u w[3][8]; float cm[4] = {0.f, 0.f, 0.f, 0.f};
#pragma unroll
    for (int it = 0; it < 4; ++it) { const int k0 = 256 * wave + 64 * it;
#pragma unroll
        for (int hh = 0; hh < 2; ++hh) {
            f32x4 va[4], vb[4]; f32x2 gg[4];
#pragma unroll
            for (int i = 0; i < 4; ++i) { const int p = 4 * (4 * hh + i) + pr; const float* s = W + (size_t)(k0 + 2 * p) * NFF + sc; va[i] = *(const f32x4*)s; vb[i] = *(const f32x4*)(s + NFF); gg[i] = *(const f32x2*)(gain + k0 + 2 * p); }
#pragma unroll
            for (int i = 0; i < 4; ++i) { const float ga = gg[i].x, gb = gg[i].y; v4u x;
                x.x = pk2(va[i][0] * ga, vb[i][0] * gb); x.y = pk2(va[i][1] * ga, vb[i][1] * gb); x.z = pk2(va[i][2] * ga, vb[i][2] * gb); x.w = pk2(va[i][3] * ga, vb[i][3] * gb);
                if (it < 3) w[it][4 * hh + i] = x; else { const int p = 4 * (4 * hh + i) + pr; *(LAS v4u*)(scr + p * 64 + 4 * (n4 ^ ((p >> 2) & 7))) = x; }
#pragma unroll
                for (int c = 0; c < 4; ++c) cm[c] = fmaxf(cm[c], fmaxf(fabsf(bflo(x[c])), fabsf(bfhi(x[c])))); }
            asm volatile("" ::: "memory");
        }
    }
#pragma unroll
    for (int c = 0; c < 4; ++c) cm[c] = pg8::max32(pg8::max16(cm[c]));
    if (pr == 0) { f32x4 t4 = {cm[0], cm[1], cm[2], cm[3]}; *(LAS f32x4*)((LAS float*)scr + 2048 + 4 * n4) = t4; }
    __syncthreads();
    if (tid < 64) { float m = 0.f;
#pragma unroll
        for (int w8 = 0; w8 < 8; ++w8) m = fmaxf(m, ((const LAS float*)(lds + RING_OFF + w8 * 16384 + 8192))[tid]);
        cinv[tid] = m > 0.f ? 127.f / m : 0.f; SWm[n0 + tid] = m * (1.f / 127.f); }
    __syncthreads();
    const int c = lane & 7, nr = lane >> 3;
#pragma unroll
    for (int t4 = 0; t4 < 4; ++t4) { const int it = (t4 + 3) & 3;
        if (it < 3) {
#pragma unroll
            for (int i = 0; i < 8; ++i) { const int p = 4 * i + pr; *(LAS v4u*)(scr + p * 64 + 4 * (n4 ^ ((p >> 2) & 7))) = w[it][i]; } }
        LDS_WAIT(); asm volatile("" ::: "memory");
#pragma unroll
        for (int j = 0; j < 8; ++j) { const int n = nr + 8 * j; const float inv = cinv[n];
            unsigned o[4];
#pragma unroll
            for (int i = 0; i < 4; ++i) { const int p = 4 * c + i; o[i] = scr[p * 64 + (n ^ (((p >> 2) & 7) << 2))]; }
            v2u q;
            q.x = ((unsigned)(int)__builtin_rintf(bflo(o[0]) * inv) & 0xffu) | (((unsigned)(int)__builtin_rintf(bfhi(o[0]) * inv) & 0xffu) << 8)
                | (((unsigned)(int)__builtin_rintf(bflo(o[1]) * inv) & 0xffu) << 16) | (((unsigned)(int)__builtin_rintf(bfhi(o[1]) * inv) & 0xffu) << 24);
            q.y = ((unsigned)(int)__builtin_rintf(bflo(o[2]) * inv) & 0xffu) | (((unsigned)(int)__builtin_rintf(bfhi(o[2]) * inv) & 0xffu) << 8)
                | (((unsigned)(int)__builtin_rintf(bflo(o[3]) * inv) & 0xffu) << 16) | (((unsigned)(int)__builtin_rintf(bfhi(o[3]) * inv) & 0xffu) << 24);
            *(GAS v2u*)(WQ + (size_t)(n0 + n) * D + 256 * wave + 64 * it + 8 * c) = q; }
        LDS_WAIT(); asm volatile("" ::: "memory");
    }
}
__device__ __forceinline__ void w2_strip(const float* W, unsigned char* WQ, float* SWm, int strip, LAS unsigned char* lds, int wave, int tid, int lane_in) {
    int lane = lane_in; asm volatile("" : "+v"(lane));
    const int n0 = 16 * strip, n4 = lane & 3, pr = lane >> 2;
    LAS unsigned* scr = (LAS unsigned*)(lds + RING_OFF + wave * 16384);
    LAS float* cinv = (LAS float*)(lds + RS_OFF);
    v4u w[11][2]; float cm[4] = {0.f, 0.f, 0.f, 0.f};
    const float* src = W + (size_t)(704 * wave) * D + n0 + 4 * n4;
#pragma unroll
    for (int it = 0; it < 11; ++it) {
        f32x4 va[2], vb[2];
#pragma unroll
        for (int i = 0; i < 2; ++i) { const int p = pr + 16 * i; const float* s = src + (size_t)(64 * it + 2 * p) * D; va[i] = *(const f32x4*)s; vb[i] = *(const f32x4*)(s + D); }
#pragma unroll
        for (int i = 0; i < 2; ++i) { v4u x; x.x = pk2(va[i][0], vb[i][0]); x.y = pk2(va[i][1], vb[i][1]); x.z = pk2(va[i][2], vb[i][2]); x.w = pk2(va[i][3], vb[i][3]);
            w[it][i] = x;
#pragma unroll
            for (int c = 0; c < 4; ++c) cm[c] = fmaxf(cm[c], fmaxf(fabsf(bflo(x[c])), fabsf(bfhi(x[c])))); }
        if (it % 3 == 2) asm volatile("" ::: "memory");
    }
#pragma unroll
    for (int c = 0; c < 4; ++c) { float m = cm[c]; m = fmaxf(m, pg8::sx<4>(m)); m = fmaxf(m, pg8::sx<8>(m)); m = pg8::max32(pg8::max16(m)); cm[c] = m; }
    if (pr == 0) { f32x4 t4 = {cm[0], cm[1], cm[2], cm[3]}; *(LAS f32x4*)((LAS float*)scr + 2048 + 4 * n4) = t4; }
    __syncthreads();
    if (tid < 16) { float m = 0.f;
#pragma unroll
        for (int w8 = 0; w8 < 8; ++w8) m = fmaxf(m, ((const LAS float*)(lds + RING_OFF + w8 * 16384 + 8192))[tid]);
        cinv[tid] = m > 0.f ? 127.f / m : 0.f; SWm[n0 + tid] = m * (1.f / 127.f); }
    __syncthreads();
    const int nr = lane & 15, c = lane >> 4; const float inv = cinv[nr];
    unsigned char* drow = WQ + (size_t)(n0 + nr) * FF + 704 * wave + 16 * c;
#pragma unroll
    for (int it = 0; it < 11; ++it) {
#pragma unroll
        for (int i = 0; i < 2; ++i) { const int p = pr + 16 * i; *(LAS v4u*)(scr + p * 16 + 4 * n4) = w[it][i]; }
        LDS_WAIT(); asm volatile("" ::: "memory");
        unsigned o[8];
#pragma unroll
        for (int j = 0; j < 8; ++j) o[j] = scr[(8 * c + j) * 16 + nr];
        v4u q;
#pragma unroll
        for (int e = 0; e < 4; ++e)
            q[e] = ((unsigned)(int)__builtin_rintf(bflo(o[2 * e]) * inv) & 0xffu) | (((unsigned)(int)__builtin_rintf(bfhi(o[2 * e]) * inv) & 0xffu) << 8)
                 | (((unsigned)(int)__builtin_rintf(bflo(o[2 * e + 1]) * inv) & 0xffu) << 16) | (((unsigned)(int)__builtin_rintf(bfhi(o[2 * e + 1]) * inv) & 0xffu) << 24);
        *(GAS v4u*)(drow + 64 * it) = q;
        LDS_WAIT(); asm volatile("" ::: "memory");
    }
}
__device__ __forceinline__ void quant_wrow(const bf16* src, unsigned char* dst, float amax, float* sw_out, int lane) {
    const float inv = amax > 0.f ? 127.f / amax : 0.f;
    const v4u* s = (const v4u*)src + 4 * lane; v4u w[4];
#pragma unroll
    for (int i = 0; i < 4; ++i) w[i] = s[i];
    v4u o[2];
#pragma unroll
    for (int i = 0; i < 4; ++i)
#pragma unroll
        for (int e = 0; e < 4; ++e) { const int q0 = (int)__builtin_rintf(bflo(w[i][e]) * inv), q1 = (int)__builtin_rintf(bfhi(w[i][e]) * inv);
            const unsigned two = ((unsigned)q0 & 0xffu) | (((unsigned)q1 & 0xffu) << 8);
            const int pos = 8 * i + 2 * e;
            if ((pos & 3) == 0) o[pos >> 4][(pos >> 2) & 3] = two; else o[pos >> 4][(pos >> 2) & 3] |= two << 16; }
    v4u* d = (v4u*)dst + 2 * lane; d[0] = o[0]; d[1] = o[1];
    if (lane == 0) *sw_out = amax * (1.f / 127.f);
}
#ifndef Q1_HI_ONLY
#define Q1_HI_ONLY 1
#endif
__device__ __forceinline__ void quant_xrow_load(v4u (&h)[4], v4u (&l)[2], const bf16* xh, const unsigned char* xl, int lane) {
    const v4u* hp = (const v4u*)xh + 4 * lane; const v4u* lp = (const v4u*)xl + 2 * lane;
#pragma unroll
    for (int i = 0; i < 4; ++i) h[i] = hp[i];
#if !Q1_HI_ONLY
    l[0] = lp[0]; l[1] = lp[1];
#else
    (void)lp; (void)l;
#endif
}
__device__ __forceinline__ void quant_xrow(const v4u (&h)[4], const v4u (&l)[2], unsigned char* q8, float* rsa, int lane) {
    float v[32]; float mx = 0.f, sq = 0.f;
#pragma unroll
    for (int i = 0; i < 32; ++i) { const unsigned hw = h[i >> 3][(i >> 1) & 3]; const unsigned hb = (i & 1) ? (hw >> 16) : (hw & 0xffffu);
#if !Q1_HI_ONLY
        const int q = (int)(l[i >> 4][(i >> 2) & 3] << (24 - 8 * (i & 3))) >> 24;
        v[i] = pg8::res_dec(hb, q);
#else
        v[i] = __uint_as_float(hb << 16);
#endif
        mx = fmaxf(mx, fabsf(v[i])); sq += v[i] * v[i]; }
    mx = fmaxf(mx, pg8::sx<1>(mx)); mx = fmaxf(mx, pg8::sx<2>(mx)); mx = fmaxf(mx, pg8::sx<4>(mx)); mx = fmaxf(mx, pg8::sx<8>(mx)); mx = fmaxf(mx, pg8::sx<16>(mx));
    { auto rr = __builtin_amdgcn_permlane32_swap(__float_as_uint(mx), __float_as_uint(mx), false, false); mx = fmaxf(__uint_as_float(rr[0]), __uint_as_float(rr[1])); }
    sq = wave_sum(sq);
    const float inv = mx > 0.f ? 127.f / mx : 0.f;
    v4u o[2];
#pragma unroll
    for (int i = 0; i < 32; i += 4) { const unsigned b0 = (unsigned)(int)__builtin_rintf(v[i] * inv) & 0xffu, b1 = (unsigned)(int)__builtin_rintf(v[i + 1] * inv) & 0xffu,
                                                     b2 = (unsigned)(int)__builtin_rintf(v[i + 2] * inv) & 0xffu, b3 = (unsigned)(int)__builtin_rintf(v[i + 3] * inv) & 0xffu;
        o[i >> 4][(i >> 2) & 3] = b0 | (b1 << 8) | (b2 << 16) | (b3 << 24); }
    v4u* d = (v4u*)q8 + 2 * lane; d[0] = o[0]; d[1] = o[1];
    if (lane == 0) *rsa = __builtin_amdgcn_rsqf(sq * (1.f / D) + EPS) * mx * (1.f / 127.f);
}
template <int NP> __device__ __forceinline__ void quant_row_bf16(const bf16* src, unsigned char* dst, float amax_known, bool have_amax, float* step_out, int lane) {
    v4u w[NP]; float mx = 0.f;
#pragma unroll
    for (int p = 0; p < NP; ++p) w[p] = ((const v4u*)src)[p * 64 + lane];
    if (!have_amax) {
#pragma unroll
        for (int p = 0; p < NP; ++p)
#pragma unroll
            for (int e = 0; e < 4; ++e) mx = fmaxf(mx, fmaxf(fabsf(bflo(w[p][e])), fabsf(bfhi(w[p][e]))));
        mx = fmaxf(mx, pg8::sx<1>(mx)); mx = fmaxf(mx, pg8::sx<2>(mx)); mx = fmaxf(mx, pg8::sx<4>(mx)); mx = fmaxf(mx, pg8::sx<8>(mx)); mx = fmaxf(mx, pg8::sx<16>(mx));
        { auto rr = __builtin_amdgcn_permlane32_swap(__float_as_uint(mx), __float_as_uint(mx), false, false); mx = fmaxf(__uint_as_float(rr[0]), __uint_as_float(rr[1])); }
    } else mx = amax_known;
    const float inv = mx > 0.f ? 127.f / mx : 0.f;
#pragma unroll
    for (int p = 0; p < NP; ++p) { v2u o;
#pragma unroll
        for (int hh = 0; hh < 2; ++hh) { const unsigned a = w[p][2 * hh], b = w[p][2 * hh + 1];
            o[hh] = ((unsigned)(int)__builtin_rintf(bflo(a) * inv) & 0xffu) | (((unsigned)(int)__builtin_rintf(bfhi(a) * inv) & 0xffu) << 8)
                  | (((unsigned)(int)__builtin_rintf(bflo(b) * inv) & 0xffu) << 16) | (((unsigned)(int)__builtin_rintf(bfhi(b) * inv) & 0xffu) << 24); }
        ((v2u*)dst)[p * 64 + lane] = o; }
    if (lane == 0) *step_out = mx * (1.f / 127.f);
}
constexpr int NPC = FF / 512;
__device__ __forceinline__ void requant_row_load(v2u (&w)[NPC], float (&sb)[NPC], const unsigned char* q, const float* bs, int lane) {
#pragma unroll
    for (int p = 0; p < NPC; ++p) { w[p] = ((const v2u*)q)[p * 64 + lane]; sb[p] = bs[(p * 64 + lane) >> 2]; }
}
__device__ __forceinline__ void requant_row_blocks(const v2u (&w)[NPC], const float (&sb)[NPC], unsigned char* q, float* step_out, int lane) {
    float smax = 0.f;
#pragma unroll
    for (int p = 0; p < NPC; ++p) smax = fmaxf(smax, sb[p]);
    smax = fmaxf(smax, pg8::sx<1>(smax)); smax = fmaxf(smax, pg8::sx<2>(smax)); smax = fmaxf(smax, pg8::sx<4>(smax)); smax = fmaxf(smax, pg8::sx<8>(smax)); smax = fmaxf(smax, pg8::sx<16>(smax));
    { auto rr = __builtin_amdgcn_permlane32_swap(__float_as_uint(smax), __float_as_uint(smax), false, false); smax = fmaxf(__uint_as_float(rr[0]), __uint_as_float(rr[1])); }
    const float isx = smax > 0.f ? __builtin_amdgcn_rcpf(smax) : 0.f;
#pragma unroll
    for (int p = 0; p < NPC; ++p) { const float r = fminf(sb[p] * isx, 1.f); v2u o;
#pragma unroll
        for (int hh = 0; hh < 2; ++hh) { const unsigned a = w[p][hh];
            const float f0 = (float)((int)(a << 24) >> 24), f1 = (float)((int)(a << 16) >> 24), f2 = (float)((int)(a << 8) >> 24), f3 = (float)((int)a >> 24);
            o[hh] = ((unsigned)(int)__builtin_rintf(f0 * r) & 0xffu) | (((unsigned)(int)__builtin_rintf(f1 * r) & 0xffu) << 8)
                  | (((unsigned)(int)__builtin_rintf(f2 * r) & 0xffu) << 16) | (((unsigned)(int)__builtin_rintf(f3 * r) & 0xffu) << 24); }
        ((v2u*)q)[p * 64 + lane] = o; }
    if (lane == 0) *step_out = smax;
}
__device__ __forceinline__ void load_rsa(LAS unsigned char* lds, int pm, const float* RSA, int wave_s) {
    const int tid = pg8::otid(wave_s);
    if (tid < 256) ((LAS float*)(lds + RS_OFF))[tid] = RSA[pm * 256 + tid];
    __syncthreads();
}

__device__ __forceinline__ void compute_rs(LAS unsigned char* lds, int pm, const float* SS, int wave_s) {
    const int tid = pg8::otid(wave_s);
    const f32x4* p = (const f32x4*)(SS + (size_t)(pm * 256 + (tid >> 1)) * 32 + (tid & 1) * 16);
    const f32x4 a = p[0], b = p[1], c = p[2], d = p[3];
    float s = ((a[0] + a[1]) + (a[2] + a[3])) + ((b[0] + b[1]) + (b[2] + b[3])) + ((c[0] + c[1]) + (c[2] + c[3])) + ((d[0] + d[1]) + (d[2] + d[3]));
    s += pg8::sx<1>(s);
    if ((tid & 1) == 0) ((LAS float*)(lds + RS_OFF))[tid >> 1] = __builtin_amdgcn_rsqf(s * (1.f / D) + EPS);
    __syncthreads();
}

__device__ __forceinline__ float sigmoidf_(float z) { return __builtin_amdgcn_rcpf(1.f + __expf(-z)); }
__device__ __forceinline__ float gelu_tanh(float x) { const float z = 0.7978845608028654f * (x + 0.044715f * x * x * x); const float t = __expf(2.f * z); return 0.5f * x * (2.f - 2.f * __builtin_amdgcn_rcpf(t + 1.f)); }
__device__ __forceinline__ bf16 f2bf(float f) { unsigned u = __float_as_uint(f); return (bf16)((u + 0x7fffu + ((u >> 16) & 1u)) >> 16); }
__device__ __forceinline__ void lru_unit(LAS unsigned char* lds, int b, int ck, const bf16* P, const float* cw, const float* cbias, const bf16* WG,
                                         const float* b_a, const float* b_x, const float* lam, float* CS, float* HL, float* CA, int wave_s) {
    const int tid = pg8::otid(wave_s), wid = __builtin_amdgcn_readfirstlane(tid >> 6), lane = tid & 63, j = lane & 31, hi = lane >> 5;
    LAS float* XF = (LAS float*)(lds + LRU_XF); LAS unsigned char* XH = lds + LRU_XH;
    const int g = wid >> 1, cwv = 64 * wid;
    float A64[2] = {1.f, 1.f}, H64[2] = {0.f, 0.f};
    volatile LAS unsigned* MISCp = (volatile LAS unsigned*)(lds + MISC_OFF);
#define LT0(r) do { if (DIAG_REGION == (r) && xb_thread0(wave_s)) MISCp[19] = (unsigned)__builtin_amdgcn_s_memrealtime(); } while (0)
#define LT1(r) do { if (DIAG_REGION == (r) && xb_thread0(wave_s)) MISCp[18] += (unsigned)__builtin_amdgcn_s_memrealtime() - MISCp[19]; } while (0)
#pragma nounroll
    for (int sub = 0; sub < LCH / 32; ++sub) {
    const int t0 = ck * LCH + 32 * sub; const size_t m0 = (size_t)b * T + t0;
    LT0(5);
#pragma unroll
    for (int it = 0; it < 4; ++it) {
        const int idx = it * 512 + tid, tt = idx >> 6, c0 = (idx & 63) * 8;
        f32x4 a0 = *(const f32x4*)(cbias + c0), a1 = *(const f32x4*)(cbias + c0 + 4);
        v4u w[4];
#pragma unroll
        for (int k = 0; k < 4; ++k) { const int tr = t0 + tt - 3 + k; w[k] = *(const v4u*)(P + (m0 + (tr >= 0 ? tt - 3 + k : -t0)) * PW + PC_X + c0); }
#pragma unroll
        for (int k = 0; k < 4; ++k) { const float ok = (t0 + tt - 3 + k >= 0) ? 1.f : 0.f;
            const f32x4 w0 = *(const f32x4*)(cw + k * DLRU + c0) * ok, w1 = *(const f32x4*)(cw + k * DLRU + c0 + 4) * ok;
            a0[0] += w0[0] * bflo(w[k].x); a0[1] += w0[1] * bfhi(w[k].x); a0[2] += w0[2] * bflo(w[k].y); a0[3] += w0[3] * bfhi(w[k].y);
            a1[0] += w1[0] * bflo(w[k].z); a1[1] += w1[1] * bfhi(w[k].z); a1[2] += w1[2] * bflo(w[k].w); a1[3] += w1[3] * bfhi(w[k].w);
        }
        *(LAS f32x4*)(XF + tt * DLRU + c0) = a0; *(LAS f32x4*)(XF + tt * DLRU + c0 + 4) = a1;
        v4u hw; hw.x = pk2(a0[0], a0[1]); hw.y = pk2(a0[2], a0[3]); hw.z = pk2(a1[0], a1[1]); hw.w = pk2(a1[2], a1[3]);
        *(LAS v4u*)(XH + tt * LRU_XH_PITCH + c0 * 2) = hw;
    }
    __syncthreads();
    LT1(5); LT0(6);
    f32x16 acc[2][2];
#pragma unroll
    for (int ga = 0; ga < 2; ++ga)
#pragma unroll
        for (int nt = 0; nt < 2; ++nt)
#pragma unroll
            for (int r = 0; r < 16; ++r) acc[ga][nt][r] = 0.f;
#pragma unroll
    for (int ks = 0; ks < 8; ++ks) {
        const bf16x8 A = *(const LAS bf16x8*)(XH + j * LRU_XH_PITCH + (128 * g + 16 * ks + 8 * hi) * 2);
#pragma unroll
        for (int ga = 0; ga < 2; ++ga)
#pragma unroll
            for (int nt = 0; nt < 2; ++nt) {
                const bf16x8 Bf = *(const bf16x8*)(WG + ((size_t)((((ga * 4 + g) * 2 + (wid & 1)) * 2 + nt) * 8 + ks) * 64 + lane) * 8);
                acc[ga][nt] = __builtin_amdgcn_mfma_f32_32x32x16_bf16(A, Bf, acc[ga][nt], 0, 0, 0);
            }
    }
    if (DIAG_REGION == 6 || DIAG_REGION == 7) asm volatile("s_waitcnt vmcnt(0) lgkmcnt(0)" ::: "memory");
    LT1(6); LT0(7);
#pragma unroll
    for (int nt = 0; nt < 2; ++nt) {
        const int c = cwv + 32 * nt + j;
        const float ba = b_a[c], bx = b_x[c], nl = -lam[c], sp = nl > 20.f ? nl : pg8::log1p_small(__expf(nl));
#pragma unroll
        for (int r = 0; r < 16; ++r) { const int tt = (r & 3) + 8 * (r >> 2) + 4 * hi;
            const float xr = XF[tt * DLRU + c];
            const float rg = sigmoidf_(acc[0][nt][r] + ba), ig = sigmoidf_(acc[1][nt][r] + bx);
            const float la = -8.f * rg * sp, a = __expf(la), x2 = 2.f * la;
            const float ser = -x2 * (1.f + x2 * 0.5f * (1.f + x2 * (1.f / 3.f) * (1.f + x2 * 0.25f * (1.f + x2 * 0.2f * (1.f + x2 * (1.f / 6.f) * (1.f + x2 * (1.f / 7.f) * (1.f + x2 * 0.125f)))))));
            const float em = x2 < -0.5f ? 1.f - a * a : ser, mult = __builtin_amdgcn_sqrtf(em);
            acc[0][nt][r] = a; acc[1][nt][r] = mult * (ig * xr); }
        float Ae[4], He[4], pA[4], pH[4], cin[4], ain[4];
#pragma unroll
        for (int q = 0; q < 4; ++q) { float hl = 0.f, cA = 1.f;
#pragma unroll
            for (int e = 0; e < 4; ++e) { const int r = 4 * q + e; const float a = acc[0][nt][r], u = acc[1][nt][r]; hl = a * hl + u; cA *= a; acc[1][nt][r] = hl; acc[0][nt][r] = cA; }
            Ae[q] = cA; He[q] = hl; cin[q] = 0.f; ain[q] = 1.f; }
#pragma unroll
        for (int q = 0; q < 4; ++q) { pA[q] = pg8::other32(Ae[q], hi); pH[q] = pg8::other32(He[q], hi); }
        float carry = 0.f, Arun = 1.f;
#pragma unroll
        for (int G = 0; G < 8; ++G) { const int q = G >> 1; const bool mine = ((G & 1) == hi);
            const float Ag = mine ? Ae[q] : pA[q], Hg = mine ? He[q] : pH[q];
            cin[q] = mine ? carry : cin[q]; ain[q] = mine ? Arun : ain[q]; carry = Ag * carry + Hg; Arun *= Ag; }
#pragma unroll
        for (int r = 0; r < 16; ++r) { acc[1][nt][r] = acc[1][nt][r] + acc[0][nt][r] * cin[r >> 2]; acc[0][nt][r] = acc[0][nt][r] * ain[r >> 2]; }
        H64[nt] = Arun * H64[nt] + carry; A64[nt] *= Arun;
        if (sub == LCH / 32 - 1 && hi == 0) { f32x2 s; s.x = A64[nt]; s.y = H64[nt]; *(f32x2*)(CS + ((size_t)(b * NCH + ck) * DLRU + c) * 2) = s; }
    }
    __syncthreads();
    LT1(7); LT0(8);
    { LAS float* stg = XF + wid * 2048;
#pragma unroll
      for (int arr = 0; arr < 2; ++arr) {
#pragma unroll
        for (int nt = 0; nt < 2; ++nt)
#pragma unroll
            for (int r = 0; r < 16; ++r) stg[((r & 3) + 8 * (r >> 2) + 4 * hi) * 64 + 32 * nt + j] = acc[1 - arr][nt][r];
        LDS_WAIT(); asm volatile("" ::: "memory");
        bf16* dst = (bf16*)(arr == 0 ? HL : CA) + m0 * DLRU + cwv + (lane & 15) * 4;
#pragma unroll
        for (int i = 0; i < 8; ++i) { const int tt = (lane >> 4) + 4 * i; const f32x4 t4 = *(const LAS f32x4*)(stg + tt * 64 + (lane & 15) * 4);
            v2u o; o.x = pk2(t4[0], t4[1]); o.y = pk2(t4[2], t4[3]); *(v2u*)(dst + (size_t)tt * DLRU) = o; }
        LDS_WAIT(); asm volatile("" ::: "memory");
      } }
    __syncthreads();
    LT1(8);
    }
#undef LT0
#undef LT1
}

__device__ __forceinline__ void token_unit(int m, int lane, const bf16* P, const bf16* YA, const float* cw, bf16* Y, const float* HL, const float* CA, const LAS float* st) {
    const int t = m & (T - 1);
    const bf16* pr = P + (size_t)m * PW + 8 * lane;
    const v4u cb = *(const v4u*)(pr + PC_B), c0 = *(const v4u*)(pr + PC_C), v0 = *(const v4u*)(pr + PC_V);
    v4u c1 = {0u, 0u, 0u, 0u}, v1 = {0u, 0u, 0u, 0u}, c2 = {0u, 0u, 0u, 0u}, v2 = {0u, 0u, 0u, 0u};
    if (t >= 1) { c1 = *(const v4u*)(pr - PW + PC_C); v1 = *(const v4u*)(pr - PW + PC_V); }
    if (t >= 2) { c2 = *(const v4u*)(pr - 2 * PW + PC_C); v2 = *(const v4u*)(pr - 2 * PW + PC_V); }
    float y[8]; float s = 0.f;
#pragma unroll
    for (int e = 0; e < 4; ++e) {
        const int ch = 8 * lane + 2 * e;
        const float z0l = bflo(c0[e]) * bflo(v0[e]), z0h = bfhi(c0[e]) * bfhi(v0[e]);
        const float z1l = bflo(c1[e]) * bflo(v1[e]), z1h = bfhi(c1[e]) * bfhi(v1[e]);
        const float z2l = bflo(c2[e]) * bflo(v2[e]), z2h = bfhi(c2[e]) * bfhi(v2[e]);
        const f32x2 w0 = *(const f32x2*)(cw + ch), w1 = *(const f32x2*)(cw + DCONV + ch), w2 = *(const f32x2*)(cw + 2 * DCONV + ch);
        y[2 * e] = bflo(cb[e]) * (w0.x * z2l + w1.x * z1l + w2.x * z0l);
        y[2 * e + 1] = bfhi(cb[e]) * (w0.y * z2h + w1.y * z1h + w2.y * z0h);
        s += y[2 * e] * y[2 * e] + y[2 * e + 1] * y[2 * e + 1];
    }
    s = wave_sum(s);
    const float rsc = __builtin_amdgcn_rsqf(s * (1.f / DCONV) + EPS);
    v4u o; o.x = pk2(y[0] * rsc, y[1] * rsc); o.y = pk2(y[2] * rsc, y[3] * rsc); o.z = pk2(y[4] * rsc, y[5] * rsc); o.w = pk2(y[6] * rsc, y[7] * rsc);
    *(v4u*)(Y + (size_t)m * D + 8 * lane) = o;
    const v4u a0 = *(const v4u*)(YA + (size_t)m * DATT + 16 * lane), a1 = *(const v4u*)(YA + (size_t)m * DATT + 16 * lane + 8);
    float tot = 0.f;
#pragma unroll
    for (int e = 0; e < 4; ++e) { const float x0 = bflo(a0[e]), x1 = bfhi(a0[e]), x2 = bflo(a1[e]), x3 = bfhi(a1[e]); tot += (x0 * x0 + x1 * x1) + (x2 * x2 + x3 * x3); }
    tot = wave_sum(tot);
    const float rsa = __builtin_amdgcn_rsqf(tot * (1.f / DATT) + EPS);
    v4u q0, q1;
#pragma unroll
    for (int e = 0; e < 4; ++e) { q0[e] = pk2(bflo(a0[e]) * rsa, bfhi(a0[e]) * rsa); q1[e] = pk2(bflo(a1[e]) * rsa, bfhi(a1[e]) * rsa); }
    *(v4u*)(Y + (size_t)m * D + DCONV + 16 * lane) = q0; *(v4u*)(Y + (size_t)m * D + DCONV + 16 * lane + 8) = q1;
    { const f32x4 s0 = *(const LAS f32x4*)(st + 8 * lane), s1 = *(const LAS f32x4*)(st + 8 * lane + 4);
      const v4u hh = *(const v4u*)((const bf16*)HL + (size_t)m * DLRU + 8 * lane), aa = *(const v4u*)((const bf16*)CA + (size_t)m * DLRU + 8 * lane);
      const f32x4 h0 = {bflo(hh.x), bfhi(hh.x), bflo(hh.y), bfhi(hh.y)}, h1 = {bflo(hh.z), bfhi(hh.z), bflo(hh.w), bfhi(hh.w)};
      const f32x4 a0 = {bflo(aa.x), bfhi(aa.x), bflo(aa.y), bfhi(aa.y)}, a1 = {bflo(aa.z), bfhi(aa.z), bflo(aa.w), bfhi(aa.w)};
      const v4u gt = *(const v4u*)(pr + PC_G);
      float yl[8]; float sl = 0.f;
#pragma unroll
      for (int e = 0; e < 4; ++e) { const float hA = h0[e] + a0[e] * s0[e], hB = h1[e] + a1[e] * s1[e];
          const float gA = (e & 1) ? bfhi(gt[e >> 1]) : bflo(gt[e >> 1]), gB = (e & 1) ? bfhi(gt[2 + (e >> 1)]) : bflo(gt[2 + (e >> 1)]);
          yl[e] = gelu_tanh(gA) * hA; yl[4 + e] = gelu_tanh(gB) * hB; sl += yl[e] * yl[e] + yl[4 + e] * yl[4 + e]; }
      sl = wave_sum(sl);
      const float rsl = __builtin_amdgcn_rsqf(sl * (1.f / DLRU) + EPS);
      v4u ol; ol.x = pk2(yl[0] * rsl, yl[1] * rsl); ol.y = pk2(yl[2] * rsl, yl[3] * rsl); ol.z = pk2(yl[4] * rsl, yl[5] * rsl); ol.w = pk2(yl[6] * rsl, yl[7] * rsl);
      *(v4u*)(Y + (size_t)m * D + (DCONV + DATT) + 8 * lane) = ol; }
}

#ifndef DIAG_IDLE
#define DIAG_IDLE 0
#endif
#ifndef DIAG_XCDSKEW
#define DIAG_XCDSKEW 0
#endif
#ifndef DIAG_CLOCK
#define DIAG_CLOCK 0
#endif
#ifndef LAYER_UNROLL
#define LAYER_UNROLL 0
#endif
#ifndef DIAG_KMIN
#define DIAG_KMIN 1
#endif
#ifndef DIAG_BARTIME
#define DIAG_BARTIME 0
#endif
#ifndef DIAG_REGION
#define DIAG_REGION 0
#endif
#define RT0(r) do { if (DIAG_REGION == (r) && xb_thread0(wave_s)) MISC[19] = (unsigned)__builtin_amdgcn_s_memrealtime(); } while (0)
#define RT1(r) do { if (DIAG_REGION == (r) && xb_thread0(wave_s)) MISC[18] += (unsigned)__builtin_amdgcn_s_memrealtime() - MISC[19]; } while (0)
#ifndef DIAG_MASK
#define DIAG_MASK 0xff
#endif
#ifndef DIAG_SCALE
#define DIAG_SCALE 1.0f
#endif
#ifndef PG8_SP2
#define PG8_SP2 true
#endif
#ifndef PG8_ALIGN
#define PG8_ALIGN true
#endif
#ifndef REP_G2
#define REP_G2 1
#endif
#ifndef REP_G4
#define REP_G4 1
#endif
#ifndef REP_G6
#define REP_G6 1
#endif
#ifndef REP_P0
#define REP_P0 1
#endif
#ifndef REP_G1
#define REP_G1 1
#endif
#ifndef REP_G3
#define REP_G3 1
#endif
#ifndef REP_X1
#define REP_X1 1
#endif
#ifndef REP_X2
#define REP_X2 1
#endif
#ifndef EN_ALL
#define EN_ALL 1
#endif
#ifndef EN_P0
#define EN_P0 EN_ALL
#endif
#ifndef EN_G1
#define EN_G1 EN_ALL
#endif
#ifndef EN_G2
#define EN_G2 EN_ALL
#endif
#ifndef EN_G3
#define EN_G3 EN_ALL
#endif
#ifndef EN_X1
#define EN_X1 EN_ALL
#endif
#ifndef EN_X2
#define EN_X2 EN_ALL
#endif
#ifndef EN_G4
#define EN_G4 EN_ALL
#endif
#ifndef EN_G5
#define EN_G5 EN_ALL
#endif
#ifndef EN_G6
#define EN_G6 EN_ALL
#endif
#ifndef EN_ATT
#define EN_ATT 1
#endif
#ifndef EN_LRU
#define EN_LRU 1
#endif
#ifndef ATT_ONESITE
#define ATT_ONESITE 1
#endif
#ifndef EN_FN
#define EN_FN EN_ALL
#endif
#ifndef MK_SINGLE
#define MK_SINGLE 1
#endif
struct Args { const float* in[21]; float* out; unsigned char* ws; int ph_lo, ph_hi; };
typedef const __attribute__((address_space(4))) Args* CArgs;
__device__ __forceinline__ CArgs oargs(CArgs p) { asm volatile("" : "+s"(p)); return p; }
template <class T> __device__ __forceinline__ T* asglobal(T* p) { return (T*)(__attribute__((address_space(1))) T*)p; }
#define WSP(T, off) ((T*)(ws + (off)))
__global__ void __launch_bounds__(NWAVES * 64, 2) hymba_fwd(Args args_unused) {
    extern __shared__ __attribute__((aligned(16))) unsigned char lds_raw[];
    LAS unsigned char* lds = (LAS unsigned char*)lds_raw;
    volatile LAS unsigned* MISC = (volatile LAS unsigned*)(lds + MISC_OFF);
    const CArgs ap = (CArgs)__builtin_amdgcn_kernarg_segment_ptr();
    const int G0 = gridDim.x, bid0 = blockIdx.x;
    const int wave_s = __builtin_amdgcn_readfirstlane(threadIdx.x >> 6);
    { const int tid = pg8::otid(wave_s); for (int u = tid; u < (LDS_BYTES - LDSCTL_OFF) / 4; u += NWAVES * 64) ((LAS unsigned*)(lds + LDSCTL_OFF))[u] = 0u; }
    __syncthreads();
#if MK_SINGLE
    constexpr int lo = 0, hi = N_PHASES;
#else
    const int lo = ap->ph_lo, hi = ap->ph_hi;
#endif
    XcdBarrier bar; bar.bar = (unsigned*)(asglobal(ap->ws) + WS_CTL) + CW_BAR; bar.x = 0; bar.st = nullptr; bar.w = wave_s; bar.np = (unsigned)G0;
    if (hi - lo > 1) bar = xcd_barrier_post((unsigned*)(asglobal(ap->ws) + WS_CTL) + CW_BAR, MISC + 8, wave_s, (unsigned)G0);
#define IN(k) (lo <= (k) && (k) < hi)
#define MY_PANEL() pg8::StaticOrder Sp_; Sp_.init(M, D, G, bid); pg8::Unit up_; up_.pm = 0; up_.pn = 0; Sp_.next(0, up_); const int pmine = up_.pm, prank = up_.pn; (void)pmine; (void)prank
    if (xb_thread0(wave_s)) { int G = G0, bid = bid0; MY_PANEL(); (void)__hip_atomic_fetch_or((unsigned*)(asglobal(ap->ws) + WS_CTL) + CW_PMASK + 64 * pmine, 1u << (xb_xcc_id() & 15u), __ATOMIC_RELAXED, __HIP_MEMORY_SCOPE_AGENT); }
    int npb = 0;
    { int G = G0, bid = bid0; MY_PANEL(); (void)xcd_barrier_post((unsigned*)(asglobal(ap->ws) + WS_CTL) + CW_BAR2 + 4096 * (pmine >> 4), MISC + 10, wave_s, 64u); }
#define SEAM_B(k) do { if (IN((k) + 1)) { int G = G0, bid = bid0; asm volatile("" : "+s"(G), "+s"(bid)); MY_PANEL(); XcdBarrier bb_; bb_.np = 64u; bb_.bar = (unsigned*)(asglobal(oargs(ap)->ws) + WS_CTL) + CW_BAR2 + 4096 * (pmine >> 4); bb_.x = xb_xcc_id(); bb_.w = wave_s; bb_.st = MISC + 10; xcd_barrier(bb_); } } while (0)
#if DIAG_BARTIME || DIAG_XCDSKEW
#define SEAM(k) do { if (IN((k) + 1)) { if (xb_thread0(wave_s)) MISC[17] = (unsigned)__builtin_amdgcn_s_memrealtime(); xcd_barrier(bar); \
        if (xb_thread0(wave_s) && (k) >= DIAG_KMIN && DIAG_BARTIME == 1) MISC[16] += (unsigned)__builtin_amdgcn_s_memrealtime() - MISC[17]; } } while (0)
#elif DIAG_IDLE
#define SEAM(k) do { if (IN((k) + 1)) { const unsigned long long t0_ = __builtin_amdgcn_s_memrealtime(); while (__builtin_amdgcn_s_memrealtime() - t0_ < (unsigned long long)DIAG_IDLE) __builtin_amdgcn_s_sleep(16); xcd_barrier(bar); } } while (0)
#else
#define SEAM(k) do { if (IN((k) + 1)) xcd_barrier(bar); } while (0)
#endif
#define SEAM_P(k) do { if (IN((k) + 1)) { int G = G0, bid = bid0; asm volatile("" : "+s"(G), "+s"(bid)); MY_PANEL(); ++npb; if (DIAG_BARTIME == 2 && xb_thread0(wave_s)) MISC[17] = (unsigned)__builtin_amdgcn_s_memrealtime(); panel_barrier((unsigned*)(asglobal(oargs(ap)->ws) + WS_CTL), pmine, (unsigned)(NOWN * npb), MISC, wave_s); if (DIAG_BARTIME == 2 && xb_thread0(wave_s)) MISC[16] += (unsigned)__builtin_amdgcn_s_memrealtime() - MISC[17]; } } while (0)
#define PHASE_ENTRY() int G = G0, bid = bid0; asm volatile("" : "+s"(G), "+s"(bid)); const CArgs a = oargs(ap); unsigned char* const ws = asglobal(a->ws); const int tid = pg8::otid(wave_s), lane = tid & 63, wave = wave_s; \
        const int gw = bid * NWAVES + wave, NGW = G * NWAVES; (void)lane; (void)gw; (void)NGW; (void)ws; (void)G; (void)bid
    const LAS float* rs_lds = (const LAS float*)(lds + RS_OFF);

    if (EN_P0 && IN(0))
_Pragma("nounroll") for (int rep_ = 0; rep_ < REP_P0; ++rep_) {
        PHASE_ENTRY();
        LAS unsigned* scr = (LAS unsigned*)(lds + RING_OFF + wave * 8192);
        RT0(9);
        {
            for (int sidx = bid; sidx < 2 * DEPTH * (NFF / 64); sidx += G) { const int mat = sidx / (NFF / 64), strip = sidx % (NFF / 64), f = mat / DEPTH, lw = mat % DEPTH;
                w1_strip((f ? asglobal(a->in[18]) : asglobal(a->in[2])) + (size_t)lw * D * NFF, (f ? asglobal(a->in[17]) : asglobal(a->in[1])) + lw * D,
                         WSP(unsigned char, WS_W1Q) + (size_t)mat * SZ_W1Q, WSP(float, WS_SW) + (size_t)mat * NFF, strip, lds, wave, tid, lane); }
            for (int sidx = bid; sidx < 2 * DEPTH * (D / 16); sidx += G) { const int mat = sidx / (D / 16), strip = sidx % (D / 16), f = mat / DEPTH, lw = mat % DEPTH;
                w2_strip((f ? asglobal(a->in[19]) : asglobal(a->in[3])) + (size_t)lw * FF * D, WSP(unsigned char, WS_W2Q) + (size_t)mat * D * FF, WSP(float, WS_SW2) + (size_t)mat * D, strip, lds, wave, tid, lane); }
            __syncthreads();
        }
        for (int l = 0; l < DEPTH; ++l) {
            tr_matrix<2>(asglobal(a->in[5]) + (size_t)l * D * DIN, D, DIN, asglobal(a->in[4]) + l * D, WSP(bf16, WS_WM + (size_t)l * SZ_WM), NMIX, scr, gw, NGW, lane);
            tr_matrix<0>(asglobal(a->in[16]) + (size_t)l * D * D, D, D, asglobal(a->in[15]) + l * D, WSP(bf16, WS_WO + (size_t)l * SZ_WO), D, scr, gw, NGW, lane);
        }
        {
            v4u* dst = (v4u*)WSP(bf16, WS_WGF);
            for (int pc = gw * 64 + lane; pc < DEPTH * 8 * 2048; pc += NGW * 64) { const int lm = pc >> 11, l2 = lm >> 3, mat = lm & 7, ga = mat >> 2, g = mat & 3, d = pc & 2047, ln = d & 63, ks = (d >> 6) & 7, nt = (d >> 9) & 1, hf = (d >> 10) & 1;
                const float* sp = (ga ? asglobal(a->in[12]) : asglobal(a->in[10])) + ((size_t)(l2 * 4 + g) * 128 + 16 * ks + 8 * (ln >> 5)) * 128 + 64 * hf + 32 * nt + (ln & 31);
                v4u o;
#pragma unroll
                for (int e = 0; e < 4; ++e) o[e] = pk2(sp[(2 * e) * 128], sp[(2 * e + 1) * 128]);
                dst[pc] = o; }
        }
        RT1(9); RT0(10);
        const float* xin = asglobal(a->in[0]); bf16* XB = WSP(bf16, WS_XB); float* SS = WSP(float, WS_SS);
        for (int m = gw; m < M; m += NGW) {
            const GAS f32x4* xr = (const GAS f32x4*)(xin + (size_t)m * D) + lane; float s = 0.f, mx = 0.f;
            GAS v2u* o8 = (GAS v2u*)(XB + (size_t)m * D) + lane; GAS unsigned* l8 = (GAS unsigned*)(WSP(unsigned char, WS_XL) + (size_t)m * D) + lane;
            v2u wq[8];
#pragma unroll
            for (int jj = 0; jj < 8; ++jj) { const f32x4 v = xr[64 * jj]; s += (v[0] * v[0] + v[1] * v[1]) + (v[2] * v[2] + v[3] * v[3]);
                v2u w;
                if (RES_LO == 2) { const unsigned u0 = __float_as_uint(v[0]) + 0x80u, u1 = __float_as_uint(v[1]) + 0x80u, u2 = __float_as_uint(v[2]) + 0x80u, u3 = __float_as_uint(v[3]) + 0x80u;
                    w.x = __builtin_amdgcn_perm(u1, u0, 0x07060302u); w.y = __builtin_amdgcn_perm(u3, u2, 0x07060302u); o8[64 * jj] = w;
                    l8[64 * jj] = __builtin_amdgcn_perm(__builtin_amdgcn_perm(u3, u2, 0x0c0c0501u), __builtin_amdgcn_perm(u1, u0, 0x0c0c0501u), 0x05040100u); }
                else { w.x = pk2(v[0], v[1]); w.y = pk2(v[2], v[3]); o8[64 * jj] = w;
                if (RES_LO == 1) l8[64 * jj] = ((unsigned)pg8::res_enc(v[0], w.x & 0xffffu) & 0xffu) | (((unsigned)pg8::res_enc(v[1], w.x >> 16) & 0xffu) << 8)
                            | (((unsigned)pg8::res_enc(v[2], w.y & 0xffffu) & 0xffu) << 16) | (((unsigned)pg8::res_enc(v[3], w.y >> 16) & 0xffu) << 24); }
                wq[jj] = w; mx = fmaxf(mx, fmaxf(fmaxf(fabsf(bflo(w.x)), fabsf(bfhi(w.x))), fmaxf(fabsf(bflo(w.y)), fabsf(bfhi(w.y))))); }
            s = wave_sum(s);
            mx = fmaxf(mx, pg8::sx<1>(mx)); mx = fmaxf(mx, pg8::sx<2>(mx)); mx = fmaxf(mx, pg8::sx<4>(mx)); mx = fmaxf(mx, pg8::sx<8>(mx)); mx = fmaxf(mx, pg8::sx<16>(mx));
            { auto rr = __builtin_amdgcn_permlane32_swap(__float_as_uint(mx), __float_as_uint(mx), false, false); mx = fmaxf(__uint_as_float(rr[0]), __uint_as_float(rr[1])); }
            const float inv = mx > 0.f ? 127.f / mx : 0.f;
            GAS unsigned* q8 = (GAS unsigned*)(WSP(unsigned char, WS_Q8) + (size_t)m * D) + lane;
#pragma unroll
            for (int jj = 0; jj < 8; ++jj)
                q8[64 * jj] = ((unsigned)(int)__builtin_rintf(bflo(wq[jj].x) * inv) & 0xffu) | (((unsigned)(int)__builtin_rintf(bfhi(wq[jj].x) * inv) & 0xffu) << 8)
                            | (((unsigned)(int)__builtin_rintf(bflo(wq[jj].y) * inv) & 0xffu) << 16) | (((unsigned)(int)__builtin_rintf(bfhi(wq[jj].y) * inv) & 0xffu) << 24);
            if (lane < 32) SS[(size_t)m * 32 + lane] = (lane == 0) ? s : 0.f;
            if (lane == 0) WSP(float, WS_RSA)[m] = __builtin_amdgcn_rsqf(s * (1.f / D) + EPS) * mx * (1.f / 127.f);
        }
        RT1(10);
        SEAM(0);
        if (xb_thread0(wave_s)) { MY_PANEL(); const unsigned mk = xb_ld((unsigned*)(ws + WS_CTL) + CW_PMASK + 64 * pmine); MISC[12] = (mk != 0u && (mk & (mk - 1u)) == 0u) ? 1u : 0u; }
    }

#if LAYER_UNROLL
#pragma clang loop unroll(full)
#else
#pragma nounroll
#endif
    for (int l = 0; l < DEPTH; ++l) {
        const int pb = 1 + 12 * l;
        if (EN_G1 && IN(pb + 0)) {
            PHASE_ENTRY();
            if (l > 0 || !IN(0)) {
            MY_PANEL(); const int r0 = pmine * 256 + prank * 64 + wave;
            const bf16* XBp = WSP(bf16, WS_XB); const unsigned char* XLp = WSP(unsigned char, WS_XL); unsigned char* Q8p = WSP(unsigned char, WS_Q8); float* RSAp = WSP(float, WS_RSA);
            v4u hA[4], lA[2], hB[4], lB[2];
            quant_xrow_load(hA, lA, XBp + (size_t)r0 * D, XLp + (size_t)r0 * D, lane);
#pragma unroll
            for (int i = 0; i < 8; i += 2) { const int ma = r0 + 8 * i, mb = ma + 8;
                quant_xrow_load(hB, lB, XBp + (size_t)mb * D, XLp + (size_t)mb * D, lane);
                quant_xrow(hA, lA, Q8p + (size_t)ma * D, RSAp + ma, lane);
                if (i + 2 < 8) quant_xrow_load(hA, lA, XBp + (size_t)(mb + 8) * D, XLp + (size_t)(mb + 8) * D, lane);
                quant_xrow(hB, lB, Q8p + (size_t)mb * D, RSAp + mb, lane); }
            }
            SEAM_P(pb + 0);
        }
        if (EN_G1 && IN(pb + 1))
_Pragma("nounroll") for (int rep_ = 0; rep_ < REP_G1; ++rep_) {
            PHASE_ENTRY();
            pg8::StaticOrder S; S.init(M, NFF, G, bid); pg8::Unit u0; u0.pm = 0; u0.pn = 0; S.next(0, u0); load_rsa(lds, u0.pm, WSP(float, WS_RSA), wave_s);
            pg8::Gemm g{WSP(bf16, WS_Q8), WSP(bf16, WS_W1Q + (size_t)(0 * DEPTH + l) * SZ_W1Q), M, NFF, D / 2}; pg8::EpiSwiGLUq E{WSP(unsigned char, WS_HQ), FF, rs_lds, WSP(float, WS_SW) + (0 * DEPTH + l) * NFF, WSP(float, WS_BS)};
            pg8::gemm_phase<pg8::EpiSwiGLUq, pg8::StaticOrder, PG8_ALIGN, PG8_SP2>(lds + RING_OFF, g, S, E, wave_s);
            SEAM_P(pb + 1);
        }
        if (EN_G2 && IN(pb + 2)) {
            PHASE_ENTRY();
            MY_PANEL(); const int r0 = pmine * 256 + prank * 64 + wave;
            unsigned char* HQp = WSP(unsigned char, WS_HQ); const float* BSp = WSP(float, WS_BS); float* SHp = WSP(float, WS_SH);
            v2u wA[NPC], wB[NPC]; float sA[NPC], sB[NPC];
            requant_row_load(wA, sA, HQp + (size_t)r0 * FF, BSp + (size_t)r0 * (FF / 32), lane);
#pragma unroll
            for (int i = 0; i < 8; i += 2) { const int ma = r0 + 8 * i, mb = ma + 8;
                requant_row_load(wB, sB, HQp + (size_t)mb * FF, BSp + (size_t)mb * (FF / 32), lane);
                requant_row_blocks(wA, sA, HQp + (size_t)ma * FF, SHp + ma, lane);
                if (i + 2 < 8) requant_row_load(wA, sA, HQp + (size_t)(mb + 8) * FF, BSp + (size_t)(mb + 8) * (FF / 32), lane);
                requant_row_blocks(wB, sB, HQp + (size_t)mb * FF, SHp + mb, lane); }
            SEAM_P(pb + 2);
        }
        if (EN_G2 && IN(pb + 3))
_Pragma("nounroll") for (int rep_ = 0; rep_ < REP_G2; ++rep_) {
            PHASE_ENTRY();
            pg8::StaticOrder S; S.init(M, D, G, bid); pg8::Unit u0; u0.pm = 0; u0.pn = 0; S.next(0, u0); load_rsa(lds, u0.pm, WSP(float, WS_SH), wave_s);
            pg8::Gemm g{WSP(bf16, WS_HQ), WSP(bf16, WS_W2Q + (size_t)(0 * DEPTH + l) * D * FF), M, D, FF / 2}; pg8::EpiRes<true> E{WSP(bf16, WS_XB), WSP(unsigned char, WS_XL), WSP(float, WS_SS), rep_ == REP_G2 - 1 ? 0.5f : 0.f, rs_lds, WSP(float, WS_SW2) + (0 * DEPTH + l) * D, true, true};
            pg8::gemm_phase<pg8::EpiRes<true>, pg8::StaticOrder, PG8_ALIGN, PG8_SP2>(lds + RING_OFF, g, S, E, wave_s);
            SEAM_P(pb + 3);
        }
        if (EN_G3 && IN(pb + 4))
_Pragma("nounroll") for (int rep_ = 0; rep_ < REP_G3; ++rep_) {
            PHASE_ENTRY();
            pg8::StaticOrder S; S.init(M, NMIX, G, bid); pg8::Unit u0; u0.pm = 0; u0.pn = 0; S.next(0, u0); compute_rs(lds, u0.pm, WSP(float, WS_SS), wave_s);
            pg8::Gemm g{WSP(bf16, WS_XB), WSP(bf16, WS_WM + (size_t)l * SZ_WM), M, NMIX, D}; pg8::EpiMix<false> E{WSP(bf16, WS_P - (size_t)(l & 1) * SZ_P), PW, rs_lds, WSP(float, WS_F), asglobal(a->in[7]) + l * NH, nullptr, WSP(float, WS_KN)};
            pg8::gemm_phase<pg8::EpiMix<false>, pg8::StaticOrder, PG8_ALIGN, PG8_SP2>(lds + RING_OFF, g, S, E, wave_s);
            SEAM_B(pb + 4);
        }
        if (EN_X1 && IN(pb + 5))
_Pragma("nounroll") for (int rep_ = 0; rep_ < REP_X1; ++rep_) {
            PHASE_ENTRY();
            const bf16* P = WSP(bf16, WS_P - (size_t)(l & 1) * SZ_P);
            RT0(1);
            MY_PANEL();
            if (EN_ATT) for (int once_ = 0; once_ < 1; ++once_) {
                const int wb = (pmine & 15) * NOWN + prank, b = pmine >> 4;
                unsigned* const qc = (unsigned*)(ws + WS_CTL) + CW_ATQ + (size_t)(l * BATCH + b) * 64;
                int cur_h = -1, h = wb & 7, qb = 15 - (wb >> 3); float kmax2 = 0.f;
#pragma nounroll
                for (;;) {
                    if (h != cur_h) { kmax2 = att::fill_table(WSP(float, WS_F) + (size_t)(b * 8 + h) * T, WSP(float, WS_KN) + (size_t)(b * 8 + h) * 4 * T, (char*)lds_raw + RING_OFF, wave_s); cur_h = h; }
                    const bf16* Pb = P + (size_t)b * T * PW + h * HD;
                    att::BlockRef r; r.P0 = qb * 256;
                    r.K = Pb + PC_K; r.V = Pb + PC_VV; r.Q = Pb + PC_Q + (size_t)r.P0 * PW;
                    r.O = WSP(bf16, WS_YA) + ((size_t)b * T + r.P0) * DATT + h * HD;
                    att::block_pp(r, (char*)lds_raw + RING_OFF, wave_s, kmax2, qc, MISC + 13);
                    const int idx = (int)MISC[13];
                    if (idx >= 64) break;
                    h = idx & 7; qb = 7 - (idx >> 3);
                }
                VM_WAIT(); __syncthreads();
            }
            RT1(1); RT0(2);
            if (EN_LRU) for (int u = NOWN * pmine + prank, once_ = 0; once_ < 1; ++once_)
                lru_unit(lds + RING_OFF, u / NCH, u % NCH, P, asglobal(a->in[8]) + l * 4 * DLRU, asglobal(a->in[9]) + l * DLRU, WSP(bf16, WS_WGF + (size_t)l * SZ_WG), asglobal(a->in[11]) + l * DLRU, asglobal(a->in[13]) + l * DLRU, asglobal(a->in[14]) + l * DLRU, WSP(float, WS_CS), WSP(float, WS_HL), WSP(float, WS_CA), wave_s);
            RT1(2);
            SEAM_B(pb + 5);
        }
        if (EN_X2 && IN(pb + 6))
_Pragma("nounroll") for (int rep_ = 0; rep_ < REP_X2; ++rep_) {
            PHASE_ENTRY();
            const bf16* P = WSP(bf16, WS_P - (size_t)(l & 1) * SZ_P);
            RT0(3);
            MY_PANEL();
            for (int u = NOWN * pmine + prank, once_ = 0; once_ < 1; ++once_) {
                const int b = u / NCH, ck = u % NCH; const size_t mc = (size_t)b * T + (size_t)ck * LCH;
                LAS float* st = (LAS float*)(lds + RING_OFF);
                const float* HLp = WSP(float, WS_HL); const float* CAp = WSP(float, WS_CA);
                { const int c = 64 * wave + lane; const f32x2* csp = (const f32x2*)WSP(float, WS_CS) + (size_t)b * NCH * DLRU + c; float h0 = 0.f; int k = 0;
                  for (; k + 16 <= ck; k += 16) { f32x2 sv[16];
#pragma unroll
                      for (int i = 0; i < 16; ++i) sv[i] = csp[(size_t)(k + i) * DLRU];
#pragma unroll
                      for (int i = 0; i < 16; ++i) h0 = sv[i].x * h0 + sv[i].y; }
                  for (; k < ck; ++k) { const f32x2 sv = csp[(size_t)k * DLRU]; h0 = sv.x * h0 + sv.y; }
                  st[c] = h0; st[512 + c] = bf1(((const bf16*)CAp)[(mc + 31) * DLRU + c]) * h0 + bf1(((const bf16*)HLp)[(mc + 31) * DLRU + c]); }
                __syncthreads();
                RT1(3); RT0(4);
#pragma nounroll
                for (int i = 0; i < 8; i += 2) {
                    token_unit((int)mc + 8 * wave + i, lane, P, WSP(bf16, WS_YA), asglobal(a->in[6]) + l * 3 * DCONV, WSP(bf16, WS_Y), HLp, CAp, st + 512 * (wave >> 2));
                    token_unit((int)mc + 8 * wave + i + 1, lane, P, WSP(bf16, WS_YA), asglobal(a->in[6]) + l * 3 * DCONV, WSP(bf16, WS_Y), HLp, CAp, st + 512 * (wave >> 2)); }
                __syncthreads();
            }
            RT1(4);
            SEAM_P(pb + 6);
        }
        if (EN_G4 && IN(pb + 7))
_Pragma("nounroll") for (int rep_ = 0; rep_ < REP_G4; ++rep_) {
            PHASE_ENTRY();
            pg8::StaticOrder S; S.init(M, D, G, bid);
            pg8::Gemm g{WSP(bf16, WS_Y), WSP(bf16, WS_WO + (size_t)l * SZ_WO), M, D, D}; pg8::EpiRes<false> E{WSP(bf16, WS_XB), WSP(unsigned char, WS_XL), WSP(float, WS_SS), rep_ == REP_G4 - 1 ? 1.0f : 0.f, nullptr, nullptr, true, true};
            pg8::gemm_phase<pg8::EpiRes<false>, pg8::StaticOrder, PG8_ALIGN, PG8_SP2>(lds + RING_OFF, g, S, E, wave_s);
            SEAM_P(pb + 7);
        }
        if (EN_G5 && IN(pb + 8)) {
            PHASE_ENTRY();
            MY_PANEL(); const int r0 = pmine * 256 + prank * 64 + wave;
            const bf16* XBp = WSP(bf16, WS_XB); const unsigned char* XLp = WSP(unsigned char, WS_XL); unsigned char* Q8p = WSP(unsigned char, WS_Q8); float* RSAp = WSP(float, WS_RSA);
            v4u hA[4], lA[2], hB[4], lB[2];
            quant_xrow_load(hA, lA, XBp + (size_t)r0 * D, XLp + (size_t)r0 * D, lane);
#pragma unroll
            for (int i = 0; i < 8; i += 2) { const int ma = r0 + 8 * i, mb = ma + 8;
                quant_xrow_load(hB, lB, XBp + (size_t)mb * D, XLp + (size_t)mb * D, lane);
                quant_xrow(hA, lA, Q8p + (size_t)ma * D, RSAp + ma, lane);
                if (i + 2 < 8) quant_xrow_load(hA, lA, XBp + (size_t)(mb + 8) * D, XLp + (size_t)(mb + 8) * D, lane);
                quant_xrow(hB, lB, Q8p + (size_t)mb * D, RSAp + mb, lane); }
            SEAM_P(pb + 8);
        }
        if (EN_G5 && IN(pb + 9)) {
            PHASE_ENTRY();
            pg8::StaticOrder S; S.init(M, NFF, G, bid); pg8::Unit u0; u0.pm = 0; u0.pn = 0; S.next(0, u0); load_rsa(lds, u0.pm, WSP(float, WS_RSA), wave_s);
            pg8::Gemm g{WSP(bf16, WS_Q8), WSP(bf16, WS_W1Q + (size_t)(1 * DEPTH + l) * SZ_W1Q), M, NFF, D / 2}; pg8::EpiSwiGLUq E{WSP(unsigned char, WS_HQ), FF, rs_lds, WSP(float, WS_SW) + (1 * DEPTH + l) * NFF, WSP(float, WS_BS)};
            pg8::gemm_phase<pg8::EpiSwiGLUq, pg8::StaticOrder, PG8_ALIGN, PG8_SP2>(lds + RING_OFF, g, S, E, wave_s);
            SEAM_P(pb + 9);
        }
        if (EN_G6 && IN(pb + 10)) {
            PHASE_ENTRY();
            MY_PANEL(); const int r0 = pmine * 256 + prank * 64 + wave;
            unsigned char* HQp = WSP(unsigned char, WS_HQ); const float* BSp = WSP(float, WS_BS); float* SHp = WSP(float, WS_SH);
            v2u wA[NPC], wB[NPC]; float sA[NPC], sB[NPC];
            requant_row_load(wA, sA, HQp + (size_t)r0 * FF, BSp + (size_t)r0 * (FF / 32), lane);
#pragma unroll
            for (int i = 0; i < 8; i += 2) { const int ma = r0 + 8 * i, mb = ma + 8;
                requant_row_load(wB, sB, HQp + (size_t)mb * FF, BSp + (size_t)mb * (FF / 32), lane);
                requant_row_blocks(wA, sA, HQp + (size_t)ma * FF, SHp + ma, lane);
                if (i + 2 < 8) requant_row_load(wA, sA, HQp + (size_t)(mb + 8) * FF, BSp + (size_t)(mb + 8) * (FF / 32), lane);
                requant_row_blocks(wB, sB, HQp + (size_t)mb * FF, SHp + mb, lane); }
            SEAM_P(pb + 10);
        }
        if (EN_G6 && IN(pb + 11))
_Pragma("nounroll") for (int rep_ = 0; rep_ < REP_G6; ++rep_) {
            PHASE_ENTRY();
            pg8::StaticOrder S; S.init(M, D, G, bid); pg8::Unit u0; u0.pm = 0; u0.pn = 0; S.next(0, u0); load_rsa(lds, u0.pm, WSP(float, WS_SH), wave_s);
            pg8::Gemm g{WSP(bf16, WS_HQ), WSP(bf16, WS_W2Q + (size_t)(1 * DEPTH + l) * D * FF), M, D, FF / 2}; pg8::EpiRes<true> E{WSP(bf16, WS_XB), WSP(unsigned char, WS_XL), WSP(float, WS_SS), rep_ == REP_G6 - 1 ? 0.5f : 0.f, rs_lds, WSP(float, WS_SW2) + (1 * DEPTH + l) * D, true, l != DEPTH - 1};
            pg8::gemm_phase<pg8::EpiRes<true>, pg8::StaticOrder, PG8_ALIGN, PG8_SP2>(lds + RING_OFF, g, S, E, wave_s);
            SEAM_P(pb + 11);
        }
    }
    if (EN_FN && IN(N_PHASES - 1)) {
        PHASE_ENTRY();
        const float* gfin = asglobal(a->in[20]); float* X = asglobal(a->out); const float* SS = WSP(float, WS_SS);
        MY_PANEL();
        for (int m = pmine * 256 + prank * 64 + wave; m < pmine * 256 + prank * 64 + 64; m += NWAVES) {
            float s = lane < 32 ? SS[(size_t)m * 32 + lane] : 0.f; s = wave_sum(s);
            const float rsn = __builtin_amdgcn_rsqf(s * (1.f / D) + EPS);
            GAS f32x4* xr = (GAS f32x4*)(X + (size_t)m * D) + lane; const GAS f32x4* gr = (const GAS f32x4*)gfin + lane;
            const GAS v2u* h8 = (const GAS v2u*)(WSP(bf16, WS_XB) + (size_t)m * D) + lane; const GAS unsigned* l8 = (const GAS unsigned*)(WSP(unsigned char, WS_XL) + (size_t)m * D) + lane;
#pragma unroll
            for (int jj = 0; jj < 8; ++jj) { const v2u h = h8[64 * jj]; const unsigned lq = 0u; (void)l8;                                 const f32x4 gg = gr[64 * jj];
                f32x4 v;
                if (RES_LO == 2) { v[0] = __uint_as_float(__builtin_amdgcn_perm(h.x, lq, 0x0504000cu)); v[1] = __uint_as_float(__builtin_amdgcn_perm(h.x, lq, 0x0706010cu));
                                   v[2] = __uint_as_float(__builtin_amdgcn_perm(h.y, lq, 0x0504020cu)); v[3] = __uint_as_float(__builtin_amdgcn_perm(h.y, lq, 0x0706030cu)); }
                else { v[0] = pg8::res_dec(h.x & 0xffffu, (int)(lq << 24) >> 24); v[1] = pg8::res_dec(h.x >> 16, (int)(lq << 16) >> 24);
                v[2] = pg8::res_dec(h.y & 0xffffu, (int)(lq << 8) >> 24); v[3] = pg8::res_dec(h.y >> 16, (int)lq >> 24); }
                xr[64 * jj] = v * rsn * gg; }
        }
    }
#if DIAG_CLOCK
    if (bid0 == 0 && xb_thread0(wave_s)) { const float mhz = (float)MISC[20] / (float)MISC[18] * 100.f; const unsigned long long w = (unsigned long long)(mhz * 100.f);
        const unsigned long long t0 = __builtin_amdgcn_s_memrealtime(); while (__builtin_amdgcn_s_memrealtime() - t0 < w) __builtin_amdgcn_s_sleep(8); }
#endif
#if DIAG_XCDSKEW
    { const CArgs a = oargs(ap); unsigned* st = (unsigned*)(asglobal(a->ws) + WS_CTL) + 2048;
      __syncthreads(); if (xb_thread0(wave_s)) atomicAdd(st + 64 * (1 + bar.x), MISC[16]);
      xcd_barrier(bar);
      if (bid0 == 0 && xb_thread0(wave_s)) { unsigned mn = 0xffffffffu, mx = 0u;
        for (int j = 0; j < 8; ++j) { const unsigned v = __hip_atomic_load(st + 64 * (1 + j), __ATOMIC_RELAXED, __HIP_MEMORY_SCOPE_AGENT); mn = v < mn ? v : mn; mx = v > mx ? v : mx; }
        const unsigned long long w = (unsigned long long)((float)(DIAG_XCDSKEW == 1 ? mx - mn : (DIAG_XCDSKEW == 2 ? mn : mx)) * (1.f / 32.f) * DIAG_SCALE);
        const unsigned long long t0 = __builtin_amdgcn_s_memrealtime(); while (__builtin_amdgcn_s_memrealtime() - t0 < w) __builtin_amdgcn_s_sleep(8); } }
#endif
#if DIAG_BARTIME || DIAG_REGION
    { const CArgs a = oargs(ap); unsigned* st = (unsigned*)(asglobal(a->ws) + WS_CTL) + 2048;
      __syncthreads(); if (xb_thread0(wave_s)) atomicAdd(st, DIAG_REGION ? MISC[18] : MISC[16]);
      xcd_barrier(bar);
      if (bid0 == 0 && xb_thread0(wave_s)) { const unsigned tot = __hip_atomic_load(st, __ATOMIC_RELAXED, __HIP_MEMORY_SCOPE_AGENT); const unsigned long long w = (unsigned long long)((float)tot * (1.f / 256.f) * DIAG_SCALE);
        const unsigned long long t0 = __builtin_amdgcn_s_memrealtime(); while (__builtin_amdgcn_s_memrealtime() - t0 < w) __builtin_amdgcn_s_sleep(8); } }
#endif
#undef IN
#undef SEAM
#undef PHASE_ENTRY
}

extern "C" void kernel_launch(void* const* d_in, const int* in_sizes, int n_in, void* d_out, int out_size, void* d_ws, size_t ws_size, hipStream_t stream) {
    static int grid = 0;
    if (grid == 0) {
        if (n_in != 21 || in_sizes[0] != M * D || out_size != M * D || ws_size < WS_END) {
            fprintf(stderr, "kernel_launch: built for 21 inputs, x/out of %d floats, >= %zu bytes of workspace; got n_in %d, in0 %d, out %d, ws %zu; nothing launched\n", M * D, (size_t)WS_END, n_in, n_in > 0 ? in_sizes[0] : -1, out_size, ws_size);
            grid = -1; return; }
        int dev = 0, cus = 0, per_cu = 0;
        if (hipGetDevice(&dev) != hipSuccess || hipDeviceGetAttribute(&cus, hipDeviceAttributeMultiprocessorCount, dev) != hipSuccess) { fprintf(stderr, "kernel_launch: device query failed\n"); grid = -1; return; }
        if (hipFuncSetAttribute((const void*)hymba_fwd, hipFuncAttributeMaxDynamicSharedMemorySize, LDS_BYTES) != hipSuccess) { fprintf(stderr, "kernel_launch: hipFuncSetAttribute failed\n"); grid = -1; return; }
        if (hipOccupancyMaxActiveBlocksPerMultiprocessor(&per_cu, (const void*)hymba_fwd, NWAVES * 64, LDS_BYTES) != hipSuccess || per_cu < 1)
            fprintf(stderr, "kernel_launch: note: occupancy query reports %d workgroups per CU\n", per_cu);
        (void)hipGetLastError();
        grid = cus;
        if (grid != 256) fprintf(stderr, "kernel_launch: %d CUs; the row-scale tables assume a 256-workgroup grid\n", grid);
        if (grid != 256) { fprintf(stderr, "kernel_launch: built for a 256-CU device (panel ownership); nothing launched\n"); grid = -1; return; }
        { int seen[64] = {0};
          for (int c = 0; c < grid; ++c) { pg8::Unit u[3]; for (int k = 0; k < 3; ++k) { const int Nk = k == 0 ? D : (k == 1 ? NFF : NMIX); pg8::StaticOrder S; S.init(M, Nk, grid, c); u[k].pm = -1; u[k].pn = -1; S.next(0, u[k]); }
              if (u[0].pm < 0 || u[0].pm >= 64 || u[0].pm != u[1].pm || u[0].pm != u[2].pm || u[0].pn < 0 || u[0].pn >= NOWN || (seen[u[0].pm] >> u[0].pn & 1)) { fprintf(stderr, "kernel_launch: unit order does not give fixed panel owners (workgroup %d)\n", c); grid = -1; return; }
              seen[u[0].pm] |= 1 << u[0].pn; }
          for (int p = 0; p < 64; ++p) if (seen[p] != (1 << NOWN) - 1) { fprintf(stderr, "kernel_launch: panel %d lacks owners\n", p); grid = -1; return; } }
        const int Ns[3] = {NFF, D, NMIX};
        for (int k = 0; k < 3; ++k) for (int c = 0; c < grid; ++c) { pg8::StaticOrder S; S.init(M, Ns[k], grid, c); pg8::Unit u0, u; if (!S.next(0, u0)) continue;
            for (int i = 1; S.next(i, u); ++i) if (u.pm != u0.pm) { fprintf(stderr, "kernel_launch: unit order gives workgroup %d two row panels (N %d)\n", c, Ns[k]); grid = -1; return; } }
    }
    if (grid < 0) return;
    if (hipMemsetAsync((char*)d_ws + WS_CTL, 0, CTL_ZERO_BYTES, stream) != hipSuccess) { fprintf(stderr, "kernel_launch: hipMemsetAsync failed\n"); return; }
    Args a{};
    for (int i = 0; i < 21; ++i) a.in[i] = (const float*)d_in[i];
    a.out = (float*)d_out; a.ws = (unsigned char*)d_ws;
#if MK_SINGLE
    a.ph_lo = 0; a.ph_hi = N_PHASES;
    hipLaunchKernelGGL(hymba_fwd, dim3(grid), dim3(NWAVES * 64), LDS_BYTES, stream, a);
#else
    for (int p = 0; p < N_PHASES; ++p) { a.ph_lo = p; a.ph_hi = p + 1; hipLaunchKernelGGL(hymba_fwd, dim3(grid), dim3(NWAVES * 64), LDS_BYTES, stream, a); }
#endif
    const hipError_t le = hipPeekAtLastError();
    if (le != hipSuccess) fprintf(stderr, "kernel_launch: launch failed: %s\n", hipGetErrorName(le));
}
```
